# Optimizing an MI355X kernel written in HIP

```python
import math
import jax, jax.numpy as jnp
from jax import lax
import numpy as np

D_MODEL = 2048
BATCH = 4
SEQ = 4096
DEPTH = 1

GRID_W = 64
CTX_LEN = 256
HEAD_DIM = 64
A_HEADS = 8
A_V_DIM = 2 * HEAD_DIM
B_HEADS = 16
B_KV_HEADS = 2
B_GROUP = B_HEADS // B_KV_HEADS
WINDOW = 128
Q_BLOCK = 128
ROPE_THETA = 10000.0
N_EXPERTS = 32
TOP_K = 4
D_FF = D_MODEL
SWIGLU_ALPHA = 1.702
SWIGLU_LIMIT = 7.0
MOE_BLOCK = 128
LN_EPS = 1e-5
NEG_INF = -1e30
DEEPNORM_ALPHA = (2 * DEPTH) ** 0.25
DEEPNORM_BETA = (8 * DEPTH) ** -0.25
A_Q = 2 * A_HEADS * HEAD_DIM
A_K = 2 * A_HEADS * HEAD_DIM
A_V = A_HEADS * A_V_DIM
B_Q = B_HEADS * HEAD_DIM
B_K = B_KV_HEADS * HEAD_DIM
B_V = B_KV_HEADS * HEAD_DIM
PROJ_SPLITS = (A_Q, A_K, A_V, B_Q, B_K, B_V, D_MODEL, D_MODEL)
PROJ_COLS = A_Q + A_K + A_V + B_Q + B_K + B_V + 2 * D_MODEL

kernel_name = "hybrid_diffattn_swa_sink_moe_dit_layer"

F32 = jnp.float32


def layer_norm(x, g, b):
    xf = x.astype(F32)
    mu = xf.mean(-1, keepdims=True)
    var = jnp.square(xf - mu).mean(-1, keepdims=True)
    return ((xf - mu) * lax.rsqrt(var + LN_EPS) * g + b).astype(x.dtype)


def rms_norm(x, w):
    xf = x.astype(F32)
    return (xf * lax.rsqrt(jnp.mean(xf * xf, -1, keepdims=True) + LN_EPS) * w).astype(x.dtype)


def axial_rope_tables(n_tok):
    rows = n_tok // GRID_W
    row = jnp.repeat(jnp.arange(rows), GRID_W).astype(F32)
    col = jnp.tile(jnp.arange(GRID_W), rows).astype(F32)
    half = HEAD_DIM // 2
    inv = ROPE_THETA ** (-jnp.arange(0, half, 2, dtype=F32) / half)
    ang_r = row[:, None] * inv
    ang_c = col[:, None] * inv
    return jnp.cos(ang_r), jnp.sin(ang_r), jnp.cos(ang_c), jnp.sin(ang_c)


def rotate(x, cos, sin):
    x1, x2 = jnp.split(x, 2, axis=-1)
    cos = cos[None, :, None, :]
    sin = sin[None, :, None, :]
    return jnp.concatenate([x1 * cos - x2 * sin, x2 * cos + x1 * sin], -1).astype(x.dtype)


def axial_rope(x, tables):
    cr, sr, cc, sc = tables
    xr, xc = jnp.split(x, 2, axis=-1)
    return jnp.concatenate([rotate(xr, cr, sr), rotate(xc, cc, sc)], -1)


def split_projection(p, n_tok):
    b = p.shape[0]
    offs, acc = [], 0
    for s in PROJ_SPLITS[:-1]:
        acc += s
        offs.append(acc)
    qa, ka, va, qb, kb, vb, ga, gb = jnp.split(p, offs, axis=-1)
    return (qa.reshape(b, n_tok, 2 * A_HEADS, HEAD_DIM),
            ka.reshape(b, n_tok, 2 * A_HEADS, HEAD_DIM),
            va.reshape(b, n_tok, A_HEADS, A_V_DIM),
            qb.reshape(b, n_tok, B_HEADS, HEAD_DIM),
            kb.reshape(b, n_tok, B_KV_HEADS, HEAD_DIM),
            vb.reshape(b, n_tok, B_KV_HEADS, HEAD_DIM),
            ga, gb)


def diff_combine(s, lam, v):
    p = jax.nn.softmax(s.astype(F32), axis=-1)
    b, m, q, k = p.shape
    p = p.reshape(b, m // 2, 2, q, k)
    a = p[:, :, 0] - lam * p[:, :, 1]
    return jnp.einsum('bhqk,bkhe->bqhe', a.astype(v.dtype), v)


def diff_output(o, subln_w, lam_init):
    b, n = o.shape[:2]
    return (rms_norm(o, subln_w) * (1.0 - lam_init)).reshape(b, n, A_V)


def diff_attention_latent(q, k, v, kc, vc, lam, subln_w, lam_init):
    b, n = q.shape[:2]
    nb = n // Q_BLOCK
    scale = HEAD_DIM ** -0.5
    k_all = jnp.concatenate([k, kc], axis=1)
    v_all = jnp.concatenate([v, vc], axis=1)
    q_blocks = q.reshape(b, nb, Q_BLOCK, 2 * A_HEADS, HEAD_DIM).swapaxes(0, 1)

    def block(qb):
        s = jnp.einsum('bqmd,bkmd->bmqk', qb, k_all) * scale
        return diff_combine(s, lam, v_all)

    o = lax.map(block, q_blocks)
    o = o.swapaxes(0, 1).reshape(b, n, A_HEADS, A_V_DIM)
    return diff_output(o, subln_w, lam_init)


def diff_attention_ctx(qc, kc, vc, lam, subln_w, lam_init):
    s = jnp.einsum('bqmd,bkmd->bmqk', qc, kc) * (HEAD_DIM ** -0.5)
    return diff_output(diff_combine(s, lam, vc), subln_w, lam_init)


def sink_softmax(s, sinks):
    sink = jnp.broadcast_to(sinks.astype(F32).reshape(B_KV_HEADS, B_GROUP, 1, 1), s.shape[:-1] + (1,))
    p = jax.nn.softmax(jnp.concatenate([s, sink], axis=-1), axis=-1)
    return p[..., :-1]


def window_attention_latent(q, k, v, kc, vc, sinks):
    b, n = q.shape[:2]
    nb = n // WINDOW
    scale = HEAD_DIM ** -0.5
    qb = q.reshape(b, nb, WINDOW, B_KV_HEADS, B_GROUP, HEAD_DIM)

    def bands(t):
        tp = jnp.pad(t, ((0, 0), (WINDOW, WINDOW), (0, 0), (0, 0)))
        tp = tp.reshape(b, nb + 2, WINDOW, B_KV_HEADS, HEAD_DIM)
        return jnp.concatenate([tp[:, :-2], tp[:, 1:-1], tp[:, 2:]], axis=2)

    kw, vw = bands(k), bands(v)
    s_win = jnp.einsum('bnqhgd,bnjhd->bnhgqj', qb, kw).astype(F32) * scale
    s_ctx = jnp.einsum('bnqhgd,bchd->bnhgqc', qb, kc).astype(F32) * scale
    blk = jnp.arange(nb)[:, None, None] * WINDOW
    qpos = blk + jnp.arange(WINDOW)[None, :, None]
    kpos = blk - WINDOW + jnp.arange(3 * WINDOW)[None, None, :]
    valid = (jnp.abs(qpos - kpos) <= WINDOW) & (kpos >= 0) & (kpos < n)
    s_win = jnp.where(valid[None, :, None, None], s_win, NEG_INF)
    p = sink_softmax(jnp.concatenate([s_win, s_ctx], axis=-1), sinks)
    p_win, p_ctx = p[..., :3 * WINDOW], p[..., 3 * WINDOW:]
    o = (jnp.einsum('bnhgqj,bnjhd->bnqhgd', p_win.astype(v.dtype), vw)
         + jnp.einsum('bnhgqc,bchd->bnqhgd', p_ctx.astype(vc.dtype), vc))
    return o.reshape(b, n, B_Q)


def sink_attention_ctx(qc, kc, vc, sinks):
    b, n = qc.shape[:2]
    qg = qc.reshape(b, n, B_KV_HEADS, B_GROUP, HEAD_DIM)
    s = jnp.einsum('bqhgd,bchd->bhgqc', qg, kc).astype(F32) * (HEAD_DIM ** -0.5)
    p = sink_softmax(s, sinks)
    o = jnp.einsum('bhgqc,bchd->bqhgd', p.astype(vc.dtype), vc)
    return o.reshape(b, n, B_Q)


def gated_merge(oa, ob, ga, gb, w_oA, w_oB, w_out):
    y = jax.nn.sigmoid(ga) * (oa @ w_oA) + jax.nn.sigmoid(gb) * (ob @ w_oB)
    return y @ w_out


def token_mixer(h, hc, rope, lam, subln_w, sinks, w_in, w_oA, w_oB, w_out, lam_init, with_ctx):
    n, n_ctx = h.shape[1], hc.shape[1]
    qa, ka, va, qb, kb, vb, ga, gb = split_projection(h @ w_in, n)
    qac, kac, vac, qbc, kbc, vbc, gac, gbc = split_projection(hc @ w_in, n_ctx)
    qa, ka, qb, kb = (axial_rope(t, rope) for t in (qa, ka, qb, kb))
    oa = diff_attention_latent(qa, ka, va, kac, vac, lam, subln_w, lam_init)
    ob = window_attention_latent(qb, kb, vb, kbc, vbc, sinks)
    out = gated_merge(oa, ob, ga, gb, w_oA, w_oB, w_out)
    if with_ctx:
        oac = diff_attention_ctx(qac, kac, vac, lam, subln_w, lam_init)
        obc = sink_attention_ctx(qbc, kbc, vbc, sinks)
        return out, gated_merge(oac, obc, gac, gbc, w_oA, w_oB, w_out)
    return out, None


def clamped_swiglu(gu):
    x_glu, x_lin = jnp.split(gu, 2, axis=-1)
    x_glu = jnp.minimum(x_glu, SWIGLU_LIMIT)
    x_lin = jnp.clip(x_lin, -SWIGLU_LIMIT, SWIGLU_LIMIT)
    return x_glu * jax.nn.sigmoid(SWIGLU_ALPHA * x_glu) * (x_lin + 1.0)


def moe_ffn(h, w_router, b_router, w_up, b_up, w_down, b_down):
    shp = h.shape
    t = h.reshape(-1, D_MODEL)
    n_tok = t.shape[0]
    n_assign = n_tok * TOP_K
    logits = (t @ w_router + b_router).astype(F32)
    top_logit, top_e = lax.top_k(logits, TOP_K)
    gate = jax.nn.softmax(top_logit, axis=-1).astype(h.dtype)
    e_flat = top_e.reshape(-1)
    tok_flat = jnp.repeat(jnp.arange(n_tok, dtype=jnp.int32), TOP_K)
    g_flat = gate.reshape(-1)
    order = jnp.argsort(e_flat, stable=True)
    se, stok, sg = e_flat[order], tok_flat[order], g_flat[order]
    counts = jnp.bincount(e_flat, length=N_EXPERTS)
    padded = (counts + MOE_BLOCK - 1) // MOE_BLOCK * MOE_BLOCK
    start = jnp.cumsum(counts) - counts
    pend = jnp.cumsum(padded)
    pstart = pend - padded
    pos = pstart[se] + jnp.arange(n_assign) - start[se]
    n_blocks = -(-n_assign // MOE_BLOCK) + N_EXPERTS
    n_rows = n_blocks * MOE_BLOCK
    row_tok = jnp.zeros((n_rows,), jnp.int32).at[pos].set(stok)
    row_gate = jnp.zeros((n_rows,), h.dtype).at[pos].set(sg)
    blk_e = jnp.minimum(jnp.searchsorted(pend, jnp.arange(n_blocks) * MOE_BLOCK, side='right'),
                        N_EXPERTS - 1)

    def expert_block(args):
        e, toks = args
        xb = t[toks]
        gu = xb @ w_up[e] + b_up[e]
        return clamped_swiglu(gu) @ w_down[e] + b_down[e]

    y = lax.map(expert_block, (blk_e, row_tok.reshape(n_blocks, MOE_BLOCK)))
    out = jnp.zeros_like(t).at[row_tok].add(y.reshape(n_rows, D_MODEL) * row_gate[:, None])
    return out.reshape(shp)


def setup_inputs(seed: int = 0) -> dict:
    key = jax.random.key(seed)
    ks = jax.random.split(key, 26)

    def nrm(k, shape, scale):
        return jax.random.normal(k, shape, F32) * scale

    L = DEPTH
    return {
        "x": nrm(ks[0], (BATCH, SEQ, D_MODEL), 1.0),
        "c": nrm(ks[1], (BATCH, D_MODEL), 1.0),
        "ctx": nrm(ks[2], (BATCH, CTX_LEN, D_MODEL), 1.0),
        "c_ctx": nrm(ks[3], (D_MODEL,), 1.0),
        "w_ada": nrm(ks[4], (L, D_MODEL, 6 * D_MODEL), 0.5 * D_MODEL ** -0.5),
        "b_ada": nrm(ks[5], (L, 6 * D_MODEL), 0.01),
        "w_in": nrm(ks[6], (L, D_MODEL, PROJ_COLS), D_MODEL ** -0.5),
        "lam_q1": nrm(ks[7], (L, HEAD_DIM), 0.1),
        "lam_k1": nrm(ks[8], (L, HEAD_DIM), 0.1),
        "lam_q2": nrm(ks[9], (L, HEAD_DIM), 0.1),
        "lam_k2": nrm(ks[10], (L, HEAD_DIM), 0.1),
        "subln_w": 1.0 + nrm(ks[11], (L, A_V_DIM), 0.01),
        "sinks": nrm(ks[12], (L, B_HEADS), 0.5),
        "w_oA": nrm(ks[13], (L, A_V, D_MODEL), A_V ** -0.5),
        "w_oB": nrm(ks[14], (L, B_Q, D_MODEL), B_Q ** -0.5),
        "w_out": nrm(ks[15], (L, D_MODEL, D_MODEL), DEEPNORM_BETA * D_MODEL ** -0.5),
        "ln1_g": 1.0 + nrm(ks[16], (L, D_MODEL), 0.01),
        "ln1_b": nrm(ks[17], (L, D_MODEL), 0.01),
        "w_router": nrm(ks[18], (L, D_MODEL, N_EXPERTS), D_MODEL ** -0.5),
        "b_router": nrm(ks[19], (L, N_EXPERTS), 0.01),
        "w_up": nrm(ks[20], (L, N_EXPERTS, D_MODEL, 2 * D_FF), D_MODEL ** -0.5),
        "b_up": nrm(ks[21], (L, N_EXPERTS, 2 * D_FF), 0.01),
        "w_down": nrm(ks[22], (L, N_EXPERTS, D_FF, D_MODEL), DEEPNORM_BETA * D_FF ** -0.5),
        "b_down": nrm(ks[23], (L, N_EXPERTS, D_MODEL), 0.01),
        "ln2_g": 1.0 + nrm(ks[24], (L, D_MODEL), 0.01),
        "ln2_b": nrm(ks[25], (L, D_MODEL), 0.01),
    }


def reference(x, c, ctx, c_ctx, w_ada, b_ada, w_in, lam_q1, lam_k1, lam_q2, lam_k2, subln_w,
              sinks, w_oA, w_oB, w_out, ln1_g, ln1_b, w_router, b_router, w_up, b_up,
              w_down, b_down, ln2_g, ln2_b):
    rope = axial_rope_tables(x.shape[1])
    for l in range(DEPTH):
        with_ctx = l < DEPTH - 1
        lam_init = 0.8 - 0.6 * math.exp(-0.3 * l)
        lam = (jnp.exp(jnp.sum(lam_q1[l] * lam_k1[l]).astype(F32))
               - jnp.exp(jnp.sum(lam_q2[l] * lam_k2[l]).astype(F32)) + lam_init)
        sh1, sc1, g1, sh2, sc2, g2 = (m[:, None, :] for m in
                                      jnp.split(jax.nn.silu(c) @ w_ada[l] + b_ada[l], 6, axis=-1))
        sh1c, sc1c, g1c, sh2c, sc2c, g2c = jnp.split(jax.nn.silu(c_ctx) @ w_ada[l] + b_ada[l], 6, axis=-1)
        h = x * (1 + sc1) + sh1
        hc = ctx * (1 + sc1c) + sh1c
        mix, mix_c = token_mixer(h, hc, rope, lam, subln_w[l], sinks[l], w_in[l], w_oA[l],
                                 w_oB[l], w_out[l], lam_init, with_ctx)
        x = layer_norm(DEEPNORM_ALPHA * x + g1 * mix, ln1_g[l], ln1_b[l])
        ffn = (w_router[l], b_router[l], w_up[l], b_up[l], w_down[l], b_down[l])
        x = layer_norm(DEEPNORM_ALPHA * x + g2 * moe_ffn(x * (1 + sc2) + sh2, *ffn), ln2_g[l], ln2_b[l])
        if with_ctx:
            ctx = layer_norm(DEEPNORM_ALPHA * ctx + g1c * mix_c, ln1_g[l], ln1_b[l])
            ctx = layer_norm(DEEPNORM_ALPHA * ctx + g2c * moe_ffn(ctx * (1 + sc2c) + sh2c, *ffn),
                             ln2_g[l], ln2_b[l])
    return x
```

```cpp
#include <hip/hip_runtime.h>
#include <cstdio>
#include <cstdint>
namespace pg8 {
#define PG8_LAS __attribute__((address_space(3)))
typedef unsigned short bf16_t;
typedef short bf16x8 __attribute__((ext_vector_type(8)));
typedef float f32x4 __attribute__((ext_vector_type(4)));
typedef unsigned u32x4 __attribute__((ext_vector_type(4)));
constexpr int BM = 256, BK = 64, HALF = 128, HTB = HALF * BK * 2  , STAGE_BYTES = 8 * HTB, NXCD = 8, WGM = 8;

__host__ __device__ __forceinline__ int lds_byte(int r, int c) { const int st = (r >> 4) * 2 + (c >> 5), rr = r & 15, cc = c & 31, ob = rr * 64 + cc * 2; return st * 1024 + (ob ^ (((ob >> 9) & 1) << 5)); }
__host__ __device__ __forceinline__ void stage_rc(int b, int& R, int& C) { const int st = b / 1024, sb = b % 1024, swz = sb ^ (((sb >> 9) & 1) << 5); R = (st >> 1) * 16 + swz / 64; C = (st & 1) * 32 + (swz % 64) / 2; }
__host__ __device__ __forceinline__ int perm32(int rho) { const int n = rho >> 4, i = rho & 15; return 8 * (i >> 2) + 4 * n + (i & 3); }

struct Unit { int pm, pn, pb; };
struct Gemm { const bf16_t* A; const bf16_t* Bt; int M, N, K; };

struct StaticOrder {
    int nM, nN, nwg, G, c;
    __host__ __device__ void init(int M, int N, int G_, int c_) { nM = M / BM; nN = N / BM; nwg = nM * nN; G = G_; c = c_; }
    __host__ __device__ bool next(int i, Unit& u) const {
        const long L = (long)i * G + c; if (L >= nwg) return false;
        int wgid = (int)L; { const int q = nwg / NXCD, r = nwg % NXCD, xcd = wgid % NXCD, off = wgid / NXCD; wgid = (xcd < r ? xcd * (q + 1) : r * (q + 1) + (xcd - r) * q) + off; }
        const int nig = WGM * nN, gid = wgid / nig, fm = gid * WGM, gsz = (nM - fm) < WGM ? (nM - fm) : WGM;
        u.pm = fm + ((wgid % nig) % gsz); u.pn = (wgid % nig) / gsz; u.pb = u.pn; return true;
    }
    __device__ __forceinline__ void a_ready(const Unit&) const {}
    __device__ __forceinline__ void done(const Unit&) const {}
};

__device__ __forceinline__ unsigned cvt_pk_bf16(float lo, float hi) { unsigned r; asm volatile("v_cvt_pk_bf16_f32 %0, %1, %2" : "=v"(r) : "v"(lo), "v"(hi)); return r; }
typedef float f32x2 __attribute__((ext_vector_type(2)));
__device__ __forceinline__ f32x2 gelu_pk(f32x2 v) {
    const f32x2 av = __builtin_elementwise_abs(v), d = av * 0.2316418882f + 1.0f;
    f32x2 t; t.x = __builtin_amdgcn_rcpf(d.x); t.y = __builtin_amdgcn_rcpf(d.y);
    f32x2 q = t * 0.5307027145f + (-0.7265760135f); q = q * t + 0.7107068705f; q = q * t + (-0.142248368f); q = q * t + 0.127414796f; q = q * t;
    const f32x2 s = (v * v) * (-0.72134752044f);
    f32x2 e; e.x = __builtin_amdgcn_exp2f(s.x); e.y = __builtin_amdgcn_exp2f(s.y);
    const f32x2 m = v * (q * e), r = v - m;
    f32x2 o; o.x = v.x < 0.f ? m.x : r.x; o.y = v.y < 0.f ? m.y : r.y; return o;
}

template <int ACT  > struct EpiBf16 {
    static constexpr bool PERM = true, AFTER_DRAIN = false; static_assert(ACT == 0 || ACT == 1, "EpiBf16: ACT is 0 (none) or 1 (gelu_pk)");
    bf16_t* O; int ldc; const float* bias; int split_cols; size_t split_stride; float scale0;
    __device__ __forceinline__ void operator()(const f32x4 (&acc)[2][2][4][2], const Unit& u, int wr, int wc, int fr, int fq) const {
        const int row0 = u.pm * BM + wr * 64 + fr; int colt = u.pn * BM; bf16_t* base = O;
        float sc = 1.f; if (split_cols) { const int t = colt / split_cols; base += (size_t)t * split_stride; colt -= t * split_cols; if (t == 0) sc = scale0; }
        const int col0 = colt + wc * 32 + 8 * fq, bcol0 = u.pn * BM + wc * 32 + 8 * fq;
        f32x4 bv[2][2];
#pragma unroll
        for (int bj = 0; bj < 2; ++bj)
#pragma unroll
            for (int n = 0; n < 2; ++n) bv[bj][n] = bias ? *(const f32x4*)(bias + bcol0 + bj * HALF + 4 * n) : (f32x4){0.f, 0.f, 0.f, 0.f};
#pragma unroll
        for (int ai = 0; ai < 2; ++ai)
#pragma unroll
            for (int m = 0; m < 4; ++m) { bf16_t* rowp = base + (size_t)(row0 + ai * HALF + m * 16) * ldc + col0;
#pragma unroll
                for (int bj = 0; bj < 2; ++bj) { f32x4 v0 = acc[ai][bj][m][0] + bv[bj][0], v1 = acc[ai][bj][m][1] + bv[bj][1];
                    if (ACT == 1) { f32x2 a = gelu_pk((f32x2){v0[0], v0[1]}), b = gelu_pk((f32x2){v0[2], v0[3]}), c = gelu_pk((f32x2){v1[0], v1[1]}), d = gelu_pk((f32x2){v1[2], v1[3]});
                        v0 = (f32x4){a.x, a.y, b.x, b.y}; v1 = (f32x4){c.x, c.y, d.x, d.y}; }
                    v0 = v0 * sc; v1 = v1 * sc; u32x4 w; w.x = cvt_pk_bf16(v0[0], v0[1]); w.y = cvt_pk_bf16(v0[2], v0[3]); w.z = cvt_pk_bf16(v1[0], v1[1]); w.w = cvt_pk_bf16(v1[2], v1[3]);
                    *(u32x4*)(rowp + bj * HALF) = w; } }
    }
};

template <class Epi, class Sched, bool ALIGN_EPI = false, bool SP2 = false>
__device__ __forceinline__ void gemm_phase(PG8_LAS unsigned char* lds, const Gemm g, const Sched& S, const Epi& E) {
    int tid_ = threadIdx.x; asm volatile("" : "+v"(tid_));
    const int tid = tid_, wid = __builtin_amdgcn_readfirstlane(tid >> 6), lane = tid & 63, wr = wid >> 2, wc = wid & 3, fr = lane & 15, fq = lane >> 4;
    const int K = g.K, nt = K / BK;
    unsigned voffA[2], voffB[2];
#pragma unroll
    for (int i = 0; i < 2; ++i) { int R, C; stage_rc(tid * 16 + i * 8192, R, C); const int Rb = Epi::PERM ? ((R & ~31) + perm32(R & 31)) : R;
        voffA[i] = (unsigned)(R * K + C) * 2u; voffB[i] = (unsigned)(Rb * K + C) * 2u; }
    const size_t kstep = (size_t)(BK * 2);
    const size_t hstep = (size_t)HALF * K * 2;
    const size_t tstep = 2 * hstep;
    const unsigned ldsw = (unsigned)wid * 1024u;
    const int aoff = lds_byte(wr * 64 + fr, fq * 8), boff = lds_byte(wc * 32 + fr, fq * 8);
#define PG8_SA(b, h) (((b) * 2 + (h)) * HTB)
#define PG8_SB(b, h) ((4 + (b) * 2 + (h)) * HTB)
#define PG8_STAGE(bufoff, gbase, voff) do { _Pragma("unroll") for (int _i = 0; _i < 2; ++_i) \
        __builtin_amdgcn_global_load_lds((const unsigned*)((const char*)(gbase) + (voff)[_i]), (PG8_LAS unsigned*)(lds + (bufoff) + ldsw + _i * 8192), 16, 0, 0); } while (0)
#define PG8_LDA(dst, b, h) do { _Pragma("unroll") for (int m = 0; m < 4; ++m) _Pragma("unroll") for (int k = 0; k < 2; ++k) dst[m][k] = *(const PG8_LAS bf16x8*)(lds + PG8_SA(b, h) + aoff + m * 2048 + k * 1024); } while (0)
#define PG8_LDB(dst, b, h) do { _Pragma("unroll") for (int n = 0; n < 2; ++n) _Pragma("unroll") for (int k = 0; k < 2; ++k) dst[n][k] = *(const PG8_LAS bf16x8*)(lds + PG8_SB(b, h) + boff + n * 2048 + k * 1024); } while (0)
#define PG8_MMA(ai, bj, At, Bt) do { __builtin_amdgcn_s_setprio(1); _Pragma("unroll") for (int m = 0; m < 4; ++m) _Pragma("unroll") for (int n = 0; n < 2; ++n) _Pragma("unroll") for (int k = 0; k < 2; ++k) \
        acc[ai][bj][m][n] = __builtin_amdgcn_mfma_f32_16x16x32_bf16(Bt[n][k], At[m][k], acc[ai][bj][m][n], 0, 0, 0); __builtin_amdgcn_s_setprio(0); } while (0)
#define PG8_WAIT_V(n) asm volatile("s_waitcnt vmcnt(" #n ")" ::: "memory")
#define PG8_WAIT_L(n) asm volatile("s_waitcnt lgkmcnt(" #n ")" ::: "memory")
#define PG8_BAR __builtin_amdgcn_s_barrier()
#define PG8_SCHED __builtin_amdgcn_sched_barrier(0)
    Unit cur, nxt; int ui = 0;
    if (!S.next(0, cur)) return;
    f32x4 acc[2][2][4][2];
#pragma unroll
    for (int a = 0; a < 2; ++a)
#pragma unroll
        for (int b = 0; b < 2; ++b)
#pragma unroll
            for (int m = 0; m < 4; ++m)
#pragma unroll
                for (int n = 0; n < 2; ++n) acc[a][b][m][n] = (f32x4){0.f, 0.f, 0.f, 0.f};
    bf16x8 At[4][2], B0[2][2], B1[2][2];
    const char* cA = (const char*)g.A + (size_t)cur.pm * tstep; const char* cB = (const char*)g.Bt + (size_t)cur.pb * tstep;
    S.a_ready(cur);
    if constexpr (SP2) {
        PG8_STAGE(PG8_SB(0, 0), cB, voffB); PG8_STAGE(PG8_SB(0, 1), cB + hstep, voffB); PG8_STAGE(PG8_SA(0, 0), cA, voffA); PG8_STAGE(PG8_SA(0, 1), cA + hstep, voffA);
        if (wr == 1) PG8_BAR;
        PG8_WAIT_V(2); PG8_BAR;
        PG8_STAGE(PG8_SB(1, 0), cB + kstep, voffB); PG8_STAGE(PG8_SA(1, 0), cA + kstep, voffA); PG8_STAGE(PG8_SB(1, 1), cB + hstep + kstep, voffB);
        PG8_WAIT_V(6); PG8_BAR;
    } else {
        PG8_STAGE(PG8_SB(0, 0), cB, voffB); PG8_STAGE(PG8_SA(0, 0), cA, voffA); PG8_STAGE(PG8_SB(0, 1), cB + hstep, voffB); PG8_STAGE(PG8_SA(0, 1), cA + hstep, voffA);
        if (wr == 1) PG8_BAR;
        PG8_WAIT_V(4); PG8_BAR;
        PG8_STAGE(PG8_SB(1, 0), cB + kstep, voffB); PG8_STAGE(PG8_SA(1, 0), cA + kstep, voffA); PG8_STAGE(PG8_SB(1, 1), cB + hstep + kstep, voffB);
        PG8_WAIT_V(6); PG8_BAR;
    }
    for (;;) {
        const bool has_next = S.next(ui + 1, nxt);
        const char* nA = has_next ? (const char*)g.A + (size_t)nxt.pm * tstep : cA; const char* nB = has_next ? (const char*)g.Bt + (size_t)nxt.pb * tstep : cB;
        for (int t = 0; t < nt; t += 2) {
            const bool last = (t == nt - 2);
            const char* a1 = cA + (size_t)(t + 1) * kstep;
            const char* a2 = last ? nA : cA + (size_t)(t + 2) * kstep; const char* b2 = last ? nB : cB + (size_t)(t + 2) * kstep;
            const char* a3 = a2 + kstep; const char* b3 = b2 + kstep;
            if (last && has_next) S.a_ready(nxt);
            if constexpr (SP2) {
            PG8_LDB(B0, 0, 0); PG8_LDB(B1, 0, 1); PG8_SCHED; PG8_LDA(At, 0, 0); PG8_STAGE(PG8_SA(1, 1), a1 + hstep, voffA);
            PG8_WAIT_V(8); PG8_WAIT_L(0); PG8_BAR; PG8_MMA(0, 0, At, B0); PG8_MMA(0, 1, At, B1); PG8_BAR; PG8_SCHED;
            PG8_LDA(At, 0, 1); PG8_STAGE(PG8_SB(0, 0), b2, voffB); PG8_STAGE(PG8_SB(0, 1), b2 + hstep, voffB); PG8_STAGE(PG8_SA(0, 0), a2, voffA);
            PG8_WAIT_V(8); PG8_WAIT_L(0); PG8_BAR; PG8_MMA(1, 0, At, B0); PG8_MMA(1, 1, At, B1); PG8_BAR; PG8_SCHED;
            PG8_LDB(B0, 1, 0); PG8_LDB(B1, 1, 1); PG8_SCHED; PG8_LDA(At, 1, 0); PG8_STAGE(PG8_SA(0, 1), a2 + hstep, voffA);
            PG8_WAIT_V(8); PG8_WAIT_L(0); PG8_BAR; PG8_MMA(0, 0, At, B0); PG8_MMA(0, 1, At, B1); PG8_BAR; PG8_SCHED;
            PG8_LDA(At, 1, 1); PG8_STAGE(PG8_SB(1, 0), b3, voffB); PG8_STAGE(PG8_SB(1, 1), b3 + hstep, voffB); PG8_STAGE(PG8_SA(1, 0), a3, voffA);
            PG8_WAIT_V(8); PG8_WAIT_L(0); PG8_BAR; PG8_MMA(1, 0, At, B0); PG8_MMA(1, 1, At, B1); PG8_BAR; PG8_SCHED;
            } else {
            PG8_LDB(B0, 0, 0); PG8_SCHED; PG8_LDA(At, 0, 0); PG8_STAGE(PG8_SA(1, 1), a1 + hstep, voffA);
            PG8_WAIT_L(8); PG8_BAR; PG8_WAIT_L(0); PG8_MMA(0, 0, At, B0); PG8_BAR; PG8_SCHED;
            PG8_LDB(B1, 0, 1); PG8_STAGE(PG8_SB(0, 0), b2, voffB);
            PG8_BAR; PG8_WAIT_L(0); PG8_MMA(0, 1, At, B1); PG8_BAR;
            PG8_LDA(At, 0, 1); PG8_STAGE(PG8_SA(0, 0), a2, voffA);
            PG8_BAR; PG8_WAIT_L(0); PG8_MMA(1, 0, At, B0); PG8_BAR; PG8_SCHED;
            PG8_STAGE(PG8_SB(0, 1), b2 + hstep, voffB);
            PG8_WAIT_V(6); PG8_BAR; PG8_MMA(1, 1, At, B1); PG8_BAR;
            PG8_LDB(B0, 1, 0); PG8_SCHED; PG8_LDA(At, 1, 0); PG8_STAGE(PG8_SA(0, 1), a2 + hstep, voffA);
            PG8_WAIT_L(8); PG8_BAR; PG8_WAIT_L(0); PG8_MMA(0, 0, At, B0); PG8_BAR; PG8_SCHED;
            PG8_LDB(B1, 1, 1); PG8_STAGE(PG8_SB(1, 0), b3, voffB);
            PG8_BAR; PG8_WAIT_L(0); PG8_MMA(0, 1, At, B1); PG8_BAR;
            PG8_LDA(At, 1, 1); PG8_STAGE(PG8_SA(1, 0), a3, voffA);
            PG8_BAR; PG8_WAIT_L(0); PG8_MMA(1, 0, At, B0); PG8_BAR; PG8_SCHED;
            PG8_STAGE(PG8_SB(1, 1), b3 + hstep, voffB);
            PG8_WAIT_V(6); PG8_BAR; PG8_MMA(1, 1, At, B1); PG8_BAR;
            }
        }
        if constexpr (ALIGN_EPI) { if (wr == 0) PG8_BAR; }
        if constexpr (!Epi::AFTER_DRAIN) { E(acc, cur, wr, wc, fr, fq); S.done(cur); }
        if (!has_next) break;
#pragma unroll
        for (int a = 0; a < 2; ++a)
#pragma unroll
            for (int b = 0; b < 2; ++b)
#pragma unroll
                for (int m = 0; m < 4; ++m)
#pragma unroll
                    for (int n = 0; n < 2; ++n) acc[a][b][m][n] = (f32x4){0.f, 0.f, 0.f, 0.f};
        cur = nxt; cA = nA; cB = nB; ++ui;
        if constexpr (ALIGN_EPI) { if (wr == 1) PG8_BAR; }
    }
    PG8_WAIT_V(0);
    if constexpr (!ALIGN_EPI) { if (wr == 0) PG8_BAR; }
    PG8_BAR;
    if constexpr (Epi::AFTER_DRAIN) { E.fused(acc, cur, wr, wc, fr, fq, lds, wid, lane); S.done(cur); }
#undef PG8_SA
#undef PG8_SB
#undef PG8_STAGE
#undef PG8_LDA
#undef PG8_LDB
#undef PG8_MMA
#undef PG8_WAIT_V
#undef PG8_WAIT_L
#undef PG8_BAR
#undef PG8_SCHED
}
}

#ifndef PG8_SP2
#define PG8_SP2 true
#endif
#ifndef PG8_ALIGN
#define PG8_ALIGN true
#endif
#include <hip/hip_bf16.h>
#include <cmath>
namespace pg8 {
__device__ __forceinline__ float bf_lo(unsigned w) { return __uint_as_float(w << 16); }
__device__ __forceinline__ float bf_hi(unsigned w) { return __uint_as_float(w & 0xffff0000u); }
__device__ __forceinline__ u32x4 pack8(const f32x4 v0, const f32x4 v1) { u32x4 w; w.x = cvt_pk_bf16(v0[0], v0[1]); w.y = cvt_pk_bf16(v0[2], v0[3]); w.z = cvt_pk_bf16(v1[0], v1[1]); w.w = cvt_pk_bf16(v1[2], v1[3]); return w; }
__device__ __forceinline__ float sigmoidf_fast(float x) { return __builtin_amdgcn_rcpf(1.0f + __builtin_amdgcn_exp2f(-1.4426950408889634f * x)); }

struct InProjOrder {
    int G, c;
    __device__ bool next(int i, Unit& u) const {
        constexpr int NMAIN = 64 * 33, NWG = NMAIN + 36;
        const int L = i * G + c; if (L >= NWG) return false;
        int wgid = L; { const int q = NWG / NXCD, r = NWG % NXCD, xcd = wgid % NXCD, off = wgid / NXCD; wgid = (xcd < r ? xcd * (q + 1) : r * (q + 1) + (xcd - r) * q) + off; }
        if (wgid < NMAIN) { const int nig = WGM * 33, gid = wgid / nig, fm = gid * WGM; u.pm = fm + ((wgid % nig) % WGM); u.pn = (wgid % nig) / WGM; }
        else { const int idx = wgid - NMAIN, j = idx >> 2; u.pm = 64 + (idx & 3); u.pn = j < 8 ? 4 + j : 16; }
        u.pb = u.pn; return true;
    }
    __device__ __forceinline__ void a_ready(const Unit&) const {}
    __device__ __forceinline__ void done(const Unit&) const {}
};
struct MoeOrder {
    int nM, nN, nwg, G, c; const PG8_LAS int* mt_e;
    __device__ void init(int nM_, int nN_, int G_, int c_, const PG8_LAS int* t) { nM = nM_; nN = nN_; nwg = nM * nN; G = G_; c = c_; mt_e = t; }
    __device__ bool next(int i, Unit& u) const {
        const long L = (long)i * G + c; if (L >= nwg) return false;
        int wgid = (int)L; { const int q = nwg / NXCD, r = nwg % NXCD, xcd = wgid % NXCD, off = wgid / NXCD; wgid = (xcd < r ? xcd * (q + 1) : r * (q + 1) + (xcd - r) * q) + off; }
        const int nig = WGM * nN, gid = wgid / nig, fm = gid * WGM, gsz = (nM - fm) < WGM ? (nM - fm) : WGM;
        u.pm = fm + ((wgid % nig) % gsz); u.pn = (wgid % nig) / gsz;
        u.pb = __builtin_amdgcn_readfirstlane(mt_e[u.pm]) * nN + u.pn; return true;
    }
    __device__ __forceinline__ void a_ready(const Unit&) const {}
    __device__ __forceinline__ void done(const Unit&) const {}
};

struct EpiInProj {
    static constexpr bool PERM = true, AFTER_DRAIN = false;
    bf16_t *QA, *KA, *VA, *QB, *KB, *VB, *GA, *GB; float c2;
    __device__ __forceinline__ void operator()(const f32x4 (&acc)[2][2][4][2], const Unit& u, int wr, int wc, int fr, int fq) const {
        const int pm = u.pm, pn = u.pn; const bool ctx = pm >= 64;
        const int b = ctx ? pm - 64 : (pm >> 4);
        const int krow0 = ctx ? b * 4352 + 4096 : b * 4352 + (pm & 15) * 256, qrow0 = pm * 256;
        float invf[4];
#pragma unroll
        for (int i = 0; i < 4; ++i) invf[i] = __builtin_amdgcn_exp2f(-(float)(4 * fq + i) * (13.287712379549449f / 16.0f)) * 0.15915494309189535f;
#pragma unroll
        for (int bj = 0; bj < 2; ++bj) {
            const int colt = 128 * bj + 32 * wc + 8 * fq;
            bf16_t* base; int pitch, row0, mode; float scl = 1.f;
            if (pn < 4)        { base = QA + (pn * 256 + colt);        pitch = 1024; row0 = qrow0; mode = 1; scl = c2; }
            else if (pn < 8)   { base = KA + ((pn - 4) * 256 + colt);  pitch = 1024; row0 = krow0; mode = ctx ? 0 : 1; }
            else if (pn < 12)  { base = VA + ((pn - 8) * 256 + colt);  pitch = 1024; row0 = krow0; mode = 0; }
            else if (pn < 16)  { base = QB + ((pn - 12) * 256 + colt); pitch = 1024; row0 = qrow0; mode = 1; scl = c2; }
            else if (pn == 16) { if (bj == 0) { base = KB + (32 * wc + 8 * fq); mode = ctx ? 0 : 1; } else { base = VB + (32 * wc + 8 * fq); mode = 0; } pitch = 128; row0 = krow0; }
            else if (pn < 25)  { base = GA + ((pn - 17) * 256 + colt); pitch = 2048; row0 = qrow0; mode = 2; }
            else               { base = GB + ((pn - 25) * 256 + colt); pitch = 2048; row0 = qrow0; mode = 2; }
#pragma unroll
            for (int ai = 0; ai < 2; ++ai)
#pragma unroll
                for (int m = 0; m < 4; ++m) {
                    const int row = ai * HALF + wr * 64 + m * 16 + fr;
                    f32x4 v0 = acc[ai][bj][m][0], v1 = acc[ai][bj][m][1];
                    if (mode == 1) {
                        const float pos = (wc & 1) ? (float)(16 * m + fr) : (float)((pm & 15) * 4 + 2 * ai + wr);
#pragma unroll
                        for (int i = 0; i < 4; ++i) { float rev = pos * invf[i]; rev -= floorf(rev); const float cs = __builtin_amdgcn_cosf(rev), sn = __builtin_amdgcn_sinf(rev);
                            const float x1 = v0[i], x2 = v1[i]; v0[i] = x1 * cs - x2 * sn; v1[i] = x2 * cs + x1 * sn; }
                    } else if (mode == 2) {
#pragma unroll
                        for (int i = 0; i < 4; ++i) { v0[i] = sigmoidf_fast(v0[i]); v1[i] = sigmoidf_fast(v1[i]); }
                    }
                    v0 = v0 * scl; v1 = v1 * scl;
                    *(u32x4*)(base + (size_t)(row0 + row) * pitch) = pack8(v0, v1);
                }
        }
    }
};
struct EpiGate1 {
    static constexpr bool PERM = true, AFTER_DRAIN = false;
    const bf16_t* G; float* Y1;
    __device__ __forceinline__ void operator()(const f32x4 (&acc)[2][2][4][2], const Unit& u, int wr, int wc, int fr, int fq) const {
#pragma unroll
        for (int ai = 0; ai < 2; ++ai)
#pragma unroll
            for (int m = 0; m < 4; ++m)
#pragma unroll
                for (int bj = 0; bj < 2; ++bj) {
                    const size_t off = (size_t)(u.pm * BM + ai * HALF + wr * 64 + m * 16 + fr) * 2048 + (u.pn * BM + bj * HALF + wc * 32 + 8 * fq);
                    const u32x4 g = *(const u32x4*)(G + off);
                    const f32x4 a0 = acc[ai][bj][m][0], a1 = acc[ai][bj][m][1];
                    f32x4 o0, o1; o0[0] = a0[0] * bf_lo(g.x); o0[1] = a0[1] * bf_hi(g.x); o0[2] = a0[2] * bf_lo(g.y); o0[3] = a0[3] * bf_hi(g.y);
                    o1[0] = a1[0] * bf_lo(g.z); o1[1] = a1[1] * bf_hi(g.z); o1[2] = a1[2] * bf_lo(g.w); o1[3] = a1[3] * bf_hi(g.w);
                    *(f32x4*)(Y1 + off) = o0; *(f32x4*)(Y1 + off + 4) = o1;
                }
    }
};
struct EpiGate2 {
    static constexpr bool PERM = true, AFTER_DRAIN = false;
    const bf16_t* G; const float* Y1; bf16_t* Y;
    __device__ __forceinline__ void operator()(const f32x4 (&acc)[2][2][4][2], const Unit& u, int wr, int wc, int fr, int fq) const {
#pragma unroll
        for (int ai = 0; ai < 2; ++ai)
#pragma unroll
            for (int m = 0; m < 4; ++m)
#pragma unroll
                for (int bj = 0; bj < 2; ++bj) {
                    const size_t off = (size_t)(u.pm * BM + ai * HALF + wr * 64 + m * 16 + fr) * 2048 + (u.pn * BM + bj * HALF + wc * 32 + 8 * fq);
                    const u32x4 g = *(const u32x4*)(G + off);
                    const f32x4 y0 = *(const f32x4*)(Y1 + off), y1 = *(const f32x4*)(Y1 + off + 4);
                    const f32x4 a0 = acc[ai][bj][m][0], a1 = acc[ai][bj][m][1];
                    f32x4 o0, o1; o0[0] = y0[0] + a0[0] * bf_lo(g.x); o0[1] = y0[1] + a0[1] * bf_hi(g.x); o0[2] = y0[2] + a0[2] * bf_lo(g.y); o0[3] = y0[3] + a0[3] * bf_hi(g.y);
                    o1[0] = y1[0] + a1[0] * bf_lo(g.z); o1[1] = y1[1] + a1[1] * bf_hi(g.z); o1[2] = y1[2] + a1[2] * bf_lo(g.w); o1[3] = y1[3] + a1[3] * bf_hi(g.w);
                    *(u32x4*)(Y + off) = pack8(o0, o1);
                }
    }
};
struct EpiOut {
    static constexpr bool PERM = true, AFTER_DRAIN = false;
    const float* X; const float* mod; float* R; float alpha;
    __device__ __forceinline__ void operator()(const f32x4 (&acc)[2][2][4][2], const Unit& u, int wr, int wc, int fr, int fq) const {
        const float* g1 = mod + (size_t)(u.pm >> 4) * 12288 + 4096;
#pragma unroll
        for (int bj = 0; bj < 2; ++bj) {
            const int col = u.pn * BM + bj * HALF + wc * 32 + 8 * fq;
            const f32x4 ga = *(const f32x4*)(g1 + col), gb = *(const f32x4*)(g1 + col + 4);
#pragma unroll
            for (int ai = 0; ai < 2; ++ai)
#pragma unroll
                for (int m = 0; m < 4; ++m) {
                    const size_t off = (size_t)(u.pm * BM + ai * HALF + wr * 64 + m * 16 + fr) * 2048 + col;
                    const f32x4 x0 = *(const f32x4*)(X + off), x1 = *(const f32x4*)(X + off + 4);
                    *(f32x4*)(R + off) = x0 * alpha + ga * acc[ai][bj][m][0]; *(f32x4*)(R + off + 4) = x1 * alpha + gb * acc[ai][bj][m][1];
                }
        }
    }
};
struct EpiUp {
    static constexpr bool PERM = true, AFTER_DRAIN = false;
    const float* bup; bf16_t* ACT;
    __device__ __forceinline__ void operator()(const f32x4 (&acc)[2][2][4][2], const Unit& u, int wr, int wc, int fr, int fq) const {
        const int e = u.pb >> 4, col = u.pn * 128 + wc * 32 + 8 * fq;
        const float* bg = bup + (size_t)e * 4096 + col; const float* bl = bg + 2048;
        const f32x4 bg0 = *(const f32x4*)bg, bg1 = *(const f32x4*)(bg + 4), bl0 = *(const f32x4*)bl, bl1 = *(const f32x4*)(bl + 4);
#pragma unroll
        for (int ai = 0; ai < 2; ++ai)
#pragma unroll
            for (int m = 0; m < 4; ++m) {
                const size_t off = (size_t)(u.pm * BM + ai * HALF + wr * 64 + m * 16 + fr) * 2048 + col;
                f32x4 g0 = acc[ai][0][m][0] + bg0, g1 = acc[ai][0][m][1] + bg1, l0 = acc[ai][1][m][0] + bl0, l1 = acc[ai][1][m][1] + bl1, o0, o1;
#pragma unroll
                for (int i = 0; i < 4; ++i) {
                    const float xg0 = fminf(g0[i], 7.0f), xl0 = fminf(fmaxf(l0[i], -7.0f), 7.0f); o0[i] = xg0 * sigmoidf_fast(1.702f * xg0) * (xl0 + 1.0f);
                    const float xg1 = fminf(g1[i], 7.0f), xl1 = fminf(fmaxf(l1[i], -7.0f), 7.0f); o1[i] = xg1 * sigmoidf_fast(1.702f * xg1) * (xl1 + 1.0f);
                }
                *(u32x4*)(ACT + off) = pack8(o0, o1);
            }
    }
};
struct EpiDown {
    static constexpr bool PERM = true, AFTER_DRAIN = false;
    const float* bdn; bf16_t* YS; const int* pos_slot; const float* pos_gate; const PG8_LAS int* cnt; const PG8_LAS int* pstart;
    __device__ __forceinline__ void operator()(const f32x4 (&acc)[2][2][4][2], const Unit& u, int wr, int wc, int fr, int fq) const {
        const int e = u.pb >> 3; const int lim = pstart[e] + cnt[e];
        f32x4 bv[2][2];
#pragma unroll
        for (int bj = 0; bj < 2; ++bj) { const float* bp = bdn + (size_t)e * 2048 + u.pn * BM + bj * HALF + wc * 32 + 8 * fq; bv[bj][0] = *(const f32x4*)bp; bv[bj][1] = *(const f32x4*)(bp + 4); }
#pragma unroll
        for (int ai = 0; ai < 2; ++ai)
#pragma unroll
            for (int m = 0; m < 4; ++m) {
                const int pos = u.pm * BM + ai * HALF + wr * 64 + m * 16 + fr;
                if (pos < lim) {
                    const int slot = pos_slot[pos]; const float gt = pos_gate[pos];
#pragma unroll
                    for (int bj = 0; bj < 2; ++bj) {
                        const f32x4 o0 = (acc[ai][bj][m][0] + bv[bj][0]) * gt, o1 = (acc[ai][bj][m][1] + bv[bj][1]) * gt;
                        *(u32x4*)(YS + (size_t)slot * 2048 + u.pn * BM + bj * HALF + wc * 32 + 8 * fq) = pack8(o0, o1);
                    }
                }
            }
    }
};
}
namespace attn_body {
using bf16=__hip_bfloat16;
using bf16x8=__attribute__((ext_vector_type(8)))short;
using s16x4=__attribute__((ext_vector_type(4)))short;
using f32x16=__attribute__((ext_vector_type(16)))float;
using u32x4=__attribute__((ext_vector_type(4)))unsigned;
constexpr int D=64;
constexpr int NW=8,QBLK=32,QB=QBLK*NW,KVBLK=64;
constexpr int ATTN_UNIT_ROWS=QB;
__device__ __forceinline__ int crow(int r,int hi){return (r&3)+8*(r>>2)+4*hi;}
#define SBAR() __builtin_amdgcn_sched_barrier(0)
__device__ __forceinline__ void wmask(f32x16&p0,f32x16&p1,int kpos0,int qpos,int hi){
  const float NEG=-INFINITY; const int kb=kpos0+4*hi-qpos;
  #pragma unroll
  for(int r=0;r<16;++r){const int d=kb+(r&3)+8*(r>>2); if(d>128||d<-128)p0[r]=NEG; if(d+32>128||d+32<-128)p1[r]=NEG;}
}
constexpr int NSLOT=3, SLOTB=8192;
constexpr int LDS_K=0, LDS_V=NSLOT*SLOTB, LDS_WS=2*NSLOT*SLOTB, LDS_OST=LDS_WS+NW*64*4, LDS_BYTES=LDS_OST+NW*4096;
constexpr float C2=0.125f*1.4426950408889634f;
__device__ __forceinline__ void glds16(const void*gsrc,unsigned lds_dst){unsigned keep;
  asm volatile("s_mov_b32 %0, m0\n\ts_mov_b32 m0, %2\n\ts_nop 0\n\tglobal_load_lds_dwordx4 %1, off\n\ts_mov_b32 m0, %0":"=&s"(keep):"v"(gsrc),"s"(lds_dst):"memory");}
__device__ __forceinline__ float max3f(float a,float b,float c){float r;asm("v_max3_f32 %0, %1, %2, %3":"=v"(r):"v"(a),"v"(b),"v"(c));return r;}
__device__ __forceinline__ float max2f(float a,float b){float r;asm("v_max_f32_e32 %0, %1, %2":"=v"(r):"v"(a),"v"(b));return r;}
__device__ __forceinline__ float fadd_s(float a,float b){float r;asm("v_add_f32_e32 %0, %1, %2":"=v"(r):"v"(a),"v"(b));return r;}
__device__ __forceinline__ float fsub_s(float a,float b){float r;asm("v_sub_f32_e32 %0, %1, %2":"=v"(r):"v"(a),"v"(b));return r;}
typedef float f32x2_t __attribute__((ext_vector_type(2))); typedef __bf16 bf16x2_t __attribute__((ext_vector_type(2)));
__device__ __forceinline__ unsigned cvtpk_s(float lo,float hi){f32x2_t v={lo,hi};bf16x2_t b=__builtin_convertvector(v,bf16x2_t);return __builtin_bit_cast(unsigned,b);}
#define WAIT_BAR(N) asm volatile("s_waitcnt vmcnt(" #N ") lgkmcnt(0)\n\ts_barrier":::"memory")

__device__ __forceinline__ void qkt(f32x16&p0,f32x16&p1,const char*Kslot,const bf16x8*qr,const f32x16&negm,int r32,int hi){
  const char*kb=Kslot+hi*1024+r32*16;
  #pragma unroll
  for(int d0=0;d0<4;++d0){
    const bf16x8 b0=*reinterpret_cast<const bf16x8*>(kb+d0*2048);
    const bf16x8 b1=*reinterpret_cast<const bf16x8*>(kb+d0*2048+512);
    if(d0==0){p0=__builtin_amdgcn_mfma_f32_32x32x16_bf16(b0,qr[0],negm,0,0,0);p1=__builtin_amdgcn_mfma_f32_32x32x16_bf16(b1,qr[0],negm,0,0,0);}
    else{p0=__builtin_amdgcn_mfma_f32_32x32x16_bf16(b0,qr[d0],p0,0,0,0);p1=__builtin_amdgcn_mfma_f32_32x32x16_bf16(b1,qr[d0],p1,0,0,0);}}
}
typedef __attribute__((address_space(3))) const char* lds_cptr;
typedef short v4i16_t __attribute__((ext_vector_type(4)));
__device__ __forceinline__ void kload8(bf16x8*kf,lds_cptr kp){
  kf[0]=*(const __attribute__((address_space(3))) bf16x8*)(kp);      kf[1]=*(const __attribute__((address_space(3))) bf16x8*)(kp+512);
  kf[2]=*(const __attribute__((address_space(3))) bf16x8*)(kp+2048); kf[3]=*(const __attribute__((address_space(3))) bf16x8*)(kp+2560);
  kf[4]=*(const __attribute__((address_space(3))) bf16x8*)(kp+4096); kf[5]=*(const __attribute__((address_space(3))) bf16x8*)(kp+4608);
  kf[6]=*(const __attribute__((address_space(3))) bf16x8*)(kp+6144); kf[7]=*(const __attribute__((address_space(3))) bf16x8*)(kp+6656);
}
__device__ __forceinline__ void kload2(bf16x8*kf,lds_cptr kp,int j){ kf[2*j]=*(const __attribute__((address_space(3))) bf16x8*)(kp+j*2048); kf[2*j+1]=*(const __attribute__((address_space(3))) bf16x8*)(kp+j*2048+512); }
__device__ __forceinline__ s16x4 vtr(lds_cptr p){ return __builtin_bit_cast(s16x4,__builtin_amdgcn_ds_read_tr16_b64_v4i16((__attribute__((address_space(3))) v4i16_t*)p)); }
__device__ __forceinline__ float rowmax(const f32x16&p0,const f32x16&p1){
  float a=max3f(p0[0],p0[1],p1[0]),b=max3f(p0[2],p0[3],p1[1]);a=max3f(a,p1[2],p1[3]);
  #pragma unroll
  for(int r=4;r<16;r+=4){a=max3f(a,p0[r],p0[r+1]);b=max3f(b,p0[r+2],p0[r+3]);a=max3f(a,p1[r],p1[r+1]);b=max3f(b,p1[r+2],p1[r+3]);}
  const float m=max2f(a,b);
  auto rr=__builtin_amdgcn_permlane32_swap(__float_as_uint(m),__float_as_uint(m),false,false);
  return max2f(__uint_as_float(rr[0]),__uint_as_float(rr[1]));
}
__device__ __forceinline__ void pv(f32x16*o,int vb,bf16x8 pa0,bf16x8 pa1,bf16x8 pa2,bf16x8 pa3){
  #pragma unroll
  for(int d0=0;d0<2;++d0){s16x4 lo[4],hi[4];
    #pragma unroll
    for(int ks=0;ks<4;++ks){
      asm volatile("ds_read_b64_tr_b16 %0,%1 offset:%c2":"=&v"(lo[ks]):"v"(vb),"i"(d0*4096+ks*1024):"memory");
      asm volatile("ds_read_b64_tr_b16 %0,%1 offset:%c2":"=&v"(hi[ks]):"v"(vb),"i"(d0*4096+ks*1024+512):"memory");}
    asm volatile("s_waitcnt lgkmcnt(0)":::"memory");SBAR();
    #define PK(k) (bf16x8){lo[k][0],lo[k][1],lo[k][2],lo[k][3],hi[k][0],hi[k][1],hi[k][2],hi[k][3]}
    o[d0]=__builtin_amdgcn_mfma_f32_32x32x16_bf16(pa0,PK(0),o[d0],0,0,0);
    o[d0]=__builtin_amdgcn_mfma_f32_32x32x16_bf16(pa1,PK(1),o[d0],0,0,0);
    o[d0]=__builtin_amdgcn_mfma_f32_32x32x16_bf16(pa2,PK(2),o[d0],0,0,0);
    o[d0]=__builtin_amdgcn_mfma_f32_32x32x16_bf16(pa3,PK(3),o[d0],0,0,0);
    #undef PK
  }
}

#ifndef ATTN_STORE16
#define ATTN_STORE16(p,v) (*(u32x4*)(p)=(v))
#endif
struct AttnArgs { const bf16* Qw0; const bf16* Kh; const bf16* Vh; bf16* Ow0; int NT; int win0; int qpos0; float sinkl2; };
template<class C,int THRL> __device__ __forceinline__ void attn_unit(const AttnArgs& aa,char*shm){
  int tid_=threadIdx.x; asm volatile("":"+v"(tid_)); const int tid=tid_,lane=tid&63,r32=lane&31,hi=lane>>5; const int wid=__builtin_amdgcn_readfirstlane(tid>>6);
  const bf16*Qw=aa.Qw0+(long)(wid*QBLK)*C::QP;
  const bf16*Kh=aa.Kh,*Vh=aa.Vh; const int win0=aa.win0;
  const unsigned lds0=(unsigned)(uintptr_t)shm;
  float*wsf=(float*)(shm+LDS_WS)+wid*64;
  const bf16*ksrc=Kh+(long)lane*C::KP+wid*8;
  const bf16*vsrc=Vh+(long)(16*(wid&3)+(lane>>2))*C::VP+(wid>>2)*32+(lane&3)*8;
  const unsigned kdst=lds0+LDS_K+wid*1024, vdst=lds0+LDS_V+wid*1024;
  #define KROW(t) (C::MASK ? ((t)<4 ? 4096+64*(t) : win0+64*((t)-4)) : 64*(t))
  #define DMA_K(t,slot) glds16(ksrc+(long)KROW(t)*C::KP,(unsigned)__builtin_amdgcn_readfirstlane(kdst+(slot)))
  #define DMA_V(t,slot) glds16(vsrc+(long)KROW(t)*C::VP,(unsigned)__builtin_amdgcn_readfirstlane(vdst+(slot)))
  const int vb0=(int)(lds0+LDS_V)+((lane>>4)&1)*32+(lane&3)*8+(4*hi+((lane&15)>>2))*64;
  const char*Kbase=shm+LDS_K; bf16x8 kf[8];
  const lds_cptr shm3=(lds_cptr)shm; const lds_cptr kp0=shm3+LDS_K+hi*1024+r32*16; const lds_cptr vp0=shm3+LDS_V+((lane>>4)&1)*32+(lane&3)*8+(4*hi+((lane&15)>>2))*64;
  const int NT=aa.NT;
  DMA_K(0,0);DMA_V(0,0);DMA_K(1,SLOTB);
  bf16x8 qr[4];
  #pragma unroll
  for(int d0=0;d0<4;++d0)qr[d0]=*reinterpret_cast<const bf16x8*>(&Qw[(long)r32*C::QP+d0*16+hi*8]);
  float mhat=0.f,l_reg=0.f;f32x16 o[2];o[0]=f32x16{};o[1]=f32x16{};f32x16 negm=f32x16{};asm volatile("":"+v"(negm));
  const int qpos=aa.qpos0+wid*QBLK+r32;
  #define CMASK(P0,P1,t) do{ if(C::MASK){ if((t)>=4) wmask(P0,P1,win0+64*((t)-4),qpos,hi); } }while(0)
  bool resc=false;
  #define START(P0,P1) do{ const float rm=rowmax(P0,P1); resc=false; \
    { const float dl=rm; mhat=fadd_s(mhat,dl); \
      _Pragma("unroll") for(int r=0;r<16;++r){P0[r]=fsub_s(P0[r],dl);P1[r]=fsub_s(P1[r],dl);} \
      _Pragma("unroll") for(int r=0;r<16;++r)negm[r]=-mhat; asm volatile("":"+v"(negm)); } \
    _Pragma("unroll") for(int r=0;r<16;++r)P0[r]=__builtin_amdgcn_exp2f(P0[r]); }while(0)
  #define RESC() do{ if(resc){ asm volatile("s_waitcnt lgkmcnt(0)":::"memory"); \
      _Pragma("unroll") for(int d_=0;d_<2;++d_) _Pragma("unroll") for(int r=0;r<16;++r)o[d_][r]*=wsf[crow(r,hi)]; } }while(0)
  f32x16 pA0,pA1,pB0,pB1;
  int sl_prev=0,sl_cur=0,sl_next=SLOTB;
  #define ROT() do{sl_prev=sl_cur;sl_cur=sl_next;sl_next=(sl_next==(NSLOT-1)*SLOTB)?0:sl_next+SLOTB;}while(0)
  DMA_K(2,2*SLOTB);
  WAIT_BAR(3);
  qkt(pA0,pA1,Kbase,qr,negm,r32,hi);asm volatile("s_nop 15\n\ts_nop 7":"+v"(pA0),"+v"(pA1));CMASK(pA0,pA1,0);
  START(pA0,pA1);
  _Pragma("unroll") for(int r=0;r<16;++r)pA1[r]=__builtin_amdgcn_exp2f(pA1[r]);
  WAIT_BAR(0);
  DMA_K(3,0);DMA_V(1,SLOTB);
  ROT();
  kload8(kf,kp0+sl_cur);
  WAIT_BAR(2);
  s16x4 vlo[8],vhi[8]; u32x4 pw0,pw1,pw2,pw3;
  #define PKW(P,B) cvtpk_s(P[B],P[B+1])
  #define PAF(k) __builtin_bit_cast(bf16x8,pw##k)
  #define VFR(i) (bf16x8){vlo[i][0],vlo[i][1],vlo[i][2],vlo[i][3],vhi[i][0],vhi[i][1],vhi[i][2],vhi[i][3]}
  #define PIN(x) asm volatile("":"+v"(x))
  #define MX3(a,b,c) __builtin_fmaxf(__builtin_fmaxf((a),(b)),(c))
  #define GAPA(MF,A0,A1,A2,A3,W0,W1,PW) do{ MF; sacc+=A0; sacc+=A1; sacc+=A2; sacc+=A3; PIN(sacc); W0; W1; PIN(PW); SBAR(); }while(0)
  #define EX(v) __builtin_amdgcn_exp2f(v)
  #define GAPB(MF,X,B) do{ MF; X[B]=EX(X[B]); X[B+1]=EX(X[B+1]); X[B+2]=EX(X[B+2]); X[B+3]=EX(X[B+3]); PIN(X); SBAR(); }while(0)
  #define VRD(i) do{ vlo[i]=vtr(vp_+(((i)>>2)*4096+((i)&3)*1024)); vhi[i]=vtr(vp_+(((i)>>2)*4096+((i)&3)*1024+512)); }while(0)
  #define KRD(G,j) do{ if(G){ kload2(kf,kp0+sl_next,j); SBAR(); } }while(0)
  #define STEP(C0,C1,P0,P1,t,GK,GV,GL) do{ SBAR(); \
    const lds_cptr vp_=vp0+sl_prev; \
    VRD(0); SBAR(); float sacc=(P0[0]+P0[1]); \
    GAPA(C0=__builtin_amdgcn_mfma_f32_32x32x16_bf16(kf[0],qr[0],negm,0,0,0), P0[2],P0[3],P0[4],P0[5],     pw0[0]=PKW(P0,0), pw0[1]=PKW(P0,2), pw0); \
    VRD(4); SBAR(); GAPA(C1=__builtin_amdgcn_mfma_f32_32x32x16_bf16(kf[1],qr[0],negm,0,0,0), P0[6],P0[7],P0[8],P0[9],     pw0[2]=PKW(P0,4), pw0[3]=PKW(P0,6), pw0); \
    VRD(1); SBAR(); GAPA(C0=__builtin_amdgcn_mfma_f32_32x32x16_bf16(kf[2],qr[1],C0,0,0,0),   P0[10],P0[11],P0[12],P0[13], pw1[0]=PKW(P0,8), pw1[1]=PKW(P0,10), pw1); \
    VRD(5); SBAR(); GAPA(C1=__builtin_amdgcn_mfma_f32_32x32x16_bf16(kf[3],qr[1],C1,0,0,0),   P0[14],P0[15],P1[0],P1[1],   pw1[2]=PKW(P0,12),pw1[3]=PKW(P0,14), pw1); \
    VRD(2); SBAR(); GAPA(C0=__builtin_amdgcn_mfma_f32_32x32x16_bf16(kf[4],qr[2],C0,0,0,0),   P1[2],P1[3],P1[4],P1[5],     pw2[0]=PKW(P1,0), pw2[1]=PKW(P1,2), pw2); \
    VRD(6); SBAR(); GAPA(C1=__builtin_amdgcn_mfma_f32_32x32x16_bf16(kf[5],qr[2],C1,0,0,0),   P1[6],P1[7],P1[8],P1[9],     pw2[2]=PKW(P1,4), pw2[3]=PKW(P1,6), pw2); \
    VRD(3); SBAR(); GAPA(C0=__builtin_amdgcn_mfma_f32_32x32x16_bf16(kf[6],qr[3],C0,0,0,0),   P1[10],P1[11],P1[12],P1[13], pw3[0]=PKW(P1,8), pw3[1]=PKW(P1,10), pw3); \
    VRD(7); SBAR(); GAPA(C1=__builtin_amdgcn_mfma_f32_32x32x16_bf16(kf[7],qr[3],C1,0,0,0),   P1[14],P1[15],0.f,0.f,       pw3[2]=PKW(P1,12),pw3[3]=PKW(P1,14), pw3); \
    l_reg+=sacc; \
    if(GK){DMA_K((t)+3,sl_cur);} if(GV){DMA_V((t)+1,sl_next);} \
    CMASK(C0,C1,t); \
    { float a=MX3(C0[0],C0[1],C1[0]),b=MX3(C0[2],C0[3],C1[1]); a=MX3(a,C1[2],C1[3]); \
      _Pragma("unroll") for(int r=4;r<16;r+=4){a=MX3(a,C0[r],C0[r+1]);b=MX3(b,C0[r+2],C0[r+3]);a=MX3(a,C1[r],C1[r+1]);b=MX3(b,C1[r+2],C1[r+3]);} \
      float rm=__builtin_fmaxf(a,b); { auto rr=__builtin_amdgcn_permlane32_swap(__float_as_uint(rm),__float_as_uint(rm),false,false); rm=__builtin_fmaxf(__uint_as_float(rr[0]),__uint_as_float(rr[1])); } \
      resc=false; \
      if(__builtin_expect(__any(rm>(float)THRL),0)){ const float dl=__builtin_fmaxf(rm,0.f); mhat+=dl; \
        _Pragma("unroll") for(int r=0;r<16;++r){C0[r]-=dl;C1[r]-=dl;} \
        _Pragma("unroll") for(int r=0;r<16;++r)negm[r]=-mhat; asm volatile("":"+v"(negm)); \
        const float f=__builtin_amdgcn_exp2f(-dl); l_reg*=f; if(hi==0)wsf[r32]=f; resc=true; } } \
    SBAR(); \
    GAPB(o[0]=__builtin_amdgcn_mfma_f32_32x32x16_bf16(PAF(0),VFR(0),o[0],0,0,0), C0,0); \
    GAPB(o[1]=__builtin_amdgcn_mfma_f32_32x32x16_bf16(PAF(0),VFR(4),o[1],0,0,0), C0,4); \
    KRD(GL,0); GAPB(o[0]=__builtin_amdgcn_mfma_f32_32x32x16_bf16(PAF(1),VFR(1),o[0],0,0,0), C0,8); \
    KRD(GL,1); GAPB(o[1]=__builtin_amdgcn_mfma_f32_32x32x16_bf16(PAF(1),VFR(5),o[1],0,0,0), C0,12); \
    KRD(GL,2); GAPB(o[0]=__builtin_amdgcn_mfma_f32_32x32x16_bf16(PAF(2),VFR(2),o[0],0,0,0), C1,0); \
    KRD(GL,3); GAPB(o[1]=__builtin_amdgcn_mfma_f32_32x32x16_bf16(PAF(2),VFR(6),o[1],0,0,0), C1,4); \
    GAPB(o[0]=__builtin_amdgcn_mfma_f32_32x32x16_bf16(PAF(3),VFR(3),o[0],0,0,0), C1,8); \
    GAPB(o[1]=__builtin_amdgcn_mfma_f32_32x32x16_bf16(PAF(3),VFR(7),o[1],0,0,0), C1,12); \
    }while(0)
  int t=1;
  #undef CMASK
  #define CMASK(P0,P1,t) do{ if(C::MASK){ if((t)>=4) wmask(P0,P1,win0+64*((t)-4),qpos,hi); } }while(0)
  for(;t+5<NT;t+=2){
    STEP(pB0,pB1,pA0,pA1,t,true,true,true);     WAIT_BAR(2); RESC(); ROT();
    STEP(pA0,pA1,pB0,pB1,t+1,true,true,true);   WAIT_BAR(2); RESC(); ROT();
  }
  #undef CMASK
  #define CMASK(P0,P1,t) do{ if(C::MASK){ if((t)>=4) wmask(P0,P1,win0+64*((t)-4),qpos,hi); } }while(0)
  #define ENDW(tt) do{ if((tt)+3<NT){WAIT_BAR(2);} else if((tt)+2<NT){WAIT_BAR(1);} else {WAIT_BAR(0);} }while(0)
  for(;t+1<NT;t+=2){
    STEP(pB0,pB1,pA0,pA1,t,(t+3<NT),(t+1<NT),(t+1<NT));       ENDW(t);   RESC(); ROT();
    STEP(pA0,pA1,pB0,pB1,t+1,(t+4<NT),(t+2<NT),(t+2<NT));     ENDW(t+1); RESC(); ROT();
  }
  STEP(pB0,pB1,pA0,pA1,NT-1,false,false,false); RESC();
  { float sacc=pB0[0]+pB0[1]; _Pragma("unroll") for(int r=2;r<16;++r)sacc+=pB0[r]; _Pragma("unroll") for(int r=0;r<16;++r)sacc+=pB1[r]; l_reg+=sacc;
    pw0=(u32x4){PKW(pB0,0),PKW(pB0,2),PKW(pB0,4),PKW(pB0,6)};pw1=(u32x4){PKW(pB0,8),PKW(pB0,10),PKW(pB0,12),PKW(pB0,14)};pw2=(u32x4){PKW(pB1,0),PKW(pB1,2),PKW(pB1,4),PKW(pB1,6)};pw3=(u32x4){PKW(pB1,8),PKW(pB1,10),PKW(pB1,12),PKW(pB1,14)};
    SBAR(); pv(o,vb0+sl_cur,PAF(0),PAF(1),PAF(2),PAF(3)); }
  #undef PKW
  #undef PAF
  #undef VFR
  #undef PIN
  #undef MX3
  #undef GAPA
  #undef GAPB
  #undef EX
  #undef VRD
  #undef KRD
  #undef STEP
  #undef ENDW
  {auto rr=__builtin_amdgcn_permlane32_swap(__float_as_uint(l_reg),__float_as_uint(l_reg),false,false);l_reg=__uint_as_float(rr[0])+__uint_as_float(rr[1]);}
  if(C::MASK) l_reg+=__builtin_amdgcn_exp2f(aa.sinkl2-mhat);
  if(hi==0)wsf[32+r32]=l_reg;asm volatile("s_waitcnt lgkmcnt(0)":::"memory");
  float rli[16];
  #pragma unroll
  for(int r=0;r<16;++r)rli[r]=__builtin_amdgcn_rcpf(wsf[32+crow(r,hi)]);
  bf16*Ow=aa.Ow0+(long)(wid*QBLK)*C::OP;
  { bf16*stg=(bf16*)(shm+LDS_OST)+wid*2048;
    #pragma unroll
    for(int r=0;r<16;++r){const int orow=crow(r,hi);
      #pragma unroll
      for(int d0=0;d0<2;++d0)stg[orow*64+d0*32+r32]=__float2bfloat16(o[d0][r]*rli[r]);}
    asm volatile("s_waitcnt lgkmcnt(0)":::"memory");
    #pragma unroll
    for(int i=0;i<4;++i){const int row=i*8+(lane>>3),ch=lane&7; const u32x4 v=*(const u32x4*)(stg+row*64+ch*8); ATTN_STORE16(Ow+(long)row*C::OP+ch*8,v);} }
  asm volatile("s_waitcnt lgkmcnt(0)\n\ts_barrier":::"memory");
  #undef DMA_K
  #undef KROW
  #undef DMA_V
  #undef CMASK
  #undef START
  #undef RESC
  #undef ROT
}
constexpr int ATTN_LDS_BYTES=LDS_BYTES;
#undef SBAR
#undef WAIT_BAR
}
constexpr int NWAVES = 8;
constexpr int DM = 2048, NBATCH = 4, SEQ = 4096, CTXL = 256;
constexpr int MT = NBATCH * SEQ, MC = NBATCH * CTXL, MH = MT + MC;
constexpr int KVR = SEQ + CTXL;
constexpr int PROJ = 8448, NE = 32, TOPK = 4;
constexpr int NASSIGN = MT * TOPK;
constexpr int MAXMT = NASSIGN / 256 + NE;
constexpr float LN_EPS = 1e-5f;
constexpr float DN_ALPHA = 1.189207115002721f;
constexpr float LAM_INIT = 0.2f;
constexpr int MODW = 6 * DM;

constexpr size_t MiB = 1u << 20;
constexpr size_t WS_CTL = 0, CTL_ZERO_BYTES = 1 * MiB;
constexpr size_t WS_MODP = 1 * MiB;
constexpr size_t WS_MOD = 2 * MiB;
constexpr size_t WS_TKE = 3 * MiB;
constexpr size_t WS_TKG = WS_TKE + 256 * 1024, WS_TKR = WS_TKG + 256 * 1024;
constexpr size_t WS_PSLOT = 4 * MiB, WS_PGATE = 5 * MiB;
constexpr size_t WS_WIN = 8 * MiB;
constexpr size_t WS_WOA = 42 * MiB, WS_WOB = 46 * MiB, WS_WOUT = 50 * MiB;
constexpr size_t WS_WUP = 64 * MiB;
constexpr size_t WS_WDN = 576 * MiB;
constexpr size_t WS_H = 832 * MiB;
constexpr size_t WS_QA = 900 * MiB, WS_KA = 932 * MiB, WS_VA = 966 * MiB, WS_QB = 1000 * MiB, WS_KB = 1032 * MiB, WS_VB = 1037 * MiB;
constexpr size_t WS_GA = 1042 * MiB, WS_GB = 1106 * MiB, WS_O4 = 1170 * MiB, WS_OA = 1234 * MiB, WS_OB = 1266 * MiB;
constexpr size_t WS_Y1 = 1298 * MiB, WS_Y = 1426 * MiB, WS_R = 1490 * MiB, WS_X1 = 1618 * MiB, WS_HM = 1746 * MiB;
constexpr size_t WS_XG = 1810 * MiB, WS_ACT = 2098 * MiB, WS_YS = 2386 * MiB, WS_END = 2642 * MiB;
constexpr int CW_BAR = 4096;
constexpr int CW_CNT = 8192;

constexpr int RING_OFF = 0, RING_BYTES = 131072;
constexpr int LDSCTL_OFF = RING_BYTES, MISC_OFF = LDSCTL_OFF + 320;
constexpr int TBL_OFF = LDSCTL_OFF + 1024;
constexpr int LDS_BYTES = 147456;
#define GAS __attribute__((address_space(1)))
#define LAS __attribute__((address_space(3)))
typedef unsigned short bf16;
typedef unsigned v4u __attribute__((ext_vector_type(4)));
typedef float f32x4 __attribute__((ext_vector_type(4)));
typedef short bf16x8 __attribute__((ext_vector_type(8)));
typedef GAS unsigned gu32;
typedef GAS unsigned long long gu64;
#define RLX_AGENT __ATOMIC_RELAXED, __HIP_MEMORY_SCOPE_AGENT
#define LDS_WAIT() asm volatile("s_waitcnt lgkmcnt(0)" ::: "memory")
#define VM_WAIT() asm volatile("s_waitcnt vmcnt(0)" ::: "memory")
__device__ __forceinline__ unsigned long long rt() { return __builtin_amdgcn_s_memrealtime(); }
__device__ __forceinline__ unsigned f2bf(float f) { unsigned u = __builtin_bit_cast(unsigned, f); return (u + 0x7fffu + ((u >> 16) & 1u)) >> 16; }
__device__ __forceinline__ unsigned pk2(float lo, float hi) { return f2bf(lo) | (f2bf(hi) << 16); }

#define XB_TMO      128
#define XB_XCNT(j)  (256  + 64 * (j))
#define XB_XSUB(j)  (1280 + 64 * (j))
#define XB_XGEN(j)  (2304 + 64 * (j))
#define XB_TOP      3328
#define XB_TOPGEN   3392
#define XCD_BAR_WORDS 3456
#define XB_SPIN_CAP (1u << 18)

__device__ __forceinline__ unsigned xb_ld(unsigned* p)              { return __hip_atomic_load(p, __ATOMIC_RELAXED, __HIP_MEMORY_SCOPE_AGENT); }
__device__ __forceinline__ unsigned xb_add(unsigned* p, unsigned v) { return __hip_atomic_fetch_add(p, v, __ATOMIC_RELAXED, __HIP_MEMORY_SCOPE_AGENT); }
__device__ __forceinline__ unsigned xb_xcc_id() { return (unsigned)__builtin_amdgcn_s_getreg((3 << 11) | 20) & 0xFu; }
#define XB_SPIN(cond, bar) do { unsigned _sp = 0; while (cond) { __builtin_amdgcn_s_sleep(1); \
    if ((++_sp & 255u) == 0u) { if (xb_ld(&(bar)[XB_TMO])) break; if (_sp > XB_SPIN_CAP) { atomicAdd(&(bar)[XB_TMO], 1u); break; } } } } while (0)

struct XcdBarrier {
    unsigned* bar; unsigned x;
    volatile LAS unsigned* st;
};

__device__ __forceinline__ XcdBarrier xcd_barrier_post(unsigned* bar, volatile LAS unsigned* st) {
    XcdBarrier b; b.bar = bar; b.x = xb_xcc_id(); b.st = st;
    if (threadIdx.x == 0) (void)xb_add(&bar[XB_XCNT(b.x)], 1u);
    return b;
}
__device__ __forceinline__ void xcd_barrier_complete(unsigned* bar, unsigned x, unsigned& nloc, unsigned& nx) {
    const unsigned G = gridDim.x * gridDim.y * gridDim.z;
    unsigned sum, cnt, mine, sp = 0u;
    for (;;) {
        sum = 0u; cnt = 0u; mine = 0u;
#pragma unroll
        for (unsigned j = 0; j < 16; ++j) { const unsigned c = xb_ld(&bar[XB_XCNT(j)]); sum += c; cnt += (c > 0u) ? 1u : 0u; mine = (j == x) ? c : mine; }
        if (sum == G) break;
        __builtin_amdgcn_s_sleep(1);
        if ((++sp & 255u) == 0u) { if (xb_ld(&bar[XB_TMO])) break; if (sp > XB_SPIN_CAP) { atomicAdd(&bar[XB_TMO], 1u); break; } }
    }
    nloc = mine > 0u ? mine : 1u; nx = cnt > 0u ? cnt : 1u;
}

__device__ __forceinline__ void xcd_barrier(const XcdBarrier& b) {
    asm volatile("s_waitcnt vmcnt(0)" ::: "memory");
    __syncthreads();
    if (threadIdx.x == 0) {
        unsigned* bar = b.bar;
        __builtin_amdgcn_s_waitcnt(0);
        unsigned nloc = b.st[0], nx = b.st[1];
        if (nloc == 0u) { xcd_barrier_complete(bar, b.x, nloc, nx); b.st[0] = nloc; b.st[1] = nx; }
        const unsigned old = xb_add(&bar[XB_XSUB(b.x)], 1u);
        const unsigned gen = old / nloc;
        if (old + 1u == (gen + 1u) * nloc) {
            __builtin_amdgcn_fence(__ATOMIC_RELEASE, "agent");
            asm volatile("s_waitcnt vmcnt(0)" ::: "memory");
            const unsigned og = xb_add(&bar[XB_TOP], 1u);
            const unsigned tg = og / nx;
            if (og + 1u == (tg + 1u) * nx) xb_add(&bar[XB_TOPGEN], 1u);
            else XB_SPIN(xb_ld(&bar[XB_TOPGEN]) == tg, bar);
            __builtin_amdgcn_fence(__ATOMIC_ACQUIRE, "agent");
            xb_add(&bar[XB_XGEN(b.x)], 1u);
            asm volatile("s_waitcnt vmcnt(0)" ::: "memory");
        } else {
            XB_SPIN(xb_ld(&bar[XB_XGEN(b.x)]) == gen, bar);
            __builtin_amdgcn_fence(__ATOMIC_ACQUIRE, "agent");
            asm volatile("s_waitcnt vmcnt(0)" ::: "memory");
        }
    }
    __syncthreads();
}
struct Frame {
    LAS unsigned char* lds;
    volatile LAS unsigned* MISC;
    gu32* ctl;
    int tid, lane, wave;
    int vcu, G;
    float* out;
    unsigned char* ws;
};
typedef float f32x2 __attribute__((ext_vector_type(2)));
typedef unsigned u32x2 __attribute__((ext_vector_type(2)));
__device__ __forceinline__ float wave_sum(float v) {
#pragma unroll
    for (int o = 1; o < 64; o <<= 1) v += __shfl_xor(v, o);
    return v;
}

template <int MODE> __device__ __forceinline__ int conv_rowmap(int n) {
    if (MODE == 1) {
        const bool rot = (n < 2048) || (n >= 3072 && n < 4224);
        if (!rot) return n;
        const int d = n & 63, g = 4 * (d >> 5) + ((d & 15) >> 2), j = 4 * ((d >> 4) & 1) + (d & 3);
        return (n & ~63) + 8 * g + j;
    }
    if (MODE == 2) { const int lin = n >= 2048 ? 1 : 0, m = n - 2048 * lin; return 256 * (m >> 7) + 128 * lin + (m & 127); }
    return n;
}
template <int MODE> __device__ __forceinline__ void conv_item(const float* W, int K, int N, bf16* WT, LAS float* scr, int item, int lane) {
    const int nblk = N / 32, kb = item / nblk, nb = item % nblk, k0 = 64 * kb, n0 = 32 * nb;
#pragma unroll 8
    for (int i = 0; i < 32; ++i) { const int kk = 2 * i + (lane >> 5); scr[kk * 33 + (lane & 31)] = W[(size_t)(k0 + kk) * N + n0 + (lane & 31)]; }
    LDS_WAIT(); asm volatile("" ::: "memory");
    const int c = lane & 7;
#pragma unroll
    for (int j = 0; j < 4; ++j) { const int n = (lane >> 3) + 8 * j; const LAS float* s = scr + (8 * c) * 33 + n;
        v4u o; o.x = pk2(s[0 * 33], s[1 * 33]); o.y = pk2(s[2 * 33], s[3 * 33]); o.z = pk2(s[4 * 33], s[5 * 33]); o.w = pk2(s[6 * 33], s[7 * 33]);
        *(GAS v4u*)(WT + (size_t)conv_rowmap<MODE>(n0 + n) * K + k0 + 8 * c) = o; }
    LDS_WAIT(); asm volatile("" ::: "memory");
}

__device__ __forceinline__ void p0_phase(Frame& F, const float* c, const float* cc, const float* wada, const float* win, const float* woa, const float* wob, const float* wout) {
    float* MODP = (float*)(F.ws + WS_MODP);
    if (blockIdx.x < 192) {
        const int chunk = blockIdx.x % 48, kg = blockIdx.x / 48;
        LAS float* s = (LAS float*)(F.lds);
        LAS float* red = (LAS float*)(F.lds + 40960);
        for (int i = F.tid; i < 5 * 2048; i += NWAVES * 64) { const int b = i >> 11, k = i & 2047; const float v = b < 4 ? c[b * 2048 + k] : cc[k]; s[i] = v / (1.0f + __expf(-v)); }
        __syncthreads();
        const float* W = wada + (size_t)(kg * 512 + F.wave * 64) * MODW + chunk * 256 + 4 * F.lane;
        const LAS float* sk = s + kg * 512 + F.wave * 64;
        f32x4 acc[5];
#pragma unroll
        for (int b = 0; b < 5; ++b) acc[b] = (f32x4){0.f, 0.f, 0.f, 0.f};
#pragma unroll 8
        for (int k = 0; k < 64; ++k) { const f32x4 w = *(const GAS f32x4*)(W + (size_t)k * MODW);
#pragma unroll
            for (int b = 0; b < 5; ++b) acc[b] += w * sk[b * 2048 + k]; }
#pragma unroll
        for (int b = 0; b < 5; ++b) *(LAS f32x4*)(red + (F.wave * 5 + b) * 256 + 4 * F.lane) = acc[b];
        __syncthreads();
        for (int i = F.tid; i < 1280; i += NWAVES * 64) { const int b = i >> 8, ci = i & 255; float t = 0.f;
#pragma unroll
            for (int w = 0; w < 8; ++w) t += red[(w * 5 + b) * 256 + ci];
            MODP[(size_t)(kg * 5 + b) * MODW + chunk * 256 + ci] = t; }
        __syncthreads();
    }
    LAS float* scr = (LAS float*)(F.lds + RING_OFF + F.wave * 16384);
    const int gw = F.vcu * NWAVES + F.wave, NGW = F.G * NWAVES;
    constexpr int I_IN = (DM / 64) * (PROJ / 32), I_OA = (1024 / 64) * (DM / 32), I_OUT = (DM / 64) * (DM / 32);
    for (int it = gw; it < I_IN + 2 * I_OA + I_OUT; it += NGW) {
        int r = it;
        if (r < I_IN) { conv_item<1>(win, DM, PROJ, (bf16*)(F.ws + WS_WIN), scr, r, F.lane); continue; } r -= I_IN;
        if (r < I_OA) { conv_item<0>(woa, 1024, DM, (bf16*)(F.ws + WS_WOA), scr, r, F.lane); continue; } r -= I_OA;
        if (r < I_OA) { conv_item<0>(wob, 1024, DM, (bf16*)(F.ws + WS_WOB), scr, r, F.lane); continue; } r -= I_OA;
        conv_item<0>(wout, DM, DM, (bf16*)(F.ws + WS_WOUT), scr, r, F.lane);
    }
}
__device__ __forceinline__ void p1_phase(Frame& F, const float* bada, const float* wup, const float* wdn) {
    const float* MODP = (const float*)(F.ws + WS_MODP); float* MOD = (float*)(F.ws + WS_MOD);
    for (int i = blockIdx.x * (NWAVES * 64) + F.tid; i < 5 * MODW; i += F.G * NWAVES * 64) { const int n = i % MODW;
        MOD[i] = bada[n] + ((MODP[i] + MODP[i + 5 * MODW]) + (MODP[i + 10 * MODW] + MODP[i + 15 * MODW])); }
    LAS float* scr = (LAS float*)(F.lds + RING_OFF + F.wave * 16384);
    const int gw = F.vcu * NWAVES + F.wave, NGW = F.G * NWAVES;
    constexpr int I_UP = (DM / 64) * (4096 / 32), I_DN = (DM / 64) * (DM / 32);
    for (int it = gw; it < NE * (I_UP + I_DN); it += NGW) {
        if (it < NE * I_UP) { const int e = it / I_UP, r = it % I_UP; conv_item<2>(wup + (size_t)e * DM * 4096, DM, 4096, (bf16*)(F.ws + WS_WUP) + (size_t)e * 4096 * DM, scr, r, F.lane); }
        else { const int q = it - NE * I_UP, e = q / I_DN, r = q % I_DN; conv_item<0>(wdn + (size_t)e * DM * DM, DM, DM, (bf16*)(F.ws + WS_WDN) + (size_t)e * DM * DM, scr, r, F.lane); }
    }
}
__device__ __forceinline__ void p2_phase(Frame& F, const float* x, const float* ctx) {
    const float* MOD = (const float*)(F.ws + WS_MOD); bf16* H = (bf16*)(F.ws + WS_H);
    const int gw = F.vcu * NWAVES + F.wave, NGW = F.G * NWAVES;
    for (int m = gw; m < MH; m += NGW) {
        const float* xr; int b; if (m < MT) { xr = x + (size_t)m * DM; b = m >> 12; } else { xr = ctx + (size_t)(m - MT) * DM; b = 4; }
        const GAS f32x4* x4 = (const GAS f32x4*)xr + F.lane; const GAS f32x4* sh4 = (const GAS f32x4*)(MOD + (size_t)b * MODW) + F.lane; const GAS f32x4* sc4 = sh4 + 512;
        GAS u32x2* o8 = (GAS u32x2*)(H + (size_t)m * DM) + F.lane;
#pragma unroll
        for (int j = 0; j < 8; ++j) { const f32x4 v = x4[64 * j], s = sc4[64 * j], h = sh4[64 * j]; const f32x4 o = v * (s + 1.0f) + h;
            u32x2 w; w.x = pk2(o[0], o[1]); w.y = pk2(o[2], o[3]); o8[64 * j] = w; }
    }
}
struct CfgA { static constexpr int QP = 1024, KP = 1024, VP = 1024, OP = 2048; static constexpr bool MASK = false; };
struct CfgB { static constexpr int QP = 1024, KP = 128, VP = 128, OP = 1024; static constexpr bool MASK = true; };
__device__ __forceinline__ void p4_phase(Frame& F, char* lds_generic, const float* lq1, const float* lk1, const float* lq2, const float* lk2, const float* subw, const float* sinks) {
    using abf = attn_body::bf16;
    const abf* QA = (const abf*)(F.ws + WS_QA); const abf* KA = (const abf*)(F.ws + WS_KA); const abf* VA = (const abf*)(F.ws + WS_VA);
    const abf* QB = (const abf*)(F.ws + WS_QB); const abf* KB = (const abf*)(F.ws + WS_KB); const abf* VB = (const abf*)(F.ws + WS_VB);
    abf* O4 = (abf*)(F.ws + WS_O4); bf16* OA = (bf16*)(F.ws + WS_OA); abf* OB = (abf*)(F.ws + WS_OB);
    for (int su = F.vcu; su < 512; su += F.G) {
        const int b = su >> 7, h = (su >> 4) & 7, qb = su & 15; const size_t qrow = (size_t)b * SEQ + qb * 256, krow = (size_t)b * KVR;
        for (int sub = 0; sub < 4; ++sub) {
            const int j = sub >> 1, c = sub & 1;
            attn_body::AttnArgs aa; aa.Qw0 = QA + qrow * 1024 + (2 * h + j) * 64; aa.Kh = KA + krow * 1024 + (2 * h + j) * 64; aa.Vh = VA + krow * 1024 + h * 128 + 64 * c;
            aa.Ow0 = O4 + qrow * 2048 + ((h * 2 + j) * 2 + c) * 64; aa.NT = KVR / 64; aa.win0 = 0; aa.qpos0 = 0; aa.sinkl2 = 0.f;
            attn_body::attn_unit<CfgA, 8>(aa, lds_generic);
        }
        VM_WAIT();
        float lam; { const float a1 = lq1[F.lane] * lk1[F.lane], a2 = lq2[F.lane] * lk2[F.lane]; lam = __expf(wave_sum(a1)) - __expf(wave_sum(a2)) + LAM_INIT; }
        const size_t r = qrow + F.wave * 32 + (F.lane >> 1); const int hf = F.lane & 1;
        const bf16* o0p = (const bf16*)O4 + r * 2048 + h * 256 + hf * 64; const bf16* o1p = o0p + 128;
        float ss = 0.f;
#pragma unroll
        for (int k = 0; k < 8; ++k) { const v4u a = *(const GAS v4u*)(o0p + 8 * k), bq = *(const GAS v4u*)(o1p + 8 * k);
            const unsigned aw[4] = {a.x, a.y, a.z, a.w}, bw[4] = {bq.x, bq.y, bq.z, bq.w};
#pragma unroll
            for (int q = 0; q < 4; ++q) { const float d0 = pg8::bf_lo(aw[q]) - lam * pg8::bf_lo(bw[q]), d1 = pg8::bf_hi(aw[q]) - lam * pg8::bf_hi(bw[q]); ss += d0 * d0 + d1 * d1; } }
        ss += __shfl_xor(ss, 1);
        const float rs = (1.0f - LAM_INIT) / sqrtf(ss * (1.0f / 128.0f) + LN_EPS);
        const float* sw = subw + hf * 64; bf16* op = OA + r * 1024 + h * 128 + hf * 64;
#pragma unroll
        for (int k = 0; k < 8; ++k) { const v4u a = *(const GAS v4u*)(o0p + 8 * k), bq = *(const GAS v4u*)(o1p + 8 * k);
            const unsigned aw[4] = {a.x, a.y, a.z, a.w}, bw[4] = {bq.x, bq.y, bq.z, bq.w}; unsigned ow[4];
#pragma unroll
            for (int q = 0; q < 4; ++q) { const float d0 = pg8::bf_lo(aw[q]) - lam * pg8::bf_lo(bw[q]), d1 = pg8::bf_hi(aw[q]) - lam * pg8::bf_hi(bw[q]);
                ow[q] = pk2(d0 * rs * sw[8 * k + 2 * q], d1 * rs * sw[8 * k + 2 * q + 1]); }
            *(GAS v4u*)(op + 8 * k) = (v4u){ow[0], ow[1], ow[2], ow[3]}; }
    }
    for (int u = F.vcu; u < 1024; u += F.G) {
        const int b = u >> 8, qh = (u >> 4) & 15, qb = u & 15, kvh = qh >> 3; const size_t qrow = (size_t)b * SEQ + qb * 256, krow = (size_t)b * KVR;
        const int w0 = qb == 0 ? 0 : 256 * qb - 128, w1 = qb == 15 ? SEQ : 256 * qb + 384;
        attn_body::AttnArgs aa; aa.Qw0 = QB + qrow * 1024 + qh * 64; aa.Kh = KB + krow * 128 + kvh * 64; aa.Vh = VB + krow * 128 + kvh * 64; aa.Ow0 = OB + qrow * 1024 + qh * 64;
        aa.NT = 4 + (w1 - w0) / 64; aa.win0 = w0; aa.qpos0 = 256 * qb; aa.sinkl2 = sinks[qh] * 1.4426950408889634f;
        attn_body::attn_unit<CfgB, 8>(aa, lds_generic);
    }
}
__device__ __forceinline__ void p7_phase(Frame& F, const float* g1n, const float* b1n, const float* wrt, const float* brt) {
    typedef float f32x16 __attribute__((ext_vector_type(16)));
    const float* R = (const float*)(F.ws + WS_R); float* X1 = (float*)(F.ws + WS_X1); bf16* HM = (bf16*)(F.ws + WS_HM); const float* MOD = (const float*)(F.ws + WS_MOD);
    int* TKE = (int*)(F.ws + WS_TKE); float* TKG = (float*)(F.ws + WS_TKG); int* TKR = (int*)(F.ws + WS_TKR);
    LAS float* part = (LAS float*)F.lds;
    LAS float* lg = (LAS float*)(F.lds + 34816);
    LAS int* cntL = (LAS int*)(F.lds + 40960);
    LAS int* baseL = cntL + 32;
    for (int tile = blockIdx.x; tile < MT / 32; tile += F.G) {
        const int R0 = tile * 32; const float* modb = MOD + (size_t)(R0 >> 12) * MODW;
        if (F.tid < 32) cntL[F.tid] = 0;
        for (int i = 0; i < 4; ++i) {
            const size_t row = R0 + 4 * F.wave + i;
            const GAS f32x4* r4 = (const GAS f32x4*)(R + row * DM) + F.lane;
            f32x4 v[8]; float s = 0.f;
#pragma unroll
            for (int j = 0; j < 8; ++j) { v[j] = r4[64 * j]; s += (v[j][0] + v[j][1]) + (v[j][2] + v[j][3]); }
            const float mean = wave_sum(s) * (1.0f / DM); float s2 = 0.f;
#pragma unroll
            for (int j = 0; j < 8; ++j) { v[j] = v[j] - mean; s2 += (v[j][0] * v[j][0] + v[j][1] * v[j][1]) + (v[j][2] * v[j][2] + v[j][3] * v[j][3]); }
            const float rstd = 1.0f / sqrtf(wave_sum(s2) * (1.0f / DM) + LN_EPS);
            GAS f32x4* xo = (GAS f32x4*)(X1 + row * DM) + F.lane; GAS u32x2* ho = (GAS u32x2*)(HM + row * DM) + F.lane;
#pragma unroll
            for (int j = 0; j < 8; ++j) { const int d4 = F.lane + 64 * j;
                const f32x4 g = ((const GAS f32x4*)g1n)[d4], bb = ((const GAS f32x4*)b1n)[d4], sc = ((const GAS f32x4*)(modb + 4 * DM))[d4], sh = ((const GAS f32x4*)(modb + 3 * DM))[d4];
                const f32x4 x1 = v[j] * rstd * g + bb; xo[64 * j] = x1; const f32x4 hm = x1 * (sc + 1.0f) + sh;
                u32x2 w; w.x = pk2(hm[0], hm[1]); w.y = pk2(hm[2], hm[3]); ho[64 * j] = w; }
        }
        VM_WAIT(); __syncthreads();
        {
            const int rw = F.lane & 31, hf = F.lane >> 5;
            const float* xr = X1 + (size_t)(R0 + rw) * DM + 256 * F.wave + 4 * hf;
            const float* wp = wrt + (size_t)(256 * F.wave + 4 * hf) * NE + rw;
            const float* scp = modb + 4 * DM + 256 * F.wave + 4 * hf; const float* shp = modb + 3 * DM + 256 * F.wave + 4 * hf;
            f32x16 acc;
#pragma unroll
            for (int q = 0; q < 16; ++q) acc[q] = 0.f;
#pragma unroll 4
            for (int c = 0; c < 32; ++c) {
                const f32x4 x4 = *(const GAS f32x4*)(xr + 8 * c), s4 = *(const GAS f32x4*)(scp + 8 * c), h4 = *(const GAS f32x4*)(shp + 8 * c);
                const f32x4 hm = x4 * (s4 + 1.0f) + h4;
#pragma unroll
                for (int i = 0; i < 4; ++i) acc = __builtin_amdgcn_mfma_f32_32x32x2f32(hm[i], wp[(size_t)(8 * c + i) * NE], acc, 0, 0, 0);
            }
#pragma unroll
            for (int q = 0; q < 16; ++q) part[(F.wave * 32 + (q & 3) + 8 * (q >> 2) + 4 * hf) * 33 + rw] = acc[q];
        }
        __syncthreads();
        for (int p = F.tid; p < 1024; p += NWAVES * 64) { const int rr = p >> 5, e = p & 31; float t = brt[e];
#pragma unroll
            for (int w = 0; w < 8; ++w) t += part[(w * 32 + rr) * 33 + e];
            lg[rr * 33 + e] = t; }
        __syncthreads();
        int sel0 = 0, sel1 = 0, sel2 = 0, sel3 = 0, lr0 = 0, lr1 = 0, lr2 = 0, lr3 = 0;
        if (F.tid < 32) {
            float val[4]; int sel[4];
#pragma unroll
            for (int k = 0; k < 4; ++k) { float best = -INFINITY; int bi = 0;
                for (int e = 0; e < NE; ++e) { const float vv = lg[F.tid * 33 + e]; if (vv > best) { best = vv; bi = e; } }
                sel[k] = bi; val[k] = best; lg[F.tid * 33 + bi] = -INFINITY; }
            const float p1 = __expf(val[1] - val[0]), p2 = __expf(val[2] - val[0]), p3 = __expf(val[3] - val[0]); const float inv = 1.0f / (1.0f + p1 + p2 + p3);
            const size_t a0 = (size_t)(R0 + F.tid) * 4;
            TKE[a0] = sel[0]; TKE[a0 + 1] = sel[1]; TKE[a0 + 2] = sel[2]; TKE[a0 + 3] = sel[3];
            TKG[a0] = inv; TKG[a0 + 1] = p1 * inv; TKG[a0 + 2] = p2 * inv; TKG[a0 + 3] = p3 * inv;
            sel0 = sel[0]; sel1 = sel[1]; sel2 = sel[2]; sel3 = sel[3];
            lr0 = atomicAdd((int*)(cntL + sel0), 1); lr1 = atomicAdd((int*)(cntL + sel1), 1); lr2 = atomicAdd((int*)(cntL + sel2), 1); lr3 = atomicAdd((int*)(cntL + sel3), 1);
        }
        __syncthreads();
        if (F.tid < 32) { const int cl = cntL[F.tid]; baseL[F.tid] = cl ? (int)__hip_atomic_fetch_add((unsigned*)(F.ctl + CW_CNT + F.tid), (unsigned)cl, __ATOMIC_RELAXED, __HIP_MEMORY_SCOPE_AGENT) : 0; }
        __syncthreads();
        if (F.tid < 32) { const size_t a0 = (size_t)(R0 + F.tid) * 4; TKR[a0] = baseL[sel0] + lr0; TKR[a0 + 1] = baseL[sel1] + lr1; TKR[a0 + 2] = baseL[sel2] + lr2; TKR[a0 + 3] = baseL[sel3] + lr3; }
        __syncthreads();
    }
}
__device__ __forceinline__ void p8_phase(Frame& F) {
    LAS int* cnt = (LAS int*)(F.lds + TBL_OFF); LAS int* pstart = cnt + 32; LAS int* nmt = cnt + 96; LAS int* mt_e = cnt + 128;
    if (F.tid < 32) cnt[F.tid] = (int)__hip_atomic_load((unsigned*)(F.ctl + CW_CNT + F.tid), RLX_AGENT);
    __syncthreads();
    if (F.tid == 0) { int acc = 0, nt = 0;
        for (int e = 0; e < NE; ++e) { pstart[e] = acc; const int t = (cnt[e] + 255) >> 8; for (int j = 0; j < t && nt < MAXMT; ++j) mt_e[nt++] = e; acc += t * 256; }
        pstart[32] = acc; nmt[0] = nt; }
    __syncthreads();
    const int* TKE = (const int*)(F.ws + WS_TKE); const float* TKG = (const float*)(F.ws + WS_TKG); const int* TKR = (const int*)(F.ws + WS_TKR);
    int* PSLOT = (int*)(F.ws + WS_PSLOT); float* PGATE = (float*)(F.ws + WS_PGATE);
    const bf16* HM = (const bf16*)(F.ws + WS_HM); bf16* XG = (bf16*)(F.ws + WS_XG);
    const int gw = F.vcu * NWAVES + F.wave, NGW = F.G * NWAVES;
    for (int a = gw; a < NASSIGN; a += NGW) {
        const int e = TKE[a] & 31; int pos = pstart[e] + TKR[a]; if (pos < 0 || pos >= MAXMT * 256) pos = 0;
        if (F.lane == 0) { PSLOT[pos] = a; PGATE[pos] = TKG[a]; }
        const GAS v4u* src = (const GAS v4u*)(HM + (size_t)(a >> 2) * DM) + F.lane; GAS v4u* dst = (GAS v4u*)(XG + (size_t)pos * DM) + F.lane;
#pragma unroll
        for (int j = 0; j < 4; ++j) dst[64 * j] = src[64 * j];
    }
}
__device__ __forceinline__ void p11_phase(Frame& F, const float* g2n, const float* b2n) {
    const float* X1 = (const float*)(F.ws + WS_X1); const bf16* YS = (const bf16*)(F.ws + WS_YS); const float* MOD = (const float*)(F.ws + WS_MOD);
    const int gw = F.vcu * NWAVES + F.wave, NGW = F.G * NWAVES;
    for (int m = gw; m < MT; m += NGW) {
        const GAS f32x4* x4 = (const GAS f32x4*)(X1 + (size_t)m * DM) + F.lane; const GAS f32x4* g24 = (const GAS f32x4*)(MOD + (size_t)(m >> 12) * MODW + 5 * DM) + F.lane;
        const GAS u32x2* y8 = (const GAS u32x2*)(YS + (size_t)m * 4 * DM) + F.lane;
        f32x4 v[8]; float s = 0.f;
#pragma unroll
        for (int j = 0; j < 8; ++j) { f32x4 mo = (f32x4){0.f, 0.f, 0.f, 0.f};
#pragma unroll
            for (int k = 0; k < 4; ++k) { const u32x2 w = y8[k * 512 + 64 * j]; mo += (f32x4){pg8::bf_lo(w.x), pg8::bf_hi(w.x), pg8::bf_lo(w.y), pg8::bf_hi(w.y)}; }
            v[j] = x4[64 * j] * DN_ALPHA + g24[64 * j] * mo; s += (v[j][0] + v[j][1]) + (v[j][2] + v[j][3]); }
        const float mean = wave_sum(s) * (1.0f / DM); float s2 = 0.f;
#pragma unroll
        for (int j = 0; j < 8; ++j) { v[j] = v[j] - mean; s2 += (v[j][0] * v[j][0] + v[j][1] * v[j][1]) + (v[j][2] * v[j][2] + v[j][3] * v[j][3]); }
        const float rstd = 1.0f / sqrtf(wave_sum(s2) * (1.0f / DM) + LN_EPS);
        GAS f32x4* o4 = (GAS f32x4*)(F.out + (size_t)m * DM) + F.lane;
#pragma unroll
        for (int j = 0; j < 8; ++j) o4[64 * j] = v[j] * rstd * ((const GAS f32x4*)g2n)[F.lane + 64 * j] + ((const GAS f32x4*)b2n)[F.lane + 64 * j];
    }
}

struct Args { const float* in[26]; float* out; unsigned char* ws; };
__global__ void __launch_bounds__(NWAVES * 64, 2) mega_fwd(Args args) {
    extern __shared__ __attribute__((aligned(16))) unsigned char lds[];
    Frame F;
    F.lds = (LAS unsigned char*)lds;
    F.MISC = (volatile LAS unsigned*)(F.lds + MISC_OFF);
    F.tid = threadIdx.x; F.lane = F.tid & 63; F.wave = __builtin_amdgcn_readfirstlane(F.tid >> 6);
    F.G = gridDim.x; { const int bx = blockIdx.x; F.vcu = (F.G % 8 == 0) ? (bx % 8) * (F.G / 8) + bx / 8 : bx; }
    F.ws = args.ws; F.ctl = (gu32*)(args.ws + WS_CTL); F.out = args.out;
    for (int u = F.tid; u < (LDS_BYTES - LDSCTL_OFF) / 4; u += NWAVES * 64) ((LAS unsigned*)(F.lds + LDSCTL_OFF))[u] = 0u;
    __syncthreads();
    XcdBarrier bar = xcd_barrier_post((unsigned*)(F.ctl + CW_BAR), F.MISC + 8);
#define GRID_BAR() xcd_barrier(bar)
    unsigned char* ws = args.ws;
    pg8::bf16_t* WIN = (pg8::bf16_t*)(ws + WS_WIN);

    p0_phase(F, args.in[1], args.in[3], args.in[4], args.in[6], args.in[13], args.in[14], args.in[15]); GRID_BAR();
    p1_phase(F, args.in[5], args.in[20], args.in[22]); GRID_BAR();
    p2_phase(F, args.in[0], args.in[2]); GRID_BAR();
    {
        pg8::Gemm g{(const pg8::bf16_t*)(ws + WS_H), WIN, MH, PROJ, DM}; pg8::InProjOrder S{F.G, (int)blockIdx.x};
        pg8::EpiInProj E{(pg8::bf16_t*)(ws + WS_QA), (pg8::bf16_t*)(ws + WS_KA), (pg8::bf16_t*)(ws + WS_VA), (pg8::bf16_t*)(ws + WS_QB), (pg8::bf16_t*)(ws + WS_KB), (pg8::bf16_t*)(ws + WS_VB),
                          (pg8::bf16_t*)(ws + WS_GA), (pg8::bf16_t*)(ws + WS_GB), attn_body::C2};
        pg8::gemm_phase<pg8::EpiInProj, pg8::InProjOrder, PG8_ALIGN, PG8_SP2>(F.lds + RING_OFF, g, S, E);
    }
    GRID_BAR();
    p4_phase(F, (char*)lds + RING_OFF, args.in[7], args.in[8], args.in[9], args.in[10], args.in[11], args.in[12]);
    GRID_BAR();
    {
        pg8::Gemm g{(const pg8::bf16_t*)(ws + WS_OA), (const pg8::bf16_t*)(ws + WS_WOA), MT, DM, 1024}; pg8::StaticOrder S; S.init(MT, DM, F.G, (int)blockIdx.x);
        pg8::EpiGate1 E{(const pg8::bf16_t*)(ws + WS_GA), (float*)(ws + WS_Y1)};
        pg8::gemm_phase<pg8::EpiGate1, pg8::StaticOrder, PG8_ALIGN, PG8_SP2>(F.lds + RING_OFF, g, S, E);
    }
    VM_WAIT(); __syncthreads();
    {
        pg8::Gemm g{(const pg8::bf16_t*)(ws + WS_OB), (const pg8::bf16_t*)(ws + WS_WOB), MT, DM, 1024}; pg8::StaticOrder S; S.init(MT, DM, F.G, (int)blockIdx.x);
        pg8::EpiGate2 E{(const pg8::bf16_t*)(ws + WS_GB), (const float*)(ws + WS_Y1), (pg8::bf16_t*)(ws + WS_Y)};
        pg8::gemm_phase<pg8::EpiGate2, pg8::StaticOrder, PG8_ALIGN, PG8_SP2>(F.lds + RING_OFF, g, S, E);
    }
    GRID_BAR();
    {
        pg8::Gemm g{(const pg8::bf16_t*)(ws + WS_Y), (const pg8::bf16_t*)(ws + WS_WOUT), MT, DM, DM}; pg8::StaticOrder S; S.init(MT, DM, F.G, (int)blockIdx.x);
        pg8::EpiOut E{args.in[0], (const float*)(ws + WS_MOD), (float*)(ws + WS_R), DN_ALPHA};
        pg8::gemm_phase<pg8::EpiOut, pg8::StaticOrder, PG8_ALIGN, PG8_SP2>(F.lds + RING_OFF, g, S, E);
    }
    GRID_BAR();
    p7_phase(F, args.in[16], args.in[17], args.in[18], args.in[19]); GRID_BAR();
    p8_phase(F); GRID_BAR();
    const LAS int* t_cnt = (const LAS int*)(F.lds + TBL_OFF); const LAS int* t_pstart = t_cnt + 32; const LAS int* t_mte = t_cnt + 128; const int nMt = t_cnt[96];
    {
        pg8::Gemm g{(const pg8::bf16_t*)(ws + WS_XG), (const pg8::bf16_t*)(ws + WS_WUP), MAXMT * 256, NE * 4096, DM}; pg8::MoeOrder S; S.init(nMt, 16, F.G, (int)blockIdx.x, t_mte);
        pg8::EpiUp E{args.in[21], (pg8::bf16_t*)(ws + WS_ACT)};
        pg8::gemm_phase<pg8::EpiUp, pg8::MoeOrder, PG8_ALIGN, PG8_SP2>(F.lds + RING_OFF, g, S, E);
    }
    GRID_BAR();
    {
        pg8::Gemm g{(const pg8::bf16_t*)(ws + WS_ACT), (const pg8::bf16_t*)(ws + WS_WDN), MAXMT * 256, NE * DM, DM}; pg8::MoeOrder S; S.init(nMt, 8, F.G, (int)blockIdx.x, t_mte);
        pg8::EpiDown E{args.in[23], (pg8::bf16_t*)(ws + WS_YS), (const int*)(ws + WS_PSLOT), (const float*)(ws + WS_PGATE), t_cnt, t_pstart};
        pg8::gemm_phase<pg8::EpiDown, pg8::MoeOrder, PG8_ALIGN, PG8_SP2>(F.lds + RING_OFF, g, S, E);
    }
    GRID_BAR();
    p11_phase(F, args.in[24], args.in[25]);
#undef GRID_BAR
}

extern "C" void kernel_launch(void* const* d_in, const int* in_sizes, int n_in, void* d_out, int out_size, void* d_ws, size_t ws_size, hipStream_t stream) {
    static int grid = 0;
    if (grid == 0) {
        if (n_in != 26 || out_size != MT * DM || ws_size < WS_END) { fprintf(stderr, "kernel_launch: unexpected shapes (n_in %d, out %d, ws %zu); nothing launched\n", n_in, out_size, ws_size); grid = -1; return; }
        int dev = 0, cus = 0, per_cu = 0;
        if (hipGetDevice(&dev) != hipSuccess || hipDeviceGetAttribute(&cus, hipDeviceAttributeMultiprocessorCount, dev) != hipSuccess) { grid = -1; return; }
        if (hipFuncSetAttribute((const void*)mega_fwd, hipFuncAttributeMaxDynamicSharedMemorySize, LDS_BYTES) != hipSuccess) { fprintf(stderr, "kernel_launch: hipFuncSetAttribute failed\n"); grid = -1; return; }
        if (hipOccupancyMaxActiveBlocksPerMultiprocessor(&per_cu, (const void*)mega_fwd, NWAVES * 64, LDS_BYTES) != hipSuccess || per_cu < 1) fprintf(stderr, "kernel_launch: occupancy query reports %d\n", per_cu);
        (void)hipGetLastError();
        grid = cus;
    }
    if (grid < 0) return;
    if (hipMemsetAsync((char*)d_ws + WS_CTL, 0, CTL_ZERO_BYTES, stream) != hipSuccess) return;
    Args a{};
    for (int i = 0; i < 26; ++i) a.in[i] = (const float*)d_in[i];
    a.out = (float*)d_out; a.ws = (unsigned char*)d_ws;
    hipLaunchKernelGGL(mega_fwd, dim3(grid), dim3(NWAVES * 64), LDS_BYTES, stream, a);
}
```

```cpp
#include <hip/hip_runtime.h>
#include <cstdio>
#include <cstdint>
namespace pg8 {
#define PG8_LAS __attribute__((address_space(3)))
typedef unsigned short bf16_t;
typedef short bf16x8 __attribute__((ext_vector_type(8)));
typedef float f32x4 __attribute__((ext_vector_type(4)));
typedef unsigned u32x4 __attribute__((ext_vector_type(4)));
typedef int i32x4 __attribute__((ext_vector_type(4)));
template <class AccT> __device__ __forceinline__ AccT pg8_mma(bf16x8 b, bf16x8 a, AccT c);
template <> __device__ __forceinline__ f32x4 pg8_mma<f32x4>(bf16x8 b, bf16x8 a, f32x4 c) { return __builtin_amdgcn_mfma_f32_16x16x32_bf16(b, a, c, 0, 0, 0); }
template <> __device__ __forceinline__ i32x4 pg8_mma<i32x4>(bf16x8 b, bf16x8 a, i32x4 c) { return __builtin_amdgcn_mfma_i32_16x16x64_i8(__builtin_bit_cast(i32x4, b), __builtin_bit_cast(i32x4, a), c, 0, 0, 0); }
constexpr int BM = 256, BK = 64, HALF = 128, HTB = HALF * BK * 2  , STAGE_BYTES = 8 * HTB, NXCD = 8, WGM = 8;

__host__ __device__ __forceinline__ int lds_byte(int r, int c) { const int st = (r >> 4) * 2 + (c >> 5), rr = r & 15, cc = c & 31, ob = rr * 64 + cc * 2; return st * 1024 + (ob ^ (((ob >> 9) & 1) << 5)); }
__host__ __device__ __forceinline__ void stage_rc(int b, int& R, int& C) { const int st = b / 1024, sb = b % 1024, swz = sb ^ (((sb >> 9) & 1) << 5); R = (st >> 1) * 16 + swz / 64; C = (st & 1) * 32 + (swz % 64) / 2; }
__host__ __device__ __forceinline__ int perm32(int rho) { const int n = rho >> 4, i = rho & 15; return 8 * (i >> 2) + 4 * n + (i & 3); }

struct Unit { int pm, pn, pb, half, ord; };
struct Gemm { const bf16_t* A; const bf16_t* Bt; int M, N, K; };

struct StaticOrder {
    int nM, nN, nwg, G, c;
    __host__ __device__ __forceinline__ void init(int M, int N, int G_, int c_) { nM = M / BM; nN = N / BM; nwg = nM * nN; G = G_; c = c_; }
    __host__ __device__ __forceinline__ bool next(int i, Unit& u) const {
        const long L = (long)i * G + c; if (L >= nwg) return false;
        int wgid = (int)L; { const int q = nwg / NXCD, r = nwg % NXCD, xcd = wgid % NXCD, off = wgid / NXCD; wgid = (xcd < r ? xcd * (q + 1) : r * (q + 1) + (xcd - r) * q) + off; }
        const int nig = WGM * nN, gid = wgid / nig, fm = gid * WGM, gsz = (nM - fm) < WGM ? (nM - fm) : WGM;
        u.pm = fm + ((wgid % nig) % gsz); u.pn = (wgid % nig) / gsz; u.pb = u.pn; u.half = 0; u.ord = i; return true;
    }
    __device__ __forceinline__ void a_ready(const Unit&) const {}
    __device__ __forceinline__ void done(const Unit&) const {}
};

__device__ __forceinline__ unsigned cvt_pk_bf16(float lo, float hi) { unsigned r; asm volatile("v_cvt_pk_bf16_f32 %0, %1, %2" : "=v"(r) : "v"(lo), "v"(hi)); return r; }
typedef float f32x2 __attribute__((ext_vector_type(2)));
__device__ __forceinline__ f32x2 gelu_pk(f32x2 v) {
    const f32x2 av = __builtin_elementwise_abs(v), d = av * 0.2316418882f + 1.0f;
    f32x2 t; t.x = __builtin_amdgcn_rcpf(d.x); t.y = __builtin_amdgcn_rcpf(d.y);
    f32x2 q = t * 0.5307027145f + (-0.7265760135f); q = q * t + 0.7107068705f; q = q * t + (-0.142248368f); q = q * t + 0.127414796f; q = q * t;
    const f32x2 s = (v * v) * (-0.72134752044f);
    f32x2 e; e.x = __builtin_amdgcn_exp2f(s.x); e.y = __builtin_amdgcn_exp2f(s.y);
    const f32x2 m = v * (q * e), r = v - m;
    f32x2 o; o.x = v.x < 0.f ? m.x : r.x; o.y = v.y < 0.f ? m.y : r.y; return o;
}

template <int ACT  > struct EpiBf16 {
    typedef f32x4 AccT; static constexpr bool PERM = true, AFTER_DRAIN = false; static_assert(ACT == 0 || ACT == 1, "EpiBf16: ACT is 0 (none) or 1 (gelu_pk)");
    bf16_t* O; int ldc; const float* bias; int split_cols; size_t split_stride; float scale0;
    __device__ __forceinline__ void operator()(const f32x4 (&acc)[2][2][4][2], const Unit& u, int wr, int wc, int fr, int fq) const {
        const int row0 = u.pm * BM + wr * 64 + fr; int colt = u.pn * BM; bf16_t* base = O;
        float sc = 1.f; if (split_cols) { const int t = colt / split_cols; base += (size_t)t * split_stride; colt -= t * split_cols; if (t == 0) sc = scale0; }
        const int col0 = colt + wc * 32 + 8 * fq, bcol0 = u.pn * BM + wc * 32 + 8 * fq;
        f32x4 bv[2][2];
#pragma unroll
        for (int bj = 0; bj < 2; ++bj)
#pragma unroll
            for (int n = 0; n < 2; ++n) bv[bj][n] = bias ? *(const f32x4*)(bias + bcol0 + bj * HALF + 4 * n) : (f32x4){0.f, 0.f, 0.f, 0.f};
#pragma unroll
        for (int ai = 0; ai < 2; ++ai)
#pragma unroll
            for (int m = 0; m < 4; ++m) { bf16_t* rowp = base + (size_t)(row0 + ai * HALF + m * 16) * ldc + col0;
#pragma unroll
                for (int bj = 0; bj < 2; ++bj) { f32x4 v0 = acc[ai][bj][m][0] + bv[bj][0], v1 = acc[ai][bj][m][1] + bv[bj][1];
                    if (ACT == 1) { f32x2 a = gelu_pk((f32x2){v0[0], v0[1]}), b = gelu_pk((f32x2){v0[2], v0[3]}), c = gelu_pk((f32x2){v1[0], v1[1]}), d = gelu_pk((f32x2){v1[2], v1[3]});
                        v0 = (f32x4){a.x, a.y, b.x, b.y}; v1 = (f32x4){c.x, c.y, d.x, d.y}; }
                    v0 = v0 * sc; v1 = v1 * sc; u32x4 w; w.x = cvt_pk_bf16(v0[0], v0[1]); w.y = cvt_pk_bf16(v0[2], v0[3]); w.z = cvt_pk_bf16(v1[0], v1[1]); w.w = cvt_pk_bf16(v1[2], v1[3]);
                    *(u32x4*)(rowp + bj * HALF) = w; } }
    }
};

template <class Epi, class Sched, bool ALIGN_EPI = false, bool SP2 = false, bool GATHER = false, bool HALFU = false>
__device__ __forceinline__ void gemm_phase(PG8_LAS unsigned char* lds, const Gemm g, const Sched& S, const Epi& E, const PG8_LAS unsigned short* tokl = nullptr) {
    int tid_ = threadIdx.x; asm volatile("" : "+v"(tid_));
    const int tid = tid_, wid = __builtin_amdgcn_readfirstlane(tid >> 6), lane = tid & 63, wr = wid >> 2, wc = wid & 3, fr = lane & 15, fq = lane >> 4;
    const int K = g.K, nt = K / BK;
    unsigned voffA[2], voffB[2]; int rA_[2]; unsigned cA2_[2];
#pragma unroll
    for (int i = 0; i < 2; ++i) { int R, C; stage_rc(tid * 16 + i * 8192, R, C); const int Rb = Epi::PERM ? ((R & ~31) + perm32(R & 31)) : R;
        voffA[i] = (unsigned)(R * K + C) * 2u; voffB[i] = (unsigned)(Rb * K + C) * 2u; rA_[i] = R; cA2_[i] = (unsigned)C * 2u; }
    unsigned gc[2][2], gn[2][2];
#define PG8_GOFF(dst, ord) do { _Pragma("unroll") for (int h_ = 0; h_ < 2; ++h_) _Pragma("unroll") for (int i_ = 0; i_ < 2; ++i_) dst[h_][i_] = (unsigned)tokl[(ord) * 256 + h_ * 128 + rA_[i_]] * (unsigned)(K * 2) + cA2_[i_]; } while (0)
#define PG8_GCOPY(dst, src) do { dst[0][0] = src[0][0]; dst[0][1] = src[0][1]; dst[1][0] = src[1][0]; dst[1][1] = src[1][1]; } while (0)
    const size_t kstep = (size_t)(BK * 2);
    const size_t hstep = (size_t)HALF * K * 2;
    const size_t tstep = 2 * hstep;
    const unsigned ldsw = (unsigned)wid * 1024u;
    const int aoff = lds_byte(wr * 64 + fr, fq * 8), boff = lds_byte(wc * 32 + fr, fq * 8);
#define PG8_SA(b, h) (((b) * 2 + (h)) * HTB)
#define PG8_SB(b, h) ((4 + (b) * 2 + (h)) * HTB)
#define PG8_STAGE(bufoff, gbase, voff) do { _Pragma("unroll") for (int _i = 0; _i < 2; ++_i) \
        __builtin_amdgcn_global_load_lds((const unsigned*)((const char*)(gbase) + (voff)[_i]), (PG8_LAS unsigned*)(lds + (bufoff) + ldsw + _i * 8192), 16, 0, 0); } while (0)
#define PG8_STAGE_A(bufoff, gbase, h, nx) do { _Pragma("unroll") for (int _i = 0; _i < 2; ++_i) { const unsigned vo_ = GATHER ? ((nx) ? gn[h][_i] : gc[h][_i]) : voffA[_i]; \
        __builtin_amdgcn_global_load_lds((const unsigned*)((const char*)(gbase) + (GATHER ? (size_t)0 : (size_t)(h) * hstep) + vo_), (PG8_LAS unsigned*)(lds + (bufoff) + ldsw + _i * 8192), 16, 0, 0); } } while (0)
#define PG8_LDA(dst, b, h) do { _Pragma("unroll") for (int m = 0; m < 4; ++m) _Pragma("unroll") for (int k = 0; k < 2; ++k) dst[m][k] = *(const PG8_LAS bf16x8*)(lds + PG8_SA(b, h) + aoff + m * 2048 + k * 1024); } while (0)
#define PG8_LDB(dst, b, h) do { _Pragma("unroll") for (int n = 0; n < 2; ++n) _Pragma("unroll") for (int k = 0; k < 2; ++k) dst[n][k] = *(const PG8_LAS bf16x8*)(lds + PG8_SB(b, h) + boff + n * 2048 + k * 1024); } while (0)
#define PG8_MMA(ai, bj, At, Bt) do { __builtin_amdgcn_s_setprio(1); _Pragma("unroll") for (int m = 0; m < 4; ++m) _Pragma("unroll") for (int n = 0; n < 2; ++n) _Pragma("unroll") for (int k = 0; k < 2; ++k) \
        acc[ai][bj][m][n] = pg8_mma<typename Epi::AccT>(Bt[n][k], At[m][k], acc[ai][bj][m][n]); __builtin_amdgcn_s_setprio(0); } while (0)
#define PG8_WAIT_V(n) asm volatile("s_waitcnt vmcnt(" #n ")" ::: "memory")
#define PG8_WAIT_L(n) asm volatile("s_waitcnt lgkmcnt(" #n ")" ::: "memory")
#define PG8_BAR __builtin_amdgcn_s_barrier()
#define PG8_SCHED __builtin_amdgcn_sched_barrier(0)
    Unit cur, nxt; int ui = 0;
    if (!S.next(0, cur)) return;
    typedef typename Epi::AccT acc_t; acc_t acc[2][2][4][2];
#pragma unroll
    for (int a = 0; a < 2; ++a)
#pragma unroll
        for (int b = 0; b < 2; ++b)
#pragma unroll
            for (int m = 0; m < 4; ++m)
#pragma unroll
                for (int n = 0; n < 2; ++n) acc[a][b][m][n] = acc_t{};
    bf16x8 At[4][2], B0[2][2], B1[2][2];
    const char* cA = (const char*)g.A + (GATHER ? (size_t)0 : (size_t)cur.pm * tstep); const char* cB = (const char*)g.Bt + (size_t)cur.pb * tstep;
    if (GATHER) { PG8_GOFF(gc, 0); PG8_GCOPY(gn, gc); }
    S.a_ready(cur);
    if constexpr (SP2) {
        PG8_STAGE(PG8_SB(0, 0), cB, voffB); PG8_STAGE(PG8_SB(0, 1), cB + hstep, voffB); PG8_STAGE_A(PG8_SA(0, 0), cA, 0, false); PG8_STAGE_A(PG8_SA(0, 1), cA, 1, false);
        if (wr == 1) PG8_BAR;
        PG8_WAIT_V(2); PG8_BAR;
        PG8_STAGE(PG8_SB(1, 0), cB + kstep, voffB); PG8_STAGE_A(PG8_SA(1, 0), cA + kstep, 0, false); PG8_STAGE(PG8_SB(1, 1), cB + hstep + kstep, voffB);
        PG8_WAIT_V(6); PG8_BAR;
    } else {
        PG8_STAGE(PG8_SB(0, 0), cB, voffB); PG8_STAGE_A(PG8_SA(0, 0), cA, 0, false); PG8_STAGE(PG8_SB(0, 1), cB + hstep, voffB); PG8_STAGE_A(PG8_SA(0, 1), cA, 1, false);
        if (wr == 1) PG8_BAR;
        PG8_WAIT_V(4); PG8_BAR;
        PG8_STAGE(PG8_SB(1, 0), cB + kstep, voffB); PG8_STAGE_A(PG8_SA(1, 0), cA + kstep, 0, false); PG8_STAGE(PG8_SB(1, 1), cB + hstep + kstep, voffB);
        PG8_WAIT_V(6); PG8_BAR;
    }
    for (;;) {
        const bool has_next = S.next(ui + 1, nxt);
        if (GATHER) { if (has_next) PG8_GOFF(gn, ui + 1); else PG8_GCOPY(gn, gc); }
        const char* nA = (has_next && !GATHER) ? (const char*)g.A + (size_t)nxt.pm * tstep : cA; const char* nB = has_next ? (const char*)g.Bt + (size_t)nxt.pb * tstep : cB;
        for (int t = 0; t < nt; t += 2) {
            const bool last = (t == nt - 2);
            const char* a1 = cA + (size_t)(t + 1) * kstep;
            const char* a2 = last ? nA : cA + (size_t)(t + 2) * kstep; const char* b2 = last ? nB : cB + (size_t)(t + 2) * kstep;
            const char* a3 = a2 + kstep; const char* b3 = b2 + kstep;
            if (last && has_next) S.a_ready(nxt);
            if (last) { int ln_ = fq * 16 + fr; asm volatile("" : "+v"(ln_)); E.stage(cur, wid, ln_); }
            if constexpr (SP2) {
            PG8_LDB(B0, 0, 0); PG8_LDB(B1, 0, 1); PG8_SCHED; PG8_LDA(At, 0, 0); PG8_STAGE_A(PG8_SA(1, 1), a1, 1, false);
            PG8_WAIT_V(8); PG8_WAIT_L(0); PG8_BAR; PG8_MMA(0, 0, At, B0); PG8_MMA(0, 1, At, B1); PG8_BAR; PG8_SCHED;
            PG8_LDA(At, 0, 1); PG8_STAGE(PG8_SB(0, 0), b2, voffB); PG8_STAGE(PG8_SB(0, 1), b2 + hstep, voffB); PG8_STAGE_A(PG8_SA(0, 0), a2, 0, last);
            PG8_WAIT_V(8); PG8_WAIT_L(0); PG8_BAR; if (!(HALFU && cur.half)) { PG8_MMA(1, 0, At, B0); PG8_MMA(1, 1, At, B1); } PG8_BAR; PG8_SCHED;
            PG8_LDB(B0, 1, 0); PG8_LDB(B1, 1, 1); PG8_SCHED; PG8_LDA(At, 1, 0); PG8_STAGE_A(PG8_SA(0, 1), a2, 1, last);
            PG8_WAIT_V(8); PG8_WAIT_L(0); PG8_BAR; PG8_MMA(0, 0, At, B0); PG8_MMA(0, 1, At, B1); PG8_BAR; PG8_SCHED;
            PG8_LDA(At, 1, 1); PG8_STAGE(PG8_SB(1, 0), b3, voffB); PG8_STAGE(PG8_SB(1, 1), b3 + hstep, voffB); PG8_STAGE_A(PG8_SA(1, 0), a3, 0, last);
            PG8_WAIT_V(8); PG8_WAIT_L(0); PG8_BAR; if (!(HALFU && cur.half)) { PG8_MMA(1, 0, At, B0); PG8_MMA(1, 1, At, B1); } PG8_BAR; PG8_SCHED;
            } else {
            PG8_LDB(B0, 0, 0); PG8_SCHED; PG8_LDA(At, 0, 0); PG8_STAGE_A(PG8_SA(1, 1), a1, 1, false);
            PG8_WAIT_L(8); PG8_BAR; PG8_WAIT_L(0); PG8_MMA(0, 0, At, B0); PG8_BAR; PG8_SCHED;
            PG8_LDB(B1, 0, 1); PG8_STAGE(PG8_SB(0, 0), b2, voffB);
            PG8_BAR; PG8_WAIT_L(0); PG8_MMA(0, 1, At, B1); PG8_BAR;
            PG8_LDA(At, 0, 1); PG8_STAGE_A(PG8_SA(0, 0), a2, 0, last);
            PG8_BAR; PG8_WAIT_L(0); PG8_MMA(1, 0, At, B0); PG8_BAR; PG8_SCHED;
            PG8_STAGE(PG8_SB(0, 1), b2 + hstep, voffB);
            PG8_WAIT_V(6); PG8_BAR; PG8_MMA(1, 1, At, B1); PG8_BAR;
            PG8_LDB(B0, 1, 0); PG8_SCHED; PG8_LDA(At, 1, 0); PG8_STAGE_A(PG8_SA(0, 1), a2, 1, last);
            PG8_WAIT_L(8); PG8_BAR; PG8_WAIT_L(0); PG8_MMA(0, 0, At, B0); PG8_BAR; PG8_SCHED;
            PG8_LDB(B1, 1, 1); PG8_STAGE(PG8_SB(1, 0), b3, voffB);
            PG8_BAR; PG8_WAIT_L(0); PG8_MMA(0, 1, At, B1); PG8_BAR;
            PG8_LDA(At, 1, 1); PG8_STAGE_A(PG8_SA(1, 0), a3, 0, last);
            PG8_BAR; PG8_WAIT_L(0); PG8_MMA(1, 0, At, B0); PG8_BAR; PG8_SCHED;
            PG8_STAGE(PG8_SB(1, 1), b3 + hstep, voffB);
            PG8_WAIT_V(6); PG8_BAR; PG8_MMA(1, 1, At, B1); PG8_BAR;
            }
        }
        if constexpr (ALIGN_EPI) { if (wr == 0) PG8_BAR; }
        if constexpr (!Epi::AFTER_DRAIN) { E(acc, cur, wr, wc, fr, fq); S.done(cur); }
        if (!has_next) break;
#pragma unroll
        for (int a = 0; a < 2; ++a)
#pragma unroll
            for (int b = 0; b < 2; ++b)
#pragma unroll
                for (int m = 0; m < 4; ++m)
#pragma unroll
                    for (int n = 0; n < 2; ++n) acc[a][b][m][n] = acc_t{};
        cur = nxt; cA = nA; cB = nB; ++ui; if (GATHER) PG8_GCOPY(gc, gn);
        if constexpr (ALIGN_EPI) { if (wr == 1) PG8_BAR; }
    }
    PG8_WAIT_V(0);
    if constexpr (!ALIGN_EPI) { if (wr == 0) PG8_BAR; }
    PG8_BAR;
    if constexpr (Epi::AFTER_DRAIN) { E.fused(acc, cur, wr, wc, fr, fq, lds, wid, lane); S.done(cur); }
#undef PG8_SA
#undef PG8_SB
#undef PG8_STAGE
#undef PG8_STAGE_A
#undef PG8_GOFF
#undef PG8_GCOPY
#undef PG8_LDA
#undef PG8_LDB
#undef PG8_MMA
#undef PG8_WAIT_V
#undef PG8_WAIT_L
#undef PG8_BAR
#undef PG8_SCHED
}
}

#ifndef PG8_SP2
#define PG8_SP2 true
#endif
#ifndef PG8_ALIGN
#define PG8_ALIGN true
#endif
#include <hip/hip_bf16.h>
#include <cmath>
namespace pg8 {
__device__ __forceinline__ float bf_lo(unsigned w) { return __uint_as_float(w << 16); }
__device__ __forceinline__ float bf_hi(unsigned w) { return __uint_as_float(w & 0xffff0000u); }
__device__ __forceinline__ u32x4 pack8(const f32x4 v0, const f32x4 v1) { u32x4 w; w.x = cvt_pk_bf16(v0[0], v0[1]); w.y = cvt_pk_bf16(v0[2], v0[3]); w.z = cvt_pk_bf16(v1[0], v1[1]); w.w = cvt_pk_bf16(v1[2], v1[3]); return w; }
__device__ __forceinline__ unsigned q4p(float a, float b, float c, float d, float inv) {
    const float M = 12582912.0f;
    const unsigned b0 = __float_as_uint(fmaf(a, inv, M)), b1 = __float_as_uint(fmaf(b, inv, M)), b2 = __float_as_uint(fmaf(c, inv, M)), b3 = __float_as_uint(fmaf(d, inv, M));
    return __builtin_amdgcn_perm(__builtin_amdgcn_perm(b3, b2, 0x0c0c0400u), __builtin_amdgcn_perm(b1, b0, 0x0c0c0400u), 0x05040100u);
}
__device__ __forceinline__ float lane_max_16_32(float v) {
    { auto r = __builtin_amdgcn_permlane16_swap(__float_as_uint(v), __float_as_uint(v), false, false); v = fmaxf(__uint_as_float(r[0]), __uint_as_float(r[1])); }
    { auto r = __builtin_amdgcn_permlane32_swap(__float_as_uint(v), __float_as_uint(v), false, false); v = fmaxf(__uint_as_float(r[0]), __uint_as_float(r[1])); }
    return v;
}
__device__ __forceinline__ float sigmoidf_fast(float x) { return __builtin_amdgcn_rcpf(1.0f + __builtin_amdgcn_exp2f(-1.4426950408889634f * x)); }

struct InProjOrder {
    int G, c;
    __device__ __forceinline__ bool next(int i, Unit& u) const {
        constexpr int NMAIN = 64 * 33, NWG = NMAIN + 36;
        const int L = i * G + c; if (L >= NWG) return false;
        int wgid = L; { const int q = NWG / NXCD, r = NWG % NXCD, xcd = wgid % NXCD, off = wgid / NXCD; wgid = (xcd < r ? xcd * (q + 1) : r * (q + 1) + (xcd - r) * q) + off; }
        if (wgid < NMAIN) { const int nig = WGM * 33, gid = wgid / nig, fm = gid * WGM; u.pm = fm + ((wgid % nig) % WGM); u.pn = (wgid % nig) / WGM; }
        else { const int idx = wgid - NMAIN, j = idx >> 2; u.pm = 64 + (idx & 3); u.pn = j < 8 ? 4 + j : 16; }
        u.pb = u.pn; u.half = 0; u.ord = i; return true;
    }
    __device__ __forceinline__ void a_ready(const Unit&) const {}
    __device__ __forceinline__ void done(const Unit&) const {}
};
struct MoeOrder {
    int nM, nN, nwg, G, c; const PG8_LAS int* mt_e; const PG8_LAS int* cnt; const PG8_LAS int* pstart;
    __device__ __forceinline__ void init(int nM_, int nN_, int G_, int c_, const PG8_LAS int* t, const PG8_LAS int* cn, const PG8_LAS int* ps) { nM = nM_; nN = nN_; nwg = nM * nN; G = G_; c = c_; mt_e = t; cnt = cn; pstart = ps; }
    __device__ __forceinline__ bool next(int i, Unit& u) const {
        const long L = (long)i * G + c; if (L >= nwg) return false;
        int wgid = (int)L; { const int q = nwg / NXCD, r = nwg % NXCD, xcd = wgid % NXCD, off = wgid / NXCD; wgid = (xcd < r ? xcd * (q + 1) : r * (q + 1) + (xcd - r) * q) + off; }
        constexpr int WG_ = 4;     const int nig = WG_ * nN, gid = wgid / nig, fm = gid * WG_, gsz = (nM - fm) < WG_ ? (nM - fm) : WG_;
        u.pm = fm + ((wgid % nig) % gsz); u.pn = (wgid % nig) / gsz;
        const int e = __builtin_amdgcn_readfirstlane(mt_e[u.pm]); u.pb = e * nN + u.pn;
        u.half = 0; u.ord = i; return true;
    }
    __device__ __forceinline__ void a_ready(const Unit&) const {}
    __device__ __forceinline__ void done(const Unit&) const {}
};

struct EpiInProj {
    typedef i32x4 AccT; static constexpr bool PERM = true, AFTER_DRAIN = false;
    const float* SH; const float* SBc; bf16_t *QA, *KA, *VA, *QB, *KB, *VB, *GA, *GB; float c2; PG8_LAS float* epl;
    __device__ __forceinline__ void stage(const Unit& u, int wid, int lane) const { const float* p = wid < 4 ? SH + u.pm * 256 + wid * 64 : SBc + u.pn * 256 + (wid - 4) * 64;
        __builtin_amdgcn_global_load_lds((const unsigned*)(p + (unsigned)lane), (PG8_LAS unsigned*)(epl + wid * 64), 4, 0, 0); }
    __device__ __forceinline__ void operator()(const i32x4 (&acc)[2][2][4][2], const Unit& u, int wr, int wc, int fr, int fq) const {
        const int pm = u.pm, pn = u.pn; const bool ctx = pm >= 64;
        const int b = ctx ? pm - 64 : (pm >> 4);
        const int krow0 = ctx ? b * 4352 + 4096 : b * 4352 + (pm & 15) * 256, qrow0 = pm * 256;
        float sa8[2][4];
#pragma unroll
        for (int ai = 0; ai < 2; ++ai)
#pragma unroll
            for (int m = 0; m < 4; ++m) sa8[ai][m] = epl[ai * HALF + wr * 64 + m * 16 + fr];
        float invf[4];
#pragma unroll
        for (int i = 0; i < 4; ++i) invf[i] = __builtin_amdgcn_exp2f(-(float)(4 * fq + i) * (13.287712379549449f / 16.0f)) * 0.15915494309189535f;
#pragma unroll
        for (int bj = 0; bj < 2; ++bj) {
            const int colt = 128 * bj + 32 * wc + 8 * fq;
            const f32x4 sb0 = *(const PG8_LAS f32x4*)(epl + 256 + colt), sb1 = *(const PG8_LAS f32x4*)(epl + 256 + colt + 4);
            bf16_t* base; int pitch, row0, mode; float scl = 1.f;
            if (pn < 4)        { base = QA + (pn * 256 + colt);        pitch = 1024; row0 = qrow0; mode = 1; scl = c2; }
            else if (pn < 8)   { base = KA + ((pn - 4) * 256 + colt);  pitch = 1024; row0 = krow0; mode = ctx ? 0 : 1; }
            else if (pn < 12)  { base = VA + ((pn - 8) * 256 + colt);  pitch = 1024; row0 = krow0; mode = 0; }
            else if (pn < 16)  { base = QB + ((pn - 12) * 256 + colt); pitch = 1024; row0 = qrow0; mode = 1; scl = c2; }
            else if (pn == 16) { if (bj == 0) { base = KB + (32 * wc + 8 * fq); mode = ctx ? 0 : 1; } else { base = VB + (32 * wc + 8 * fq); mode = 0; } pitch = 128; row0 = krow0; }
            else if (pn < 25)  { base = GA + ((pn - 17) * 256 + colt); pitch = 2048; row0 = qrow0; mode = 2; }
            else               { base = GB + ((pn - 25) * 256 + colt); pitch = 2048; row0 = qrow0; mode = 2; }
#pragma unroll
            for (int ai = 0; ai < 2; ++ai)
#pragma unroll
                for (int m = 0; m < 4; ++m) {
                    const int row = ai * HALF + wr * 64 + m * 16 + fr;
                    const float sa = sa8[ai][m];
                    f32x4 v0 = __builtin_convertvector(acc[ai][bj][m][0], f32x4) * (sb0 * sa), v1 = __builtin_convertvector(acc[ai][bj][m][1], f32x4) * (sb1 * sa);
                    if (mode == 1) {
                        const float pos = (wc & 1) ? (float)(16 * m + fr) : (float)((pm & 15) * 4 + 2 * ai + wr);
#pragma unroll
                        for (int i = 0; i < 4; ++i) { float rev = pos * invf[i]; rev -= floorf(rev); const float cs = __builtin_amdgcn_cosf(rev), sn = __builtin_amdgcn_sinf(rev);
                            const float x1 = v0[i], x2 = v1[i]; v0[i] = x1 * cs - x2 * sn; v1[i] = x2 * cs + x1 * sn; }
                    } else if (mode == 2) {
#pragma unroll
                        for (int i = 0; i < 4; ++i) { v0[i] = sigmoidf_fast(v0[i]); v1[i] = sigmoidf_fast(v1[i]); }
                    }
                    v0 = v0 * scl; v1 = v1 * scl;
                    *(u32x4*)(base + (size_t)(row0 + row) * pitch) = pack8(v0, v1);
                }
        }
    }
};
struct EpiGate1 {
    typedef f32x4 AccT; static constexpr bool PERM = true, AFTER_DRAIN = false;
    __device__ __forceinline__ void stage(const Unit&, int, int) const {}
    const bf16_t* G; float* Y1;
    __device__ __forceinline__ void operator()(const f32x4 (&acc)[2][2][4][2], const Unit& u, int wr, int wc, int fr, int fq) const {
        u32x4 g[2][4][2];
#pragma unroll
        for (int ai = 0; ai < 2; ++ai)
#pragma unroll
            for (int m = 0; m < 4; ++m)
#pragma unroll
                for (int bj = 0; bj < 2; ++bj) g[ai][m][bj] = *(const u32x4*)(G + (size_t)(u.pm * BM + ai * HALF + wr * 64 + m * 16 + fr) * 2048 + (u.pn * BM + bj * HALF + wc * 32 + 8 * fq));
#pragma unroll
        for (int ai = 0; ai < 2; ++ai)
#pragma unroll
            for (int m = 0; m < 4; ++m)
#pragma unroll
                for (int bj = 0; bj < 2; ++bj) {
                    const size_t off = (size_t)(u.pm * BM + ai * HALF + wr * 64 + m * 16 + fr) * 2048 + (u.pn * BM + bj * HALF + wc * 32 + 8 * fq);
                    const u32x4 gg = g[ai][m][bj];
                    const f32x4 a0 = acc[ai][bj][m][0], a1 = acc[ai][bj][m][1];
                    f32x4 o0, o1; o0[0] = a0[0] * bf_lo(gg.x); o0[1] = a0[1] * bf_hi(gg.x); o0[2] = a0[2] * bf_lo(gg.y); o0[3] = a0[3] * bf_hi(gg.y);
                    o1[0] = a1[0] * bf_lo(gg.z); o1[1] = a1[1] * bf_hi(gg.z); o1[2] = a1[2] * bf_lo(gg.w); o1[3] = a1[3] * bf_hi(gg.w);
                    *(f32x4*)(Y1 + off) = o0; *(f32x4*)(Y1 + off + 4) = o1;
                }
    }
};
struct EpiGate2 {
    typedef f32x4 AccT; static constexpr bool PERM = true, AFTER_DRAIN = false;
    __device__ __forceinline__ void stage(const Unit&, int, int) const {}
    const bf16_t* G; const float* Y1; bf16_t* Y;
    __device__ __forceinline__ void operator()(const f32x4 (&acc)[2][2][4][2], const Unit& u, int wr, int wc, int fr, int fq) const {
#pragma unroll
        for (int ai = 0; ai < 2; ++ai)
#pragma unroll
            for (int mh = 0; mh < 2; ++mh) {
                u32x4 g[2][2]; f32x4 ya[2][2], yb[2][2];
#pragma unroll
                for (int mm = 0; mm < 2; ++mm)
#pragma unroll
                    for (int bj = 0; bj < 2; ++bj) { const size_t off = (size_t)(u.pm * BM + ai * HALF + wr * 64 + (2 * mh + mm) * 16 + fr) * 2048 + (u.pn * BM + bj * HALF + wc * 32 + 8 * fq);
                        g[mm][bj] = *(const u32x4*)(G + off); ya[mm][bj] = *(const f32x4*)(Y1 + off); yb[mm][bj] = *(const f32x4*)(Y1 + off + 4); }
#pragma unroll
                for (int mm = 0; mm < 2; ++mm)
#pragma unroll
                    for (int bj = 0; bj < 2; ++bj) { const int m = 2 * mh + mm; const size_t off = (size_t)(u.pm * BM + ai * HALF + wr * 64 + m * 16 + fr) * 2048 + (u.pn * BM + bj * HALF + wc * 32 + 8 * fq);
                        const u32x4 gg = g[mm][bj]; const f32x4 y0 = ya[mm][bj], y1 = yb[mm][bj], a0 = acc[ai][bj][m][0], a1 = acc[ai][bj][m][1];
                        f32x4 o0, o1; o0[0] = y0[0] + a0[0] * bf_lo(gg.x); o0[1] = y0[1] + a0[1] * bf_hi(gg.x); o0[2] = y0[2] + a0[2] * bf_lo(gg.y); o0[3] = y0[3] + a0[3] * bf_hi(gg.y);
                        o1[0] = y1[0] + a1[0] * bf_lo(gg.z); o1[1] = y1[1] + a1[1] * bf_hi(gg.z); o1[2] = y1[2] + a1[2] * bf_lo(gg.w); o1[3] = y1[3] + a1[3] * bf_hi(gg.w);
                        *(u32x4*)(Y + off) = pack8(o0, o1); }
            }
    }
};
struct EpiGate1Q {
    typedef i32x4 AccT; static constexpr bool PERM = true, AFTER_DRAIN = false;
    const bf16_t* G; float* Y1;
    const float* SR; const float* SC; PG8_LAS float* epl;
    __device__ __forceinline__ void stage(const Unit& u, int wid, int lane) const { const float* p = wid < 4 ? SR + u.pm * 256 + wid * 64 : SC + u.pn * 256 + (wid - 4) * 64;
        __builtin_amdgcn_global_load_lds((const unsigned*)(p + (unsigned)lane), (PG8_LAS unsigned*)(epl + wid * 64), 4, 0, 0); }
    __device__ __forceinline__ void operator()(const i32x4 (&acc)[2][2][4][2], const Unit& u, int wr, int wc, int fr, int fq) const {
#pragma unroll
        for (int ai = 0; ai < 2; ++ai) {
            u32x4 g[4][2];
#pragma unroll
            for (int m = 0; m < 4; ++m)
#pragma unroll
                for (int bj = 0; bj < 2; ++bj) g[m][bj] = *(const u32x4*)(G + (size_t)(u.pm * BM + ai * HALF + wr * 64 + m * 16 + fr) * 2048 + (u.pn * BM + bj * HALF + wc * 32 + 8 * fq));
#pragma unroll
            for (int m = 0; m < 4; ++m) {
                const float sa = epl[ai * HALF + wr * 64 + m * 16 + fr];
#pragma unroll
                for (int bj = 0; bj < 2; ++bj) {
                    const size_t off = (size_t)(u.pm * BM + ai * HALF + wr * 64 + m * 16 + fr) * 2048 + (u.pn * BM + bj * HALF + wc * 32 + 8 * fq);
                    const u32x4 gg = g[m][bj]; const PG8_LAS float* ec = epl + 256 + bj * HALF + wc * 32 + 8 * fq;
                    const f32x4 a0 = __builtin_convertvector(acc[ai][bj][m][0], f32x4) * (*(const PG8_LAS f32x4*)ec * sa), a1 = __builtin_convertvector(acc[ai][bj][m][1], f32x4) * (*(const PG8_LAS f32x4*)(ec + 4) * sa);
                    f32x4 o0, o1; o0[0] = a0[0] * bf_lo(gg.x); o0[1] = a0[1] * bf_hi(gg.x); o0[2] = a0[2] * bf_lo(gg.y); o0[3] = a0[3] * bf_hi(gg.y);
                    o1[0] = a1[0] * bf_lo(gg.z); o1[1] = a1[1] * bf_hi(gg.z); o1[2] = a1[2] * bf_lo(gg.w); o1[3] = a1[3] * bf_hi(gg.w);
                    *(f32x4*)(Y1 + off) = o0; *(f32x4*)(Y1 + off + 4) = o1;
                }
            }
        }
    }
};
struct EpiGate2Q {
    typedef i32x4 AccT; static constexpr bool PERM = true, AFTER_DRAIN = false;
    const bf16_t* G; const float* Y1; unsigned char* YQ; float* RMAXY;
    const float* SR; const float* SC; PG8_LAS float* epl;
    __device__ __forceinline__ void stage(const Unit& u, int wid, int lane) const { const float* p = wid < 4 ? SR + u.pm * 256 + wid * 64 : SC + u.pn * 256 + (wid - 4) * 64;
        __builtin_amdgcn_global_load_lds((const unsigned*)(p + (unsigned)lane), (PG8_LAS unsigned*)(epl + wid * 64), 4, 0, 0); }
    __device__ __forceinline__ void operator()(const i32x4 (&acc)[2][2][4][2], const Unit& u, int wr, int wc, int fr, int fq) const {
#pragma unroll
        for (int ai = 0; ai < 2; ++ai)
#pragma unroll
            for (int mh = 0; mh < 2; ++mh) {
                u32x4 g[2][2]; f32x4 ya[2][2], yb[2][2];
#pragma unroll
                for (int mm = 0; mm < 2; ++mm)
#pragma unroll
                    for (int bj = 0; bj < 2; ++bj) { const size_t off = (size_t)(u.pm * BM + ai * HALF + wr * 64 + (2 * mh + mm) * 16 + fr) * 2048 + (u.pn * BM + bj * HALF + wc * 32 + 8 * fq);
                        g[mm][bj] = *(const u32x4*)(G + off); ya[mm][bj] = *(const f32x4*)(Y1 + off); yb[mm][bj] = *(const f32x4*)(Y1 + off + 4); }
#pragma unroll
                for (int mm = 0; mm < 2; ++mm)
#pragma unroll
                    for (int bj = 0; bj < 2; ++bj) { const int m = 2 * mh + mm; const size_t off = (size_t)(u.pm * BM + ai * HALF + wr * 64 + m * 16 + fr) * 2048 + (u.pn * BM + bj * HALF + wc * 32 + 8 * fq);
                        const u32x4 gg = g[mm][bj]; const float sa = epl[ai * HALF + wr * 64 + m * 16 + fr]; const PG8_LAS float* ec = epl + 256 + bj * HALF + wc * 32 + 8 * fq;
                        const f32x4 y0 = ya[mm][bj], y1 = yb[mm][bj], a0 = __builtin_convertvector(acc[ai][bj][m][0], f32x4) * (*(const PG8_LAS f32x4*)ec * sa), a1 = __builtin_convertvector(acc[ai][bj][m][1], f32x4) * (*(const PG8_LAS f32x4*)(ec + 4) * sa);
                        f32x4 o0, o1; o0[0] = y0[0] + a0[0] * bf_lo(gg.x); o0[1] = y0[1] + a0[1] * bf_hi(gg.x); o0[2] = y0[2] + a0[2] * bf_lo(gg.y); o0[3] = y0[3] + a0[3] * bf_hi(gg.y);
                        o1[0] = y1[0] + a1[0] * bf_lo(gg.z); o1[1] = y1[1] + a1[1] * bf_hi(gg.z); o1[2] = y1[2] + a1[2] * bf_lo(gg.w); o1[3] = y1[3] + a1[3] * bf_hi(gg.w);
                        float mx = fmaxf(fmaxf(fmaxf(fabsf(o0[0]), fabsf(o0[1])), fmaxf(fabsf(o0[2]), fabsf(o0[3]))), fmaxf(fmaxf(fabsf(o1[0]), fabsf(o1[1])), fmaxf(fabsf(o1[2]), fabsf(o1[3]))));
                        mx = lane_max_16_32(mx);
                        const float qi = mx > 0.f ? 127.0f * __builtin_amdgcn_rcpf(mx) : 0.f;
                        typedef unsigned u2_t __attribute__((ext_vector_type(2))); u2_t w; w.x = q4p(o0[0], o0[1], o0[2], o0[3], qi); w.y = q4p(o1[0], o1[1], o1[2], o1[3], qi);
                        *(u2_t*)(YQ + off) = w;
                        if (fq == 0) RMAXY[(size_t)(u.pm * BM + ai * HALF + wr * 64 + m * 16 + fr) * 64 + u.pn * 8 + bj * 4 + wc] = mx; }
            }
    }
};
struct EpiOut {
    typedef f32x4 AccT; static constexpr bool PERM = true, AFTER_DRAIN = false;
    __device__ __forceinline__ void stage(const Unit&, int, int) const {}
    const float* X; const float* mod; float* R; float alpha;
    __device__ __forceinline__ void operator()(const f32x4 (&acc)[2][2][4][2], const Unit& u, int wr, int wc, int fr, int fq) const {
        const float* g1 = mod + (size_t)(u.pm >> 4) * 12288 + 4096;
#pragma unroll
        for (int bj = 0; bj < 2; ++bj) {
            const int col = u.pn * BM + bj * HALF + wc * 32 + 8 * fq;
            const f32x4 ga = *(const f32x4*)(g1 + col), gb = *(const f32x4*)(g1 + col + 4);
#pragma unroll
            for (int ai = 0; ai < 2; ++ai) {
                f32x4 xa[4], xb[4];
#pragma unroll
                for (int m = 0; m < 4; ++m) { const size_t off = (size_t)(u.pm * BM + ai * HALF + wr * 64 + m * 16 + fr) * 2048 + col; xa[m] = *(const f32x4*)(X + off); xb[m] = *(const f32x4*)(X + off + 4); }
#pragma unroll
                for (int m = 0; m < 4; ++m) {
                    const size_t off = (size_t)(u.pm * BM + ai * HALF + wr * 64 + m * 16 + fr) * 2048 + col;
                    *(f32x4*)(R + off) = xa[m] * alpha + ga * acc[ai][bj][m][0]; *(f32x4*)(R + off + 4) = xb[m] * alpha + gb * acc[ai][bj][m][1];
                }
            }
        }
    }
};
struct EpiOutQ {
    typedef i32x4 AccT; static constexpr bool PERM = true, AFTER_DRAIN = false;
    const float* X; const float* mod; float* R; float alpha;
    const float* SR; const float* SC; PG8_LAS float* epl;
    __device__ __forceinline__ void stage(const Unit& u, int wid, int lane) const { const float* p = wid < 4 ? SR + u.pm * 256 + wid * 64 : SC + u.pn * 256 + (wid - 4) * 64;
        __builtin_amdgcn_global_load_lds((const unsigned*)(p + (unsigned)lane), (PG8_LAS unsigned*)(epl + wid * 64), 4, 0, 0); }
    __device__ __forceinline__ void operator()(const i32x4 (&acc)[2][2][4][2], const Unit& u, int wr, int wc, int fr, int fq) const {
        const float* g1 = mod + (size_t)(u.pm >> 4) * 12288 + 4096;
#pragma unroll
        for (int bj = 0; bj < 2; ++bj) {
            const int col = u.pn * BM + bj * HALF + wc * 32 + 8 * fq;
            const PG8_LAS float* ec = epl + 256 + bj * HALF + wc * 32 + 8 * fq;
            const f32x4 ga = *(const f32x4*)(g1 + col) * *(const PG8_LAS f32x4*)ec, gb = *(const f32x4*)(g1 + col + 4) * *(const PG8_LAS f32x4*)(ec + 4);
#pragma unroll
            for (int ai = 0; ai < 2; ++ai) {
                f32x4 xa[4], xb[4];
#pragma unroll
                for (int m = 0; m < 4; ++m) { const size_t off = (size_t)(u.pm * BM + ai * HALF + wr * 64 + m * 16 + fr) * 2048 + col; xa[m] = *(const f32x4*)(X + off); xb[m] = *(const f32x4*)(X + off + 4); }
#pragma unroll
                for (int m = 0; m < 4; ++m) {
                    const size_t off = (size_t)(u.pm * BM + ai * HALF + wr * 64 + m * 16 + fr) * 2048 + col;
                    const float sa = epl[ai * HALF + wr * 64 + m * 16 + fr];
                    *(f32x4*)(R + off) = xa[m] * alpha + (ga * sa) * __builtin_convertvector(acc[ai][bj][m][0], f32x4); *(f32x4*)(R + off + 4) = xb[m] * alpha + (gb * sa) * __builtin_convertvector(acc[ai][bj][m][1], f32x4);
                }
            }
        }
    }
};
struct EpiUp {
    typedef f32x4 AccT; static constexpr bool PERM = true, AFTER_DRAIN = false;
    __device__ __forceinline__ void stage(const Unit&, int, int) const {}
    const float* bup; bf16_t* ACT;
    __device__ __forceinline__ void operator()(const f32x4 (&acc)[2][2][4][2], const Unit& u, int wr, int wc, int fr, int fq) const {
        const int e = u.pb >> 4, col = u.pn * 128 + wc * 32 + 8 * fq;
        const float* bg = bup + (size_t)e * 4096 + col; const float* bl = bg + 2048;
        const f32x4 bg0 = *(const f32x4*)bg, bg1 = *(const f32x4*)(bg + 4), bl0 = *(const f32x4*)bl, bl1 = *(const f32x4*)(bl + 4);
#pragma unroll
        for (int ai = 0; ai < 2; ++ai)
#pragma unroll
            for (int m = 0; m < 4; ++m) {
                const size_t off = (size_t)(u.pm * BM + ai * HALF + wr * 64 + m * 16 + fr) * 2048 + col;
                f32x4 g0 = acc[ai][0][m][0] + bg0, g1 = acc[ai][0][m][1] + bg1, l0 = acc[ai][1][m][0] + bl0, l1 = acc[ai][1][m][1] + bl1, o0, o1;
#pragma unroll
                for (int i = 0; i < 4; ++i) {
                    const float xg0 = fminf(g0[i], 7.0f), xl0 = fminf(fmaxf(l0[i], -7.0f), 7.0f); o0[i] = xg0 * sigmoidf_fast(1.702f * xg0) * (xl0 + 1.0f);
                    const float xg1 = fminf(g1[i], 7.0f), xl1 = fminf(fmaxf(l1[i], -7.0f), 7.0f); o1[i] = xg1 * sigmoidf_fast(1.702f * xg1) * (xl1 + 1.0f);
                }
                *(u32x4*)(ACT + off) = pack8(o0, o1);
            }
    }
};
struct EpiUpQ {
    typedef i32x4 AccT; static constexpr bool PERM = true, AFTER_DRAIN = false;
    const float* bup; unsigned char* ACTP; const float* SA; const float* SB; const int* pos_slot; const PG8_LAS int* cnt; const PG8_LAS int* pstart; float* RMAXP; const PG8_LAS float* sclL; PG8_LAS float* epl;
    __device__ __forceinline__ void stage(const Unit& u, int wid, int lane) const { const int e = u.pb >> 4;
        const float* p = wid < 2 ? bup + (size_t)e * 4096 + u.pn * 128 + wid * 64 : wid < 4 ? bup + (size_t)e * 4096 + 2048 + u.pn * 128 + (wid - 2) * 64 : SB + (size_t)e * 4096 + u.pn * 256 + (wid - 4) * 64;
        __builtin_amdgcn_global_load_lds((const unsigned*)(p + (unsigned)lane), (PG8_LAS unsigned*)(epl + wid * 64), 4, 0, 0); }
    __device__ __forceinline__ void operator()(const i32x4 (&acc)[2][2][4][2], const Unit& u, int wr, int wc, int fr, int fq) const {
        const int e = u.pb >> 4, col = u.pn * 128 + wc * 32 + 8 * fq, lim = pstart[e] + cnt[e], vb = e * 16384 - pstart[e]; (void)e;
        const PG8_LAS float* ec = epl + wc * 32 + 8 * fq;
        const f32x4 bg0 = *(const PG8_LAS f32x4*)ec, bg1 = *(const PG8_LAS f32x4*)(ec + 4), bl0 = *(const PG8_LAS f32x4*)(ec + 128), bl1 = *(const PG8_LAS f32x4*)(ec + 132);
        const f32x4 sg0 = *(const PG8_LAS f32x4*)(ec + 256), sg1 = *(const PG8_LAS f32x4*)(ec + 260), sl0 = *(const PG8_LAS f32x4*)(ec + 384), sl1 = *(const PG8_LAS f32x4*)(ec + 388);
#pragma unroll
        for (int ai = 0; ai < 2; ++ai)
#pragma unroll
            for (int m = 0; m < 4; ++m) {
                const int pos = u.pm * BM + ai * HALF + wr * 64 + m * 16 + fr; const size_t off = (size_t)pos * 2048 + col;
                const float sa = sclL[u.ord * 256 + ai * HALF + wr * 64 + m * 16 + fr]; (void)lim; (void)vb;
                const f32x4 g0 = __builtin_convertvector(acc[ai][0][m][0], f32x4) * (sg0 * sa) + bg0, g1 = __builtin_convertvector(acc[ai][0][m][1], f32x4) * (sg1 * sa) + bg1;
                const f32x4 l0 = __builtin_convertvector(acc[ai][1][m][0], f32x4) * (sl0 * sa) + bl0, l1 = __builtin_convertvector(acc[ai][1][m][1], f32x4) * (sl1 * sa) + bl1;
                f32x4 xg0, xg1, xl0, xl1;
#pragma unroll
                for (int i = 0; i < 4; ++i) { xg0[i] = fminf(g0[i], 7.0f); xg1[i] = fminf(g1[i], 7.0f); xl0[i] = __builtin_amdgcn_fmed3f(l0[i], -7.0f, 7.0f); xl1[i] = __builtin_amdgcn_fmed3f(l1[i], -7.0f, 7.0f); }
                const f32x4 t0 = xg0 * -2.4554669595930157f, t1 = xg1 * -2.4554669595930157f;
                f32x4 e0, e1;
#pragma unroll
                for (int i = 0; i < 4; ++i) { e0[i] = __builtin_amdgcn_exp2f(t0[i]); e1[i] = __builtin_amdgcn_exp2f(t1[i]); }
                const f32x4 d0 = e0 + 1.0f, d1 = e1 + 1.0f;
                f32x4 r0, r1;
#pragma unroll
                for (int i = 0; i < 4; ++i) { r0[i] = __builtin_amdgcn_rcpf(d0[i]); r1[i] = __builtin_amdgcn_rcpf(d1[i]); }
                const f32x4 o0 = (xg0 * r0) * (xl0 + 1.0f), o1 = (xg1 * r1) * (xl1 + 1.0f);
                float mx = fmaxf(fmaxf(fmaxf(fabsf(o0[0]), fabsf(o0[1])), fmaxf(fabsf(o0[2]), fabsf(o0[3]))), fmaxf(fmaxf(fabsf(o1[0]), fabsf(o1[1])), fmaxf(fabsf(o1[2]), fabsf(o1[3]))));
                mx = lane_max_16_32(mx);
                const float qi = mx > 0.f ? 127.0f * __builtin_amdgcn_rcpf(mx) : 0.f;
                const f32x4 q0 = o0 * qi + 12582912.0f, q1 = o1 * qi + 12582912.0f;
                typedef unsigned u2_t __attribute__((ext_vector_type(2))); u2_t w;
                w.x = __builtin_amdgcn_perm(__builtin_amdgcn_perm(__float_as_uint(q0[3]), __float_as_uint(q0[2]), 0x0c0c0400u), __builtin_amdgcn_perm(__float_as_uint(q0[1]), __float_as_uint(q0[0]), 0x0c0c0400u), 0x05040100u);
                w.y = __builtin_amdgcn_perm(__builtin_amdgcn_perm(__float_as_uint(q1[3]), __float_as_uint(q1[2]), 0x0c0c0400u), __builtin_amdgcn_perm(__float_as_uint(q1[1]), __float_as_uint(q1[0]), 0x0c0c0400u), 0x05040100u);
                *(u2_t*)(ACTP + off) = w;
                if (fq == 0) RMAXP[((size_t)pos * 16 + u.pn) * 4 + wc] = mx;
            }
    }
};
struct EpiDown {
    typedef f32x4 AccT; static constexpr bool PERM = true, AFTER_DRAIN = false;
    __device__ __forceinline__ void stage(const Unit&, int, int) const {}
    const float* bdn; bf16_t* YS; const int* pos_slot; const float* pos_gate; const PG8_LAS int* cnt; const PG8_LAS int* pstart;
    __device__ __forceinline__ void operator()(const f32x4 (&acc)[2][2][4][2], const Unit& u, int wr, int wc, int fr, int fq) const {
        const int e = u.pb >> 3; const int lim = pstart[e] + cnt[e], vb = e * 16384 - pstart[e];
        f32x4 bv[2][2];
#pragma unroll
        for (int bj = 0; bj < 2; ++bj) { const float* bp = bdn + (size_t)e * 2048 + u.pn * BM + bj * HALF + wc * 32 + 8 * fq; bv[bj][0] = *(const f32x4*)bp; bv[bj][1] = *(const f32x4*)(bp + 4); }
#pragma unroll
        for (int ai = 0; ai < 2; ++ai)
#pragma unroll
            for (int m = 0; m < 4; ++m) {
                const int pos = u.pm * BM + ai * HALF + wr * 64 + m * 16 + fr;
                if (pos < lim) {
                    const int slot = pos_slot[vb + pos]; const float gt = pos_gate[vb + pos];
#pragma unroll
                    for (int bj = 0; bj < 2; ++bj) {
                        const f32x4 o0 = (acc[ai][bj][m][0] + bv[bj][0]) * gt, o1 = (acc[ai][bj][m][1] + bv[bj][1]) * gt;
                        *(u32x4*)(YS + (size_t)slot * 2048 + u.pn * BM + bj * HALF + wc * 32 + 8 * fq) = pack8(o0, o1);
                    }
                }
            }
    }
};
struct EpiDownQ {
    typedef i32x4 AccT; static constexpr bool PERM = true, AFTER_DRAIN = false;
    const float* bdn; bf16_t* YS; const int* pos_slot; const float* pos_gate; const PG8_LAS int* cnt; const PG8_LAS int* pstart; const float* SACT; const float* SBD; PG8_LAS float* epl; int probe_skip = 0;
    __device__ __forceinline__ void stage(const Unit& u, int wid, int lane) const { const int e = u.pb >> 3;
        if (wid < 4) { const int lim = pstart[e] + cnt[e], r0 = u.pm * BM + wid * 64; const int row = min(r0 + lane, lim - 1); const size_t vb = (size_t)(e * 16384 - pstart[e]);
            __builtin_amdgcn_global_load_lds((const unsigned*)(pos_gate + vb) + (unsigned)row, (PG8_LAS unsigned*)(epl + wid * 64), 4, 0, 0);
            __builtin_amdgcn_global_load_lds((const unsigned*)SACT + (unsigned)row, (PG8_LAS unsigned*)(epl + 256 + wid * 64), 4, 0, 0); }
        else { const size_t ci = (size_t)e * 2048 + u.pn * BM + (wid - 4) * 64;
            __builtin_amdgcn_global_load_lds((const unsigned*)(bdn + ci) + (unsigned)lane, (PG8_LAS unsigned*)(epl + 512 + (wid - 4) * 64), 4, 0, 0);
            __builtin_amdgcn_global_load_lds((const unsigned*)(SBD + ci) + (unsigned)lane, (PG8_LAS unsigned*)(epl + 768 + (wid - 4) * 64), 4, 0, 0); } }
    __device__ __forceinline__ void operator()(const i32x4 (&acc)[2][2][4][2], const Unit& u, int wr, int wc, int fr, int fq) const {
        if (probe_skip) return;
        f32x4 bv[2][2], sv[2][2];
#pragma unroll
        for (int bj = 0; bj < 2; ++bj) { const PG8_LAS float* ec = epl + 512 + bj * HALF + wc * 32 + 8 * fq; bv[bj][0] = *(const PG8_LAS f32x4*)ec; bv[bj][1] = *(const PG8_LAS f32x4*)(ec + 4);
            sv[bj][0] = *(const PG8_LAS f32x4*)(ec + 256); sv[bj][1] = *(const PG8_LAS f32x4*)(ec + 260); }
#pragma unroll
        for (int ai = 0; ai < 2; ++ai)
#pragma unroll
            for (int m = 0; m < 4; ++m) {
                const int r = ai * HALF + wr * 64 + m * 16 + fr; const float gt = epl[r], sa = epl[256 + r];
                bf16_t* yr = YS + (size_t)(u.pm * BM + r) * 2048 + u.pn * BM + wc * 32 + 8 * fq;
#pragma unroll
                for (int bj = 0; bj < 2; ++bj) {
                    const f32x4 o0 = (__builtin_convertvector(acc[ai][bj][m][0], f32x4) * (sv[bj][0] * sa) + bv[bj][0]) * gt, o1 = (__builtin_convertvector(acc[ai][bj][m][1], f32x4) * (sv[bj][1] * sa) + bv[bj][1]) * gt;
                    *(u32x4*)(yr + bj * HALF) = pack8(o0, o1);
                }
            }
    }
};
}
namespace attn_body {
using bf16=__hip_bfloat16;
using bf16x8=__attribute__((ext_vector_type(8)))short;
using s16x4=__attribute__((ext_vector_type(4)))short;
using f32x16=__attribute__((ext_vector_type(16)))float;
using u32x4=__attribute__((ext_vector_type(4)))unsigned;
constexpr int D=64;
constexpr int NW=8,QBLK=32,QB=QBLK*NW,KVBLK=64;
constexpr int ATTN_UNIT_ROWS=QB;
__device__ __forceinline__ int crow(int r,int hi){return (r&3)+8*(r>>2)+4*hi;}
#define SBAR() __builtin_amdgcn_sched_barrier(0)
__device__ __forceinline__ void wmask(f32x16&p0,f32x16&p1,int kpos0,int qpos,int hi){
  const float NEG=-INFINITY; const int kb=kpos0+4*hi-qpos;
  #pragma unroll
  for(int r=0;r<16;++r){const int d=kb+(r&3)+8*(r>>2); if(d>128||d<-128)p0[r]=NEG; if(d+32>128||d+32<-128)p1[r]=NEG;}
}
constexpr int NSLOT=3, SLOTB=8192;
constexpr int LDS_K=0, LDS_V=NSLOT*SLOTB, LDS_WS=2*NSLOT*SLOTB, LDS_OST=LDS_WS+NW*64*4, LDS_BYTES=LDS_OST+NW*4096;
constexpr float C2=0.125f*1.4426950408889634f;
__device__ __forceinline__ void glds16(const void*gsrc,unsigned lds_dst){unsigned keep;
  asm volatile("s_mov_b32 %0, m0\n\ts_mov_b32 m0, %2\n\ts_nop 0\n\tglobal_load_lds_dwordx4 %1, off\n\ts_mov_b32 m0, %0":"=&s"(keep):"v"(gsrc),"s"(lds_dst):"memory");}
__device__ __forceinline__ float max3f(float a,float b,float c){float r;asm("v_max3_f32 %0, %1, %2, %3":"=v"(r):"v"(a),"v"(b),"v"(c));return r;}
__device__ __forceinline__ float max2f(float a,float b){float r;asm("v_max_f32_e32 %0, %1, %2":"=v"(r):"v"(a),"v"(b));return r;}
__device__ __forceinline__ float fadd_s(float a,float b){float r;asm("v_add_f32_e32 %0, %1, %2":"=v"(r):"v"(a),"v"(b));return r;}
__device__ __forceinline__ float fsub_s(float a,float b){float r;asm("v_sub_f32_e32 %0, %1, %2":"=v"(r):"v"(a),"v"(b));return r;}
typedef float f32x2_t __attribute__((ext_vector_type(2))); typedef __bf16 bf16x2_t __attribute__((ext_vector_type(2)));
__device__ __forceinline__ unsigned cvtpk_s(float lo,float hi){f32x2_t v={lo,hi};bf16x2_t b=__builtin_convertvector(v,bf16x2_t);return __builtin_bit_cast(unsigned,b);}
#define WAIT_BAR(N) asm volatile("s_waitcnt vmcnt(" #N ") lgkmcnt(0)\n\ts_barrier":::"memory")

__device__ __forceinline__ void qkt(f32x16&p0,f32x16&p1,const char*Kslot,const bf16x8*qr,const f32x16&negm,int r32,int hi){
  const char*kb=Kslot+hi*1024+r32*16;
  #pragma unroll
  for(int d0=0;d0<4;++d0){
    const bf16x8 b0=*reinterpret_cast<const bf16x8*>(kb+d0*2048);
    const bf16x8 b1=*reinterpret_cast<const bf16x8*>(kb+d0*2048+512);
    if(d0==0){p0=__builtin_amdgcn_mfma_f32_32x32x16_bf16(b0,qr[0],negm,0,0,0);p1=__builtin_amdgcn_mfma_f32_32x32x16_bf16(b1,qr[0],negm,0,0,0);}
    else{p0=__builtin_amdgcn_mfma_f32_32x32x16_bf16(b0,qr[d0],p0,0,0,0);p1=__builtin_amdgcn_mfma_f32_32x32x16_bf16(b1,qr[d0],p1,0,0,0);}}
}
typedef __attribute__((address_space(3))) const char* lds_cptr;
typedef short v4i16_t __attribute__((ext_vector_type(4)));
__device__ __forceinline__ void kload8(bf16x8*kf,lds_cptr kp){
  kf[0]=*(const __attribute__((address_space(3))) bf16x8*)(kp);      kf[1]=*(const __attribute__((address_space(3))) bf16x8*)(kp+512);
  kf[2]=*(const __attribute__((address_space(3))) bf16x8*)(kp+2048); kf[3]=*(const __attribute__((address_space(3))) bf16x8*)(kp+2560);
  kf[4]=*(const __attribute__((address_space(3))) bf16x8*)(kp+4096); kf[5]=*(const __attribute__((address_space(3))) bf16x8*)(kp+4608);
  kf[6]=*(const __attribute__((address_space(3))) bf16x8*)(kp+6144); kf[7]=*(const __attribute__((address_space(3))) bf16x8*)(kp+6656);
}
__device__ __forceinline__ void kload2(bf16x8*kf,lds_cptr kp,int j){ kf[2*j]=*(const __attribute__((address_space(3))) bf16x8*)(kp+j*2048); kf[2*j+1]=*(const __attribute__((address_space(3))) bf16x8*)(kp+j*2048+512); }
__device__ __forceinline__ s16x4 vtr(lds_cptr p){ return __builtin_bit_cast(s16x4,__builtin_amdgcn_ds_read_tr16_b64_v4i16((__attribute__((address_space(3))) v4i16_t*)p)); }
__device__ __forceinline__ float rowmax(const f32x16&p0,const f32x16&p1){
  float a=max3f(p0[0],p0[1],p1[0]),b=max3f(p0[2],p0[3],p1[1]);a=max3f(a,p1[2],p1[3]);
  #pragma unroll
  for(int r=4;r<16;r+=4){a=max3f(a,p0[r],p0[r+1]);b=max3f(b,p0[r+2],p0[r+3]);a=max3f(a,p1[r],p1[r+1]);b=max3f(b,p1[r+2],p1[r+3]);}
  const float m=max2f(a,b);
  auto rr=__builtin_amdgcn_permlane32_swap(__float_as_uint(m),__float_as_uint(m),false,false);
  return max2f(__uint_as_float(rr[0]),__uint_as_float(rr[1]));
}
__device__ __forceinline__ void pv(f32x16*o,int vb,bf16x8 pa0,bf16x8 pa1,bf16x8 pa2,bf16x8 pa3){
  #pragma unroll
  for(int d0=0;d0<2;++d0){s16x4 lo[4],hi[4];
    #pragma unroll
    for(int ks=0;ks<4;++ks){
      asm volatile("ds_read_b64_tr_b16 %0,%1 offset:%c2":"=&v"(lo[ks]):"v"(vb),"i"(d0*4096+ks*1024):"memory");
      asm volatile("ds_read_b64_tr_b16 %0,%1 offset:%c2":"=&v"(hi[ks]):"v"(vb),"i"(d0*4096+ks*1024+512):"memory");}
    asm volatile("s_waitcnt lgkmcnt(0)":::"memory");SBAR();
    #define PK(k) (bf16x8){lo[k][0],lo[k][1],lo[k][2],lo[k][3],hi[k][0],hi[k][1],hi[k][2],hi[k][3]}
    o[d0]=__builtin_amdgcn_mfma_f32_32x32x16_bf16(pa0,PK(0),o[d0],0,0,0);
    o[d0]=__builtin_amdgcn_mfma_f32_32x32x16_bf16(pa1,PK(1),o[d0],0,0,0);
    o[d0]=__builtin_amdgcn_mfma_f32_32x32x16_bf16(pa2,PK(2),o[d0],0,0,0);
    o[d0]=__builtin_amdgcn_mfma_f32_32x32x16_bf16(pa3,PK(3),o[d0],0,0,0);
    #undef PK
  }
}

#ifndef ATTN_STORE16
#define ATTN_STORE16(p,v) (*(u32x4*)(p)=(v))
#endif
struct AttnArgs { const bf16* Qw0; const bf16* Kh; const bf16* Vh; bf16* Ow0; int NT; int win0; int qpos0; float sinkl2; };
template<class C,int THRL> __device__ __forceinline__ void attn_unit(const AttnArgs& aa,char*shm){
  int tid_=threadIdx.x; asm volatile("":"+v"(tid_)); const int tid=tid_,lane=tid&63,r32=lane&31,hi=lane>>5; const int wid=__builtin_amdgcn_readfirstlane(tid>>6);
  const bf16*Qw=aa.Qw0+(long)(wid*QBLK)*C::QP;
  const bf16*Kh=aa.Kh,*Vh=aa.Vh; const int win0=aa.win0;
  const unsigned lds0=(unsigned)(uintptr_t)shm;
  float*wsf=(float*)(shm+LDS_WS)+wid*64;
  const bf16*ksrc=Kh+(long)lane*C::KP+wid*8;
  const bf16*vsrc=Vh+(long)(16*(wid&3)+(lane>>2))*C::VP+(wid>>2)*32+(lane&3)*8;
  const unsigned kdst=lds0+LDS_K+wid*1024, vdst=lds0+LDS_V+wid*1024;
  #define KROW(t) (C::MASK ? ((t)<4 ? 4096+64*(t) : win0+64*((t)-4)) : 64*(t))
  #define DMA_K(t,slot) glds16(ksrc+(long)KROW(t)*C::KP,(unsigned)__builtin_amdgcn_readfirstlane(kdst+(slot)))
  #define DMA_V(t,slot) glds16(vsrc+(long)KROW(t)*C::VP,(unsigned)__builtin_amdgcn_readfirstlane(vdst+(slot)))
  const int vb0=(int)(lds0+LDS_V)+((lane>>4)&1)*32+(lane&3)*8+(4*hi+((lane&15)>>2))*64;
  const char*Kbase=shm+LDS_K; bf16x8 kf[8];
  const lds_cptr shm3=(lds_cptr)shm; const lds_cptr kp0=shm3+LDS_K+hi*1024+r32*16; const lds_cptr vp0=shm3+LDS_V+((lane>>4)&1)*32+(lane&3)*8+(4*hi+((lane&15)>>2))*64;
  const int NT=aa.NT;
  DMA_K(0,0);DMA_V(0,0);DMA_K(1,SLOTB);
  bf16x8 qr[4];
  #pragma unroll
  for(int d0=0;d0<4;++d0)qr[d0]=*reinterpret_cast<const bf16x8*>(&Qw[(long)r32*C::QP+d0*16+hi*8]);
  float mhat=0.f,l_reg=0.f;f32x16 o[2];o[0]=f32x16{};o[1]=f32x16{};f32x16 negm=f32x16{};asm volatile("":"+v"(negm));
  const int qpos=aa.qpos0+wid*QBLK+r32;
  #define CMASK(P0,P1,t) do{ if(C::MASK){ if((t)>=4) wmask(P0,P1,win0+64*((t)-4),qpos,hi); } }while(0)
  bool resc=false;
  #define START(P0,P1) do{ const float rm=rowmax(P0,P1); resc=false; \
    { const float dl=rm; mhat=fadd_s(mhat,dl); \
      _Pragma("unroll") for(int r=0;r<16;++r){P0[r]=fsub_s(P0[r],dl);P1[r]=fsub_s(P1[r],dl);} \
      _Pragma("unroll") for(int r=0;r<16;++r)negm[r]=-mhat; asm volatile("":"+v"(negm)); } \
    _Pragma("unroll") for(int r=0;r<16;++r)P0[r]=__builtin_amdgcn_exp2f(P0[r]); }while(0)
  #define RESC() do{ if(resc){ asm volatile("s_waitcnt lgkmcnt(0)":::"memory"); \
      _Pragma("unroll") for(int d_=0;d_<2;++d_) _Pragma("unroll") for(int r=0;r<16;++r)o[d_][r]*=wsf[crow(r,hi)]; } }while(0)
  f32x16 pA0,pA1,pB0,pB1;
  int sl_prev=0,sl_cur=0,sl_next=SLOTB;
  #define ROT() do{sl_prev=sl_cur;sl_cur=sl_next;sl_next=(sl_next==(NSLOT-1)*SLOTB)?0:sl_next+SLOTB;}while(0)
  DMA_K(2,2*SLOTB);
  WAIT_BAR(3);
  qkt(pA0,pA1,Kbase,qr,negm,r32,hi);asm volatile("s_nop 15\n\ts_nop 7":"+v"(pA0),"+v"(pA1));CMASK(pA0,pA1,0);
  START(pA0,pA1);
  _Pragma("unroll") for(int r=0;r<16;++r)pA1[r]=__builtin_amdgcn_exp2f(pA1[r]);
  WAIT_BAR(0);
  DMA_K(3,0);DMA_V(1,SLOTB);
  ROT();
  kload8(kf,kp0+sl_cur);
  WAIT_BAR(2);
  s16x4 vlo[8],vhi[8]; u32x4 pw0,pw1,pw2,pw3;
  #define PKW(P,B) cvtpk_s(P[B],P[B+1])
  #define PAF(k) __builtin_bit_cast(bf16x8,pw##k)
  #define VFR(i) (bf16x8){vlo[i][0],vlo[i][1],vlo[i][2],vlo[i][3],vhi[i][0],vhi[i][1],vhi[i][2],vhi[i][3]}
  #define PIN(x) asm volatile("":"+v"(x))
  #define MX3(a,b,c) __builtin_fmaxf(__builtin_fmaxf((a),(b)),(c))
  #define GAPA(MF,A0,A1,A2,A3,W0,W1,PW) do{ MF; sacc+=A0; sacc+=A1; sacc+=A2; sacc+=A3; PIN(sacc); W0; W1; PIN(PW); SBAR(); }while(0)
  #define EX(v) __builtin_amdgcn_exp2f(v)
  #define GAPB(MF,X,B) do{ MF; X[B]=EX(X[B]); X[B+1]=EX(X[B+1]); X[B+2]=EX(X[B+2]); X[B+3]=EX(X[B+3]); PIN(X); SBAR(); }while(0)
  #define VRD(i) do{ vlo[i]=vtr(vp_+(((i)>>2)*4096+((i)&3)*1024)); vhi[i]=vtr(vp_+(((i)>>2)*4096+((i)&3)*1024+512)); }while(0)
  #define KRD(G,j) do{ if(G){ kload2(kf,kp0+sl_next,j); SBAR(); } }while(0)
  #define STEP(C0,C1,P0,P1,t,GK,GV,GL) do{ SBAR(); \
    const lds_cptr vp_=vp0+sl_prev; \
    VRD(0); SBAR(); float sacc=(P0[0]+P0[1]); \
    GAPA(C0=__builtin_amdgcn_mfma_f32_32x32x16_bf16(kf[0],qr[0],negm,0,0,0), P0[2],P0[3],P0[4],P0[5],     pw0[0]=PKW(P0,0), pw0[1]=PKW(P0,2), pw0); \
    VRD(4); SBAR(); GAPA(C1=__builtin_amdgcn_mfma_f32_32x32x16_bf16(kf[1],qr[0],negm,0,0,0), P0[6],P0[7],P0[8],P0[9],     pw0[2]=PKW(P0,4), pw0[3]=PKW(P0,6), pw0); \
    VRD(1); SBAR(); GAPA(C0=__builtin_amdgcn_mfma_f32_32x32x16_bf16(kf[2],qr[1],C0,0,0,0),   P0[10],P0[11],P0[12],P0[13], pw1[0]=PKW(P0,8), pw1[1]=PKW(P0,10), pw1); \
    VRD(5); SBAR(); GAPA(C1=__builtin_amdgcn_mfma_f32_32x32x16_bf16(kf[3],qr[1],C1,0,0,0),   P0[14],P0[15],P1[0],P1[1],   pw1[2]=PKW(P0,12),pw1[3]=PKW(P0,14), pw1); \
    VRD(2); SBAR(); GAPA(C0=__builtin_amdgcn_mfma_f32_32x32x16_bf16(kf[4],qr[2],C0,0,0,0),   P1[2],P1[3],P1[4],P1[5],     pw2[0]=PKW(P1,0), pw2[1]=PKW(P1,2), pw2); \
    VRD(6); SBAR(); GAPA(C1=__builtin_amdgcn_mfma_f32_32x32x16_bf16(kf[5],qr[2],C1,0,0,0),   P1[6],P1[7],P1[8],P1[9],     pw2[2]=PKW(P1,4), pw2[3]=PKW(P1,6), pw2); \
    VRD(3); SBAR(); GAPA(C0=__builtin_amdgcn_mfma_f32_32x32x16_bf16(kf[6],qr[3],C0,0,0,0),   P1[10],P1[11],P1[12],P1[13], pw3[0]=PKW(P1,8), pw3[1]=PKW(P1,10), pw3); \
    VRD(7); SBAR(); GAPA(C1=__builtin_amdgcn_mfma_f32_32x32x16_bf16(kf[7],qr[3],C1,0,0,0),   P1[14],P1[15],0.f,0.f,       pw3[2]=PKW(P1,12),pw3[3]=PKW(P1,14), pw3); \
    l_reg+=sacc; \
    if(GK){DMA_K((t)+3,sl_cur);} if(GV){DMA_V((t)+1,sl_next);} \
    CMASK(C0,C1,t); \
    { float a=MX3(C0[0],C0[1],C1[0]),b=MX3(C0[2],C0[3],C1[1]); a=MX3(a,C1[2],C1[3]); \
      _Pragma("unroll") for(int r=4;r<16;r+=4){a=MX3(a,C0[r],C0[r+1]);b=MX3(b,C0[r+2],C0[r+3]);a=MX3(a,C1[r],C1[r+1]);b=MX3(b,C1[r+2],C1[r+3]);} \
      float rm=__builtin_fmaxf(a,b); { auto rr=__builtin_amdgcn_permlane32_swap(__float_as_uint(rm),__float_as_uint(rm),false,false); rm=__builtin_fmaxf(__uint_as_float(rr[0]),__uint_as_float(rr[1])); } \
      resc=false; \
      if(__builtin_expect(__any(rm>(float)THRL),0)){ const float dl=__builtin_fmaxf(rm,0.f); mhat+=dl; \
        _Pragma("unroll") for(int r=0;r<16;++r){C0[r]-=dl;C1[r]-=dl;} \
        _Pragma("unroll") for(int r=0;r<16;++r)negm[r]=-mhat; asm volatile("":"+v"(negm)); \
        const float f=__builtin_amdgcn_exp2f(-dl); l_reg*=f; if(hi==0)wsf[r32]=f; resc=true; } } \
    SBAR(); \
    GAPB(o[0]=__builtin_amdgcn_mfma_f32_32x32x16_bf16(PAF(0),VFR(0),o[0],0,0,0), C0,0); \
    GAPB(o[1]=__builtin_amdgcn_mfma_f32_32x32x16_bf16(PAF(0),VFR(4),o[1],0,0,0), C0,4); \
    KRD(GL,0); GAPB(o[0]=__builtin_amdgcn_mfma_f32_32x32x16_bf16(PAF(1),VFR(1),o[0],0,0,0), C0,8); \
    KRD(GL,1); GAPB(o[1]=__builtin_amdgcn_mfma_f32_32x32x16_bf16(PAF(1),VFR(5),o[1],0,0,0), C0,12); \
    KRD(GL,2); GAPB(o[0]=__builtin_amdgcn_mfma_f32_32x32x16_bf16(PAF(2),VFR(2),o[0],0,0,0), C1,0); \
    KRD(GL,3); GAPB(o[1]=__builtin_amdgcn_mfma_f32_32x32x16_bf16(PAF(2),VFR(6),o[1],0,0,0), C1,4); \
    GAPB(o[0]=__builtin_amdgcn_mfma_f32_32x32x16_bf16(PAF(3),VFR(3),o[0],0,0,0), C1,8); \
    GAPB(o[1]=__builtin_amdgcn_mfma_f32_32x32x16_bf16(PAF(3),VFR(7),o[1],0,0,0), C1,12); \
    }while(0)
  int t=1;
  #undef CMASK
  #define CMASK(P0,P1,t) do{ if(C::MASK){ if((t)>=4) wmask(P0,P1,win0+64*((t)-4),qpos,hi); } }while(0)
  for(;t+5<NT;t+=2){
    STEP(pB0,pB1,pA0,pA1,t,true,true,true);     WAIT_BAR(2); RESC(); ROT();
    STEP(pA0,pA1,pB0,pB1,t+1,true,true,true);   WAIT_BAR(2); RESC(); ROT();
  }
  #undef CMASK
  #define CMASK(P0,P1,t) do{ if(C::MASK){ if((t)>=4) wmask(P0,P1,win0+64*((t)-4),qpos,hi); } }while(0)
  #define ENDW(tt) do{ if((tt)+3<NT){WAIT_BAR(2);} else if((tt)+2<NT){WAIT_BAR(1);} else {WAIT_BAR(0);} }while(0)
  for(;t+1<NT;t+=2){
    STEP(pB0,pB1,pA0,pA1,t,(t+3<NT),(t+1<NT),(t+1<NT));       ENDW(t);   RESC(); ROT();
    STEP(pA0,pA1,pB0,pB1,t+1,(t+4<NT),(t+2<NT),(t+2<NT));     ENDW(t+1); RESC(); ROT();
  }
  STEP(pB0,pB1,pA0,pA1,NT-1,false,false,false); RESC();
  { float sacc=pB0[0]+pB0[1]; _Pragma("unroll") for(int r=2;r<16;++r)sacc+=pB0[r]; _Pragma("unroll") for(int r=0;r<16;++r)sacc+=pB1[r]; l_reg+=sacc;
    pw0=(u32x4){PKW(pB0,0),PKW(pB0,2),PKW(pB0,4),PKW(pB0,6)};pw1=(u32x4){PKW(pB0,8),PKW(pB0,10),PKW(pB0,12),PKW(pB0,14)};pw2=(u32x4){PKW(pB1,0),PKW(pB1,2),PKW(pB1,4),PKW(pB1,6)};pw3=(u32x4){PKW(pB1,8),PKW(pB1,10),PKW(pB1,12),PKW(pB1,14)};
    SBAR(); pv(o,vb0+sl_cur,PAF(0),PAF(1),PAF(2),PAF(3)); }
  #undef PKW
  #undef PAF
  #undef VFR
  #undef PIN
  #undef MX3
  #undef GAPA
  #undef GAPB
  #undef EX
  #undef VRD
  #undef KRD
  #undef STEP
  #undef ENDW
  {auto rr=__builtin_amdgcn_permlane32_swap(__float_as_uint(l_reg),__float_as_uint(l_reg),false,false);l_reg=__uint_as_float(rr[0])+__uint_as_float(rr[1]);}
  if(C::MASK) l_reg+=__builtin_amdgcn_exp2f(aa.sinkl2-mhat);
  if(hi==0)wsf[32+r32]=l_reg;asm volatile("s_waitcnt lgkmcnt(0)":::"memory");
  float rli[16];
  #pragma unroll
  for(int r=0;r<16;++r)rli[r]=__builtin_amdgcn_rcpf(wsf[32+crow(r,hi)]);
  bf16*Ow=aa.Ow0+(long)(wid*QBLK)*C::OP;
  { bf16*stg=(bf16*)(shm+LDS_OST)+wid*2048;
    #pragma unroll
    for(int r=0;r<16;++r){const int orow=crow(r,hi);
      #pragma unroll
      for(int d0=0;d0<2;++d0)stg[orow*64+d0*32+r32]=__float2bfloat16(o[d0][r]*rli[r]);}
    asm volatile("s_waitcnt lgkmcnt(0)":::"memory");
    #pragma unroll
    for(int i=0;i<4;++i){const int row=i*8+(lane>>3),ch=lane&7; const u32x4 v=*(const u32x4*)(stg+row*64+ch*8); ATTN_STORE16(Ow+(long)row*C::OP+ch*8,v);} }
  asm volatile("s_waitcnt lgkmcnt(0)\n\ts_barrier":::"memory");
  #undef DMA_K
  #undef KROW
  #undef DMA_V
  #undef CMASK
  #undef START
  #undef RESC
  #undef ROT
}
__device__ __forceinline__ void pv128(f32x16*o,int vb,bf16x8 pa0,bf16x8 pa1,bf16x8 pa2,bf16x8 pa3){
  #pragma unroll
  for(int d0=0;d0<4;++d0){s16x4 lo[4],hi[4];
    #pragma unroll
    for(int ks=0;ks<4;++ks){
      asm volatile("ds_read_b64_tr_b16 %0,%1 offset:%c2":"=&v"(lo[ks]):"v"(vb),"i"(d0*4096+ks*1024):"memory");
      asm volatile("ds_read_b64_tr_b16 %0,%1 offset:%c2":"=&v"(hi[ks]):"v"(vb),"i"(d0*4096+ks*1024+512):"memory");}
    asm volatile("s_waitcnt lgkmcnt(0)":::"memory");SBAR();
    #define PK(k) (bf16x8){lo[k][0],lo[k][1],lo[k][2],lo[k][3],hi[k][0],hi[k][1],hi[k][2],hi[k][3]}
    o[d0]=__builtin_amdgcn_mfma_f32_32x32x16_bf16(pa0,PK(0),o[d0],0,0,0);
    o[d0]=__builtin_amdgcn_mfma_f32_32x32x16_bf16(pa1,PK(1),o[d0],0,0,0);
    o[d0]=__builtin_amdgcn_mfma_f32_32x32x16_bf16(pa2,PK(2),o[d0],0,0,0);
    o[d0]=__builtin_amdgcn_mfma_f32_32x32x16_bf16(pa3,PK(3),o[d0],0,0,0);
    #undef PK
  }
}
template<class C,int THRL> __device__ __forceinline__ void attn_unit128(const AttnArgs& aa,char*shm){
  constexpr int LDS_K=0, LDS_V=NSLOT*SLOTB, LDS_WS=LDS_V+NSLOT*2*SLOTB, LDS_OST=LDS_WS+NW*64*4;

  int tid_=threadIdx.x; asm volatile("":"+v"(tid_)); const int tid=tid_,lane=tid&63,r32=lane&31,hi=lane>>5; const int wid=__builtin_amdgcn_readfirstlane(tid>>6);
  const bf16*Qw=aa.Qw0+(long)(wid*QBLK)*C::QP;
  const bf16*Kh=aa.Kh,*Vh=aa.Vh; const int win0=aa.win0;
  const unsigned lds0=(unsigned)(uintptr_t)shm;
  float*wsf=(float*)(shm+LDS_WS)+wid*64;
  const bf16*ksrc=Kh+(long)lane*C::KP+wid*8;
  const bf16*vsrc=Vh+(long)(16*(wid&3)+(lane>>2))*C::VP+(wid>>2)*32+(lane&3)*8;
  const unsigned kdst=lds0+LDS_K+wid*1024, vdst=lds0+LDS_V+wid*1024;
  #define KROW(t) (C::MASK ? ((t)<4 ? 4096+64*(t) : win0+64*((t)-4)) : 64*(t))
  #define DMA_K(t,slot) glds16(ksrc+(long)KROW(t)*C::KP,(unsigned)__builtin_amdgcn_readfirstlane(kdst+(slot)))
  #define DMA_V(t,slot) do{ glds16(vsrc+(long)KROW(t)*C::VP,(unsigned)__builtin_amdgcn_readfirstlane(vdst+2*(slot))); glds16(vsrc+(long)KROW(t)*C::VP+64,(unsigned)__builtin_amdgcn_readfirstlane(vdst+2*(slot)+8192)); }while(0)
  const int vb0=(int)(lds0+LDS_V)+((lane>>4)&1)*32+(lane&3)*8+(4*hi+((lane&15)>>2))*64;
  const char*Kbase=shm+LDS_K; bf16x8 kf[8];
  const lds_cptr shm3=(lds_cptr)shm; const lds_cptr kp0=shm3+LDS_K+hi*1024+r32*16; const lds_cptr vp0=shm3+LDS_V+((lane>>4)&1)*32+(lane&3)*8+(4*hi+((lane&15)>>2))*64;
  const int NT=aa.NT;
  DMA_K(0,0);DMA_V(0,0);DMA_K(1,SLOTB);
  bf16x8 qr[4];
  #pragma unroll
  for(int d0=0;d0<4;++d0)qr[d0]=*reinterpret_cast<const bf16x8*>(&Qw[(long)r32*C::QP+d0*16+hi*8]);
  float mhat=0.f,l_reg=0.f;f32x16 o[4];o[0]=f32x16{};o[1]=f32x16{};o[2]=f32x16{};o[3]=f32x16{};f32x16 negm=f32x16{};asm volatile("":"+v"(negm));
  const int qpos=aa.qpos0+wid*QBLK+r32;
  #define CMASK(P0,P1,t) do{ if(C::MASK){ if((t)>=4) wmask(P0,P1,win0+64*((t)-4),qpos,hi); } }while(0)
  bool resc=false;
  #define START(P0,P1) do{ const float rm=rowmax(P0,P1); resc=false; \
    { const float dl=rm; mhat=fadd_s(mhat,dl); \
      _Pragma("unroll") for(int r=0;r<16;++r){P0[r]=fsub_s(P0[r],dl);P1[r]=fsub_s(P1[r],dl);} \
      _Pragma("unroll") for(int r=0;r<16;++r)negm[r]=-mhat; asm volatile("":"+v"(negm)); } \
    _Pragma("unroll") for(int r=0;r<16;++r)P0[r]=__builtin_amdgcn_exp2f(P0[r]); }while(0)
  #define RESC() do{ if(resc){ asm volatile("s_waitcnt lgkmcnt(0)":::"memory"); \
      _Pragma("unroll") for(int d_=0;d_<4;++d_) _Pragma("unroll") for(int r=0;r<16;++r)o[d_][r]*=wsf[crow(r,hi)]; } }while(0)
  f32x16 pA0,pA1,pB0,pB1;
  int sl_prev=0,sl_cur=0,sl_next=SLOTB;
  #define ROT() do{sl_prev=sl_cur;sl_cur=sl_next;sl_next=(sl_next==(NSLOT-1)*SLOTB)?0:sl_next+SLOTB;}while(0)
  DMA_K(2,2*SLOTB);
  WAIT_BAR(3);
  qkt(pA0,pA1,Kbase,qr,negm,r32,hi);asm volatile("s_nop 15\n\ts_nop 7":"+v"(pA0),"+v"(pA1));CMASK(pA0,pA1,0);
  START(pA0,pA1);
  _Pragma("unroll") for(int r=0;r<16;++r)pA1[r]=__builtin_amdgcn_exp2f(pA1[r]);
  WAIT_BAR(0);
  DMA_K(3,0);DMA_V(1,SLOTB);
  ROT();
  kload8(kf,kp0+sl_cur);
  WAIT_BAR(3);
  s16x4 vlo[4],vhi[4]; u32x4 pw0,pw1,pw2,pw3;
  #define PKW(P,B) cvtpk_s(P[B],P[B+1])
  #define PAF(k) __builtin_bit_cast(bf16x8,pw##k)
  #define PIN(x) asm volatile("":"+v"(x))
  #define MX3(a,b,c) __builtin_fmaxf(__builtin_fmaxf((a),(b)),(c))
  #define GAPA(MF,A0,A1,A2,A3,W0,W1,PW) do{ MF; sacc+=A0; sacc+=A1; sacc+=A2; sacc+=A3; PIN(sacc); W0; W1; PIN(PW); SBAR(); }while(0)
  #define EX(v) __builtin_amdgcn_exp2f(v)
  #define GAPB(MF,X,B) do{ MF; X[B]=EX(X[B]); X[B+1]=EX(X[B+1]); PIN(X); SBAR(); }while(0)
  #define VRD(j) do{ vlo[(j)&3]=vtr(vp_+(((j)&3)*4096+((j)>>2)*1024)); vhi[(j)&3]=vtr(vp_+(((j)&3)*4096+((j)>>2)*1024+512)); SBAR(); }while(0)
  #define VFR(j) (bf16x8){vlo[(j)&3][0],vlo[(j)&3][1],vlo[(j)&3][2],vlo[(j)&3][3],vhi[(j)&3][0],vhi[(j)&3][1],vhi[(j)&3][2],vhi[(j)&3][3]}
  #define KRD(G,j) do{ if(G){ kload2(kf,kp0+sl_next,j); SBAR(); } }while(0)
  #define STEP(C0,C1,P0,P1,t,GK,GV,GL) do{ SBAR(); \
    const lds_cptr vp_=vp0+2*sl_prev; \
    float sacc=(P0[0]+P0[1]); \
    GAPA(C0=__builtin_amdgcn_mfma_f32_32x32x16_bf16(kf[0],qr[0],negm,0,0,0), P0[2],P0[3],P0[4],P0[5],     pw0[0]=PKW(P0,0), pw0[1]=PKW(P0,2), pw0); \
    GAPA(C1=__builtin_amdgcn_mfma_f32_32x32x16_bf16(kf[1],qr[0],negm,0,0,0), P0[6],P0[7],P0[8],P0[9],     pw0[2]=PKW(P0,4), pw0[3]=PKW(P0,6), pw0); \
    GAPA(C0=__builtin_amdgcn_mfma_f32_32x32x16_bf16(kf[2],qr[1],C0,0,0,0),   P0[10],P0[11],P0[12],P0[13], pw1[0]=PKW(P0,8), pw1[1]=PKW(P0,10), pw1); \
    GAPA(C1=__builtin_amdgcn_mfma_f32_32x32x16_bf16(kf[3],qr[1],C1,0,0,0),   P0[14],P0[15],P1[0],P1[1],   pw1[2]=PKW(P0,12),pw1[3]=PKW(P0,14), pw1); \
    GAPA(C0=__builtin_amdgcn_mfma_f32_32x32x16_bf16(kf[4],qr[2],C0,0,0,0),   P1[2],P1[3],P1[4],P1[5],     pw2[0]=PKW(P1,0), pw2[1]=PKW(P1,2), pw2); \
    GAPA(C1=__builtin_amdgcn_mfma_f32_32x32x16_bf16(kf[5],qr[2],C1,0,0,0),   P1[6],P1[7],P1[8],P1[9],     pw2[2]=PKW(P1,4), pw2[3]=PKW(P1,6), pw2); \
    VRD(0); GAPA(C0=__builtin_amdgcn_mfma_f32_32x32x16_bf16(kf[6],qr[3],C0,0,0,0),   P1[10],P1[11],P1[12],P1[13], pw3[0]=PKW(P1,8), pw3[1]=PKW(P1,10), pw3); \
    VRD(1); GAPA(C1=__builtin_amdgcn_mfma_f32_32x32x16_bf16(kf[7],qr[3],C1,0,0,0),   P1[14],P1[15],0.f,0.f,       pw3[2]=PKW(P1,12),pw3[3]=PKW(P1,14), pw3); \
    l_reg+=sacc; \
    if(GK){DMA_K((t)+3,sl_cur);} if(GV){DMA_V((t)+1,sl_next);} \
    CMASK(C0,C1,t); \
    { float a=MX3(C0[0],C0[1],C1[0]),b=MX3(C0[2],C0[3],C1[1]); a=MX3(a,C1[2],C1[3]); \
      _Pragma("unroll") for(int r=4;r<16;r+=4){a=MX3(a,C0[r],C0[r+1]);b=MX3(b,C0[r+2],C0[r+3]);a=MX3(a,C1[r],C1[r+1]);b=MX3(b,C1[r+2],C1[r+3]);} \
      float rm=__builtin_fmaxf(a,b); { auto rr=__builtin_amdgcn_permlane32_swap(__float_as_uint(rm),__float_as_uint(rm),false,false); rm=__builtin_fmaxf(__uint_as_float(rr[0]),__uint_as_float(rr[1])); } \
      resc=false; \
      if(__builtin_expect(__any(rm>(float)THRL),0)){ const float dl=__builtin_fmaxf(rm,0.f); mhat+=dl; \
        _Pragma("unroll") for(int r=0;r<16;++r){C0[r]-=dl;C1[r]-=dl;} \
        _Pragma("unroll") for(int r=0;r<16;++r)negm[r]=-mhat; asm volatile("":"+v"(negm)); \
        const float f=__builtin_amdgcn_exp2f(-dl); l_reg*=f; if(hi==0)wsf[r32]=f; resc=true; } } \
    SBAR(); \
    GAPB(o[0]=__builtin_amdgcn_mfma_f32_32x32x16_bf16(PAF(0),VFR(0),o[0],0,0,0),  C0,0);  VRD(2); \
    GAPB(o[1]=__builtin_amdgcn_mfma_f32_32x32x16_bf16(PAF(0),VFR(1),o[1],0,0,0),  C0,2);  VRD(3); \
    GAPB(o[2]=__builtin_amdgcn_mfma_f32_32x32x16_bf16(PAF(0),VFR(2),o[2],0,0,0),  C0,4);  VRD(4); \
    GAPB(o[3]=__builtin_amdgcn_mfma_f32_32x32x16_bf16(PAF(0),VFR(3),o[3],0,0,0),  C0,6);  VRD(5); \
    KRD(GL,0); GAPB(o[0]=__builtin_amdgcn_mfma_f32_32x32x16_bf16(PAF(1),VFR(4),o[0],0,0,0),  C0,8);  VRD(6); \
    GAPB(o[1]=__builtin_amdgcn_mfma_f32_32x32x16_bf16(PAF(1),VFR(5),o[1],0,0,0),  C0,10);  VRD(7); \
    KRD(GL,1); GAPB(o[2]=__builtin_amdgcn_mfma_f32_32x32x16_bf16(PAF(1),VFR(6),o[2],0,0,0),  C0,12);  VRD(8); \
    GAPB(o[3]=__builtin_amdgcn_mfma_f32_32x32x16_bf16(PAF(1),VFR(7),o[3],0,0,0),  C0,14);  VRD(9); \
    KRD(GL,2); GAPB(o[0]=__builtin_amdgcn_mfma_f32_32x32x16_bf16(PAF(2),VFR(8),o[0],0,0,0),  C1,0);  VRD(10); \
    GAPB(o[1]=__builtin_amdgcn_mfma_f32_32x32x16_bf16(PAF(2),VFR(9),o[1],0,0,0),  C1,2);  VRD(11); \
    KRD(GL,3); GAPB(o[2]=__builtin_amdgcn_mfma_f32_32x32x16_bf16(PAF(2),VFR(10),o[2],0,0,0), C1,4);  VRD(12); \
    GAPB(o[3]=__builtin_amdgcn_mfma_f32_32x32x16_bf16(PAF(2),VFR(11),o[3],0,0,0), C1,6);  VRD(13); \
    GAPB(o[0]=__builtin_amdgcn_mfma_f32_32x32x16_bf16(PAF(3),VFR(12),o[0],0,0,0), C1,8);  VRD(14); \
    GAPB(o[1]=__builtin_amdgcn_mfma_f32_32x32x16_bf16(PAF(3),VFR(13),o[1],0,0,0), C1,10);  VRD(15); \
    GAPB(o[2]=__builtin_amdgcn_mfma_f32_32x32x16_bf16(PAF(3),VFR(14),o[2],0,0,0), C1,12); \
    GAPB(o[3]=__builtin_amdgcn_mfma_f32_32x32x16_bf16(PAF(3),VFR(15),o[3],0,0,0), C1,14); \
    }while(0)
  int t=1;
  #undef CMASK
  #define CMASK(P0,P1,t) do{ if(C::MASK){ if((t)>=4) wmask(P0,P1,win0+64*((t)-4),qpos,hi); } }while(0)
  for(;t+5<NT;t+=2){
    STEP(pB0,pB1,pA0,pA1,t,true,true,true);     WAIT_BAR(3); RESC(); ROT();
    STEP(pA0,pA1,pB0,pB1,t+1,true,true,true);   WAIT_BAR(3); RESC(); ROT();
  }
  #undef CMASK
  #define CMASK(P0,P1,t) do{ if(C::MASK){ if((t)>=4) wmask(P0,P1,win0+64*((t)-4),qpos,hi); } }while(0)
  #define ENDW(tt) do{ if((tt)+3<NT){WAIT_BAR(3);} else if((tt)+2<NT){WAIT_BAR(2);} else {WAIT_BAR(0);} }while(0)
  for(;t+1<NT;t+=2){
    STEP(pB0,pB1,pA0,pA1,t,(t+3<NT),(t+1<NT),(t+1<NT));       ENDW(t);   RESC(); ROT();
    STEP(pA0,pA1,pB0,pB1,t+1,(t+4<NT),(t+2<NT),(t+2<NT));     ENDW(t+1); RESC(); ROT();
  }
  STEP(pB0,pB1,pA0,pA1,NT-1,false,false,false); RESC();
  { float sacc=pB0[0]+pB0[1]; _Pragma("unroll") for(int r=2;r<16;++r)sacc+=pB0[r]; _Pragma("unroll") for(int r=0;r<16;++r)sacc+=pB1[r]; l_reg+=sacc;
    pw0=(u32x4){PKW(pB0,0),PKW(pB0,2),PKW(pB0,4),PKW(pB0,6)};pw1=(u32x4){PKW(pB0,8),PKW(pB0,10),PKW(pB0,12),PKW(pB0,14)};pw2=(u32x4){PKW(pB1,0),PKW(pB1,2),PKW(pB1,4),PKW(pB1,6)};pw3=(u32x4){PKW(pB1,8),PKW(pB1,10),PKW(pB1,12),PKW(pB1,14)};
    SBAR(); pv128(o,vb0+2*sl_cur,PAF(0),PAF(1),PAF(2),PAF(3)); }
  #undef PKW
  #undef PAF
  #undef VFR
  #undef PIN
  #undef MX3
  #undef GAPA
  #undef GAPB
  #undef EX
  #undef VRD
  #undef KRD
  #undef STEP
  #undef ENDW
  {auto rr=__builtin_amdgcn_permlane32_swap(__float_as_uint(l_reg),__float_as_uint(l_reg),false,false);l_reg=__uint_as_float(rr[0])+__uint_as_float(rr[1]);}
  if(C::MASK) l_reg+=__builtin_amdgcn_exp2f(aa.sinkl2-mhat);
  if(hi==0)wsf[32+r32]=l_reg;asm volatile("s_waitcnt lgkmcnt(0)":::"memory");
  float rli[16];
  #pragma unroll
  for(int r=0;r<16;++r)rli[r]=__builtin_amdgcn_rcpf(wsf[32+crow(r,hi)]);
  bf16*Ow=aa.Ow0+(long)(wid*QBLK)*C::OP;
  { bf16*stg=(bf16*)(shm+LDS_OST)+wid*2048;
    #pragma unroll
    for(int hp=0;hp<2;++hp){
      #pragma unroll
      for(int r=0;r<16;++r){const int orow=crow(r,hi);
        #pragma unroll
        for(int d0=0;d0<2;++d0)stg[orow*64+d0*32+r32]=__float2bfloat16(o[2*hp+d0][r]*rli[r]);}
      asm volatile("s_waitcnt lgkmcnt(0)":::"memory");
      #pragma unroll
      for(int i=0;i<4;++i){const int row=i*8+(lane>>3),ch=lane&7; const u32x4 v=*(const u32x4*)(stg+row*64+ch*8); ATTN_STORE16(Ow+(long)row*C::OP+hp*64+ch*8,v);}
      asm volatile("s_waitcnt lgkmcnt(0)":::"memory");
    } }
  asm volatile("s_waitcnt lgkmcnt(0)\n\ts_barrier":::"memory");
  #undef DMA_K
  #undef KROW
  #undef DMA_V
  #undef CMASK
  #undef START
  #undef RESC
  #undef ROT
}
constexpr int ATTN_LDS_BYTES=LDS_BYTES;
#undef SBAR
#undef WAIT_BAR
}
constexpr int NWAVES = 8;
constexpr int DM = 2048, NBATCH = 4, SEQ = 4096, CTXL = 256;
constexpr int MT = NBATCH * SEQ, MC = NBATCH * CTXL, MH = MT + MC;
constexpr int KVR = SEQ + CTXL;
constexpr int PROJ = 8448, NE = 32, TOPK = 4;
constexpr int NASSIGN = MT * TOPK;
constexpr int MAXMT = NASSIGN / 256 + NE;
constexpr float LN_EPS = 1e-5f;
constexpr float DN_ALPHA = 1.189207115002721f;
constexpr float LAM_INIT = 0.2f;
constexpr int MODW = 6 * DM;

constexpr size_t MiB = 1u << 20;
constexpr size_t WS_CTL = 0, CTL_ZERO_BYTES = 64 * 1024;
constexpr size_t WS_MODP = 1 * MiB;
constexpr size_t WS_MOD = 2 * MiB;
constexpr size_t WS_PSLOT = 3 * MiB, WS_PGATE = 5 * MiB, WS_STATS = 7 * MiB, WS_SA = 7 * MiB + 256 * 1024, WS_SB = 7 * MiB + 512 * 1024, WS_SH = 7 * MiB + 128 * 1024, WS_SBIN = 7 * MiB + 320 * 1024;
constexpr size_t WS_WIN = 8 * MiB;
constexpr size_t WS_WOA = 42 * MiB, WS_WOB = 46 * MiB, WS_WOUT = 50 * MiB;
constexpr size_t WS_WUP = 64 * MiB;
constexpr size_t WS_WDN = 576 * MiB;
constexpr size_t WS_H = 832 * MiB;
constexpr size_t WS_QA = 900 * MiB, WS_KA = 932 * MiB, WS_VA = 966 * MiB, WS_QB = 1000 * MiB, WS_KB = 1032 * MiB, WS_VB = 1037 * MiB;
constexpr size_t WS_GA = 1042 * MiB, WS_GB = 1106 * MiB, WS_O4 = 1170 * MiB, WS_OA = 1234 * MiB, WS_OB = 1266 * MiB;
constexpr size_t WS_Y1 = 1298 * MiB, WS_Y = 1426 * MiB, WS_R = 1490 * MiB, WS_X1 = 1618 * MiB, WS_HM = 1746 * MiB;
constexpr size_t WS_XG = 1810 * MiB, WS_ACT = 2098 * MiB, WS_YS = 2386 * MiB, WS_ACTQ = 2642 * MiB, WS_RMAXP = 2794 * MiB, WS_SACT = 2814 * MiB, WS_SBD = 2815 * MiB, WS_END = 2816 * MiB;
constexpr size_t WS_YSG = WS_XG, WS_INV = WS_SBD + 512 * 1024;
constexpr size_t WS_OBQ = WS_X1, WS_SOA = WS_STATS + 384 * 1024, WS_SOB = WS_STATS + 448 * 1024, WS_SBOA = WS_SBD + 768 * 1024, WS_SBOB = WS_SBD + 776 * 1024;
constexpr size_t WS_RMAXY = WS_RMAXP, WS_SY = WS_SACT, WS_SBOUT = WS_SBD + 784 * 1024;
constexpr int CW_BAR = 4096;
constexpr int CW_CNT = 8192;
constexpr int CW_QDNQ = 8896;
constexpr int CW_QUPQ = 8512;
constexpr int CW_QCONV = 8448;
constexpr int NG_INPROJ = 144;
constexpr int NWORK = 208;

constexpr int RING_OFF = 0, RING_BYTES = 131072;
constexpr int LDSCTL_OFF = RING_BYTES, MISC_OFF = LDSCTL_OFF + 320;
constexpr int TOK_OFF = LDSCTL_OFF + 2816, EPL_OFF = TOK_OFF + 9216 + 18432;
constexpr int TBL_OFF = LDSCTL_OFF + 1024;
constexpr int LDS_BYTES = 163840;
#define GAS __attribute__((address_space(1)))
#define LAS __attribute__((address_space(3)))
typedef unsigned short bf16;
typedef unsigned v4u __attribute__((ext_vector_type(4)));
typedef float f32x4 __attribute__((ext_vector_type(4)));
typedef short bf16x8 __attribute__((ext_vector_type(8)));
typedef GAS unsigned gu32;
typedef GAS unsigned long long gu64;
#define RLX_AGENT __ATOMIC_RELAXED, __HIP_MEMORY_SCOPE_AGENT
#define LDS_WAIT() asm volatile("s_waitcnt lgkmcnt(0)" ::: "memory")
#define VM_WAIT() asm volatile("s_waitcnt vmcnt(0)" ::: "memory")
__device__ __forceinline__ unsigned long long rt() { return __builtin_amdgcn_s_memrealtime(); }
__device__ __forceinline__ unsigned f2bf(float f) { unsigned u = __builtin_bit_cast(unsigned, f); return (u + 0x7fffu + ((u >> 16) & 1u)) >> 16; }
__device__ __forceinline__ unsigned pk2(float lo, float hi) { return f2bf(lo) | (f2bf(hi) << 16); }

#define XB_TMO      128
#define XB_XCNT(j)  (256  + 64 * (j))
#define XB_XSUB(j)  (1280 + 64 * (j))
#define XB_XGEN(j)  (2304 + 64 * (j))
#define XB_TOP      3328
#define XB_TOPGEN   3392
#define XCD_BAR_WORDS 3456
#define XB_SPIN_CAP (1u << 18)

__device__ __forceinline__ unsigned xb_ld(unsigned* p)              { return __hip_atomic_load(p, __ATOMIC_RELAXED, __HIP_MEMORY_SCOPE_AGENT); }
__device__ __forceinline__ unsigned xb_add(unsigned* p, unsigned v) { return __hip_atomic_fetch_add(p, v, __ATOMIC_RELAXED, __HIP_MEMORY_SCOPE_AGENT); }
__device__ __forceinline__ unsigned xb_xcc_id() { return (unsigned)__builtin_amdgcn_s_getreg((3 << 11) | 20) & 0xFu; }
#define XB_SPIN(cond, bar) do { unsigned _sp = 0; while (cond) { __builtin_amdgcn_s_sleep(1); \
    if ((++_sp & 255u) == 0u) { if (xb_ld(&(bar)[XB_TMO])) break; if (_sp > XB_SPIN_CAP) { atomicAdd(&(bar)[XB_TMO], 1u); break; } } } } while (0)

struct XcdBarrier {
    unsigned* bar; unsigned x;
    volatile LAS unsigned* st;
};

__device__ __forceinline__ XcdBarrier xcd_barrier_post(unsigned* bar, volatile LAS unsigned* st) {
    XcdBarrier b; b.bar = bar; b.x = xb_xcc_id(); b.st = st;
    if (threadIdx.x == 0) (void)xb_add(&bar[XB_XCNT(b.x)], 1u);
    return b;
}
__device__ __forceinline__ void xcd_barrier_complete(unsigned* bar, unsigned x, unsigned& nloc, unsigned& nx) {
    const unsigned G = gridDim.x * gridDim.y * gridDim.z;
    unsigned sum, cnt, mine, sp = 0u;
    for (;;) {
        sum = 0u; cnt = 0u; mine = 0u;
#pragma unroll
        for (unsigned j = 0; j < 16; ++j) { const unsigned c = xb_ld(&bar[XB_XCNT(j)]); sum += c; cnt += (c > 0u) ? 1u : 0u; mine = (j == x) ? c : mine; }
        if (sum == G) break;
        __builtin_amdgcn_s_sleep(1);
        if ((++sp & 255u) == 0u) { if (xb_ld(&bar[XB_TMO])) break; if (sp > XB_SPIN_CAP) { atomicAdd(&bar[XB_TMO], 1u); break; } }
    }
    nloc = mine > 0u ? mine : 1u; nx = cnt > 0u ? cnt : 1u;
}

__device__ __forceinline__ void xcd_barrier(const XcdBarrier& b) {
    asm volatile("s_waitcnt vmcnt(0)" ::: "memory");
    __syncthreads();
    if (threadIdx.x == 0) {
        unsigned* bar = b.bar;
        __builtin_amdgcn_s_waitcnt(0);
        unsigned nloc = b.st[0], nx = b.st[1];
        if (nloc == 0u) { xcd_barrier_complete(bar, b.x, nloc, nx); b.st[0] = nloc; b.st[1] = nx; }
        const unsigned old = xb_add(&bar[XB_XSUB(b.x)], 1u);
        const unsigned gen = old / nloc;
        if (old + 1u == (gen + 1u) * nloc) {
            __builtin_amdgcn_fence(__ATOMIC_RELEASE, "agent");
            asm volatile("s_waitcnt vmcnt(0)" ::: "memory");
            const unsigned og = xb_add(&bar[XB_TOP], 1u);
            const unsigned tg = og / nx;
            if (og + 1u == (tg + 1u) * nx) xb_add(&bar[XB_TOPGEN], 1u);
            else XB_SPIN(xb_ld(&bar[XB_TOPGEN]) == tg, bar);
            __builtin_amdgcn_fence(__ATOMIC_ACQUIRE, "agent");
            xb_add(&bar[XB_XGEN(b.x)], 1u);
            asm volatile("s_waitcnt vmcnt(0)" ::: "memory");
        } else {
            XB_SPIN(xb_ld(&bar[XB_XGEN(b.x)]) == gen, bar);
            __builtin_amdgcn_fence(__ATOMIC_ACQUIRE, "agent");
            asm volatile("s_waitcnt vmcnt(0)" ::: "memory");
        }
    }
    __syncthreads();
}

__device__ __forceinline__ unsigned xcd_barrier_arrive(const XcdBarrier& b) {
    asm volatile("s_waitcnt vmcnt(0)" ::: "memory");
    __syncthreads();
    unsigned gen = 0u;
    if (threadIdx.x == 0) {
        unsigned* bar = b.bar;
        __builtin_amdgcn_s_waitcnt(0);
        unsigned nloc = b.st[0], nx = b.st[1];
        if (nloc == 0u) { xcd_barrier_complete(bar, b.x, nloc, nx); b.st[0] = nloc; b.st[1] = nx; }
        const unsigned old = xb_add(&bar[XB_XSUB(b.x)], 1u);
        gen = old / nloc;
        if (old + 1u == (gen + 1u) * nloc) {
            __builtin_amdgcn_fence(__ATOMIC_RELEASE, "agent");
            asm volatile("s_waitcnt vmcnt(0)" ::: "memory");
            const unsigned og = xb_add(&bar[XB_TOP], 1u);
            const unsigned tg = og / nx;
            if (og + 1u == (tg + 1u) * nx) xb_add(&bar[XB_TOPGEN], 1u);
            else XB_SPIN(xb_ld(&bar[XB_TOPGEN]) == tg, bar);
            __builtin_amdgcn_fence(__ATOMIC_ACQUIRE, "agent");
            xb_add(&bar[XB_XGEN(b.x)], 1u);
            asm volatile("s_waitcnt vmcnt(0)" ::: "memory");
        }
        b.st[2] = gen;
    }
    __syncthreads();
    return gen;
}
__device__ __forceinline__ bool xcd_barrier_test(const XcdBarrier& b) {
    if (threadIdx.x == 0) {
        const unsigned open_ = (xb_ld(&b.bar[XB_XGEN(b.x)]) != b.st[2]) ? 1u : 0u;
        if (open_) { __builtin_amdgcn_fence(__ATOMIC_ACQUIRE, "agent"); asm volatile("s_waitcnt vmcnt(0)" ::: "memory"); }
        b.st[3] = open_;
    }
    __syncthreads();
    const unsigned r = b.st[3];
    __syncthreads();
    return r != 0u;
}
__device__ __forceinline__ void xcd_barrier_wait(const XcdBarrier& b) {
    if (threadIdx.x == 0) {
        unsigned* bar = b.bar; const unsigned gen = b.st[2];
        XB_SPIN(xb_ld(&bar[XB_XGEN(b.x)]) == gen, bar);
        __builtin_amdgcn_fence(__ATOMIC_ACQUIRE, "agent");
        asm volatile("s_waitcnt vmcnt(0)" ::: "memory");
    }
    __syncthreads();
}
struct Frame {
    LAS unsigned char* lds;
    volatile LAS unsigned* MISC;
    gu32* ctl;
    int tid, lane, wave;
    int vcu, G;
    float* out;
    unsigned char* ws;
};
typedef float f32x2 __attribute__((ext_vector_type(2)));
typedef unsigned u32x2 __attribute__((ext_vector_type(2)));
__device__ __forceinline__ float wave_sum(float v) {
#pragma unroll
    for (int o = 1; o < 64; o <<= 1) v += __shfl_xor(v, o);
    return v;
}

template <int MODE> __device__ __forceinline__ int conv_rowmap(int n) {
    if (MODE == 1) {
        const bool rot = (n < 2048) || (n >= 3072 && n < 4224);
        if (!rot) return n;
        const int d = n & 63, g = 4 * (d >> 5) + ((d & 15) >> 2), j = 4 * ((d >> 4) & 1) + (d & 3);
        return (n & ~63) + 8 * g + j;
    }
    if (MODE == 2) { const int lin = n >= 2048 ? 1 : 0, m = n - 2048 * lin; return 256 * (m >> 7) + 128 * lin + (m & 127); }
    return n;
}
template <int MODE, int NI = 1> __device__ __forceinline__ void conv_item(const float* W, int K, int N, bf16* WT, LAS float* scr, int item, int lane) {
    (void)scr;
    const int nblk = N / 32, kb = item / nblk, nb = item % nblk, k0 = 64 * kb, n0 = 32 * nb, c = lane & 7, kg = lane >> 3;
    const float* src = W + (size_t)(k0 + 8 * kg) * N + n0 + 4 * c;
    f32x4 v[NI][8];
#pragma unroll
    for (int t = 0; t < NI; ++t)
#pragma unroll
        for (int i = 0; i < 8; ++i) v[t][i] = __builtin_nontemporal_load((const GAS f32x4*)(src + (size_t)i * N + 32 * t));
#pragma unroll
    for (int t = 0; t < NI; ++t)
#pragma unroll
        for (int q = 0; q < 4; ++q) { v4u o; o.x = pk2(v[t][0][q], v[t][1][q]); o.y = pk2(v[t][2][q], v[t][3][q]); o.z = pk2(v[t][4][q], v[t][5][q]); o.w = pk2(v[t][6][q], v[t][7][q]);
            *(GAS v4u*)(WT + (size_t)conv_rowmap<MODE>(n0 + 32 * t + 4 * c + q) * K + k0 + 8 * kg) = o; }
}
constexpr int CONV_I_UP = (DM / 64) * (4096 / 32), CONV_I_DN = (DM / 64) * (DM / 32), CONV_NCHUNK = NE * (CONV_I_UP + CONV_I_DN) / 16;
__device__ __forceinline__ void conv_pair_load(f32x4 (&v)[2][8], const float* src, int N) {
#pragma unroll
    for (int t = 0; t < 2; ++t)
#pragma unroll
        for (int i = 0; i < 8; ++i) v[t][i] = __builtin_nontemporal_load((const GAS f32x4*)(src + (size_t)i * N + 32 * t));
}
template <int MODE> __device__ __forceinline__ void conv_pair_store(const f32x4 (&v)[2][8], bf16* WT, int K, int ncol0, int kcol) {
#pragma unroll
    for (int t = 0; t < 2; ++t)
#pragma unroll
        for (int q = 0; q < 4; ++q) { v4u o; o.x = pk2(v[t][0][q], v[t][1][q]); o.y = pk2(v[t][2][q], v[t][3][q]); o.z = pk2(v[t][4][q], v[t][5][q]); o.w = pk2(v[t][6][q], v[t][7][q]);
            *(GAS v4u*)(WT + (size_t)conv_rowmap<MODE>(ncol0 + 32 * t + q) * K + kcol) = o; }
}
template <int MODE> __device__ __forceinline__ void conv_chunk(const float* W, int N, bf16* WT, int item0, int lane) {
    const int nblk = N / 32, kb = item0 / nblk, nb = item0 % nblk, k0 = 64 * kb, n0 = 32 * nb, c = lane & 7, kg = lane >> 3;
    const float* src = W + (size_t)(k0 + 8 * kg) * N + n0 + 4 * c; const int ncol = n0 + 4 * c, kcol = k0 + 8 * kg;
    f32x4 va[2][8], vb[2][8];
    conv_pair_load(va, src, N);
#pragma unroll
    for (int p = 0; p < 8; p += 2) {
        conv_pair_load(vb, src + 64 * (p + 1), N);
        conv_pair_store<MODE>(va, WT, DM, ncol + 64 * p, kcol);
        if (p + 2 < 8) conv_pair_load(va, src + 64 * (p + 2), N);
        conv_pair_store<MODE>(vb, WT, DM, ncol + 64 * (p + 1), kcol);
    }
}
__device__ __forceinline__ void conv_expert_queue(Frame& F, const float* wup, const float* wdn, int qword = CW_QCONV) {
    int tid = threadIdx.x; asm volatile("" : "+v"(tid)); const int lane = tid & 63;
    gu32* q = F.ctl + qword;
    unsigned nx = 0u; if (lane == 0) nx = __hip_atomic_fetch_add(q, 1u, RLX_AGENT);
    for (;;) {
        const unsigned ch = (unsigned)__builtin_amdgcn_readfirstlane((int)nx) + (unsigned)(NE * CONV_I_UP / 16);
        if (ch >= (unsigned)CONV_NCHUNK) break;
        if (lane == 0) nx = __hip_atomic_fetch_add(q, 1u, RLX_AGENT);
        const int it0 = (int)ch * 16;
        if (it0 < NE * CONV_I_UP) { const int e = it0 / CONV_I_UP, r = it0 % CONV_I_UP; conv_chunk<2>(wup + (size_t)e * DM * 4096, 4096, (bf16*)(F.ws + WS_WUP) + (size_t)e * 4096 * DM, r, lane); }
        else { const int qq = it0 - NE * CONV_I_UP, e = qq / CONV_I_DN, r = qq % CONV_I_DN; conv_chunk<0>(wdn + (size_t)e * DM * DM, DM, (bf16*)(F.ws + WS_WDN) + (size_t)e * DM * DM, r, lane); }
    }
}

__device__ __forceinline__ unsigned q4_pack(float a, float b, float c, float d, float inv);
template <int MODE, int KK = DM> __device__ __forceinline__ void conv_int8_task(const float* W, int N, int n0, unsigned char* WQ, float* SB, LAS float* red, int tid) {
    constexpr int RPL = KK / 64;
    const int lane = tid & 63, wave = __builtin_amdgcn_readfirstlane(tid >> 6), c = lane & 7, kg = lane >> 3;
    const float* src = W + (size_t)(8 * RPL * wave + RPL * kg) * N + n0 + 4 * c;
    f32x4 v[RPL];
#pragma unroll
    for (int i = 0; i < RPL; ++i) v[i] = __builtin_nontemporal_load((const GAS f32x4*)(src + (size_t)i * N));
    f32x4 mx = (f32x4){0.f, 0.f, 0.f, 0.f};
#pragma unroll
    for (int i = 0; i < RPL; ++i) { mx[0] = fmaxf(mx[0], fabsf(v[i][0])); mx[1] = fmaxf(mx[1], fabsf(v[i][1])); mx[2] = fmaxf(mx[2], fabsf(v[i][2])); mx[3] = fmaxf(mx[3], fabsf(v[i][3])); }
#pragma unroll
    for (int o = 8; o < 64; o <<= 1) { mx[0] = fmaxf(mx[0], __shfl_xor(mx[0], o)); mx[1] = fmaxf(mx[1], __shfl_xor(mx[1], o)); mx[2] = fmaxf(mx[2], __shfl_xor(mx[2], o)); mx[3] = fmaxf(mx[3], __shfl_xor(mx[3], o)); }
    if (kg == 0) *(LAS f32x4*)(red + wave * 32 + 4 * c) = mx;
    __syncthreads();
#pragma unroll
    for (int w = 0; w < 8; ++w) { const f32x4 t = *(const LAS f32x4*)(red + w * 32 + 4 * c); mx[0] = fmaxf(mx[0], t[0]); mx[1] = fmaxf(mx[1], t[1]); mx[2] = fmaxf(mx[2], t[2]); mx[3] = fmaxf(mx[3], t[3]); }
#pragma unroll
    for (int qq = 0; qq < 4; ++qq) {
        const float m = mx[qq], inv = m > 0.f ? 127.0f / m : 0.f; const int row = conv_rowmap<MODE>(n0 + 4 * c + qq);
        if (wave == 0 && kg == 0) SB[row] = m * (1.0f / 127.0f);
        unsigned wds[RPL / 4];
#pragma unroll
        for (int d = 0; d < RPL / 4; ++d) wds[d] = q4_pack(v[4 * d][qq], v[4 * d + 1][qq], v[4 * d + 2][qq], v[4 * d + 3][qq], inv);
        GAS v4u* dst = (GAS v4u*)(WQ + (size_t)row * KK + 8 * RPL * wave + RPL * kg);
#pragma unroll
        for (int d = 0; d < RPL / 16; ++d) dst[d] = (v4u){wds[4 * d], wds[4 * d + 1], wds[4 * d + 2], wds[4 * d + 3]};
    }
    __syncthreads();
}
__device__ __forceinline__ unsigned q4_pack(float a, float b, float c, float d, float inv) {
    const float M = 12582912.0f;
    const unsigned b0 = __float_as_uint(fmaf(a, inv, M)), b1 = __float_as_uint(fmaf(b, inv, M)), b2 = __float_as_uint(fmaf(c, inv, M)), b3 = __float_as_uint(fmaf(d, inv, M));
    return __builtin_amdgcn_perm(__builtin_amdgcn_perm(b3, b2, 0x0c0c0400u), __builtin_amdgcn_perm(b1, b0, 0x0c0c0400u), 0x05040100u);
}
typedef __fp16 h2_t __attribute__((ext_vector_type(2)));
template <int MODE, int N> __device__ __forceinline__ int conv_int8_queue(Frame& F, const float* W, unsigned char* WQ, float* SB, int qword, int maxit = 0x7fffffff) {
    int tid = threadIdx.x; asm volatile("" : "+v"(tid)); const int lane = tid & 63, wave = __builtin_amdgcn_readfirstlane(tid >> 6), c = lane & 15, kg = lane >> 4;
    constexpr int NCB = N / 64, NTASK = NE * NCB;
    gu32* q = F.ctl + qword; LAS float* red = (LAS float*)(F.lds + 1024); LAS unsigned* tkw = (LAS unsigned*)(F.lds);
    if (tid == 0) tkw[0] = __hip_atomic_fetch_add(q, 1u, RLX_AGENT);
    __syncthreads();
    unsigned cur = tkw[0];
    const size_t loff = (size_t)(256 * wave + 64 * kg) * N + 4 * c;
    int it = 0;
    for (; it < maxit && cur < (unsigned)NTASK; ++it) {
        if (tid == 0 && it + 1 < maxit) tkw[(it + 1) & 1] = __hip_atomic_fetch_add(q, 1u, RLX_AGENT);
        const int e = (int)(cur / NCB), n0 = 64 * (int)(cur % NCB);
        const float* src = W + (size_t)e * DM * N + loff + n0;
        f32x4 v[40]; h2_t hlo[40][2];
        f32x4 mx = (f32x4){0.f, 0.f, 0.f, 0.f};
#pragma unroll
        for (int i = 0; i < 40; ++i) v[i] = __builtin_nontemporal_load((const GAS f32x4*)(src + (size_t)i * N));
#pragma unroll
        for (int i = 0; i < 40; ++i) { mx[0] = fmaxf(mx[0], fabsf(v[i][0])); mx[1] = fmaxf(mx[1], fabsf(v[i][1])); mx[2] = fmaxf(mx[2], fabsf(v[i][2])); mx[3] = fmaxf(mx[3], fabsf(v[i][3]));
            hlo[i][0] = __builtin_amdgcn_cvt_pkrtz(v[i][0], v[i][1]); hlo[i][1] = __builtin_amdgcn_cvt_pkrtz(v[i][2], v[i][3]); }
#pragma unroll
        for (int i = 0; i < 40; ++i) { asm volatile("" : "+v"(hlo[i][0]), "+v"(hlo[i][1])); }
        __builtin_amdgcn_sched_barrier(0);
#pragma unroll
        for (int i = 0; i < 24; ++i) v[i] = __builtin_nontemporal_load((const GAS f32x4*)(src + (size_t)(40 + i) * N));
#pragma unroll
        for (int i = 0; i < 24; ++i) { mx[0] = fmaxf(mx[0], fabsf(v[i][0])); mx[1] = fmaxf(mx[1], fabsf(v[i][1])); mx[2] = fmaxf(mx[2], fabsf(v[i][2])); mx[3] = fmaxf(mx[3], fabsf(v[i][3])); }
#pragma unroll
        for (int o = 16; o < 64; o <<= 1) { mx[0] = fmaxf(mx[0], __shfl_xor(mx[0], o)); mx[1] = fmaxf(mx[1], __shfl_xor(mx[1], o)); mx[2] = fmaxf(mx[2], __shfl_xor(mx[2], o)); mx[3] = fmaxf(mx[3], __shfl_xor(mx[3], o)); }
        if (kg == 0) *(LAS f32x4*)(red + wave * 64 + 4 * c) = mx;
        __syncthreads();
        const unsigned nxt = tkw[(it + 1) & 1];
#pragma unroll
        for (int w = 0; w < 8; ++w) { const f32x4 t = *(const LAS f32x4*)(red + w * 64 + 4 * c); mx[0] = fmaxf(mx[0], t[0]); mx[1] = fmaxf(mx[1], t[1]); mx[2] = fmaxf(mx[2], t[2]); mx[3] = fmaxf(mx[3], t[3]); }
#pragma unroll
        for (int qq = 0; qq < 4; ++qq) {
            const float m = mx[qq], inv = m > 0.f ? 127.0f / m : 0.f; const int row = conv_rowmap<MODE>(n0 + 4 * c + qq);
            if (wave == 0 && kg == 0) SB[(size_t)e * N + row] = m * (1.0f / 127.0f);
            GAS v4u* dst = (GAS v4u*)(WQ + ((size_t)e * N + row) * DM + 256 * wave + 64 * kg);
            unsigned wd[16];
#pragma unroll
            for (int d = 0; d < 10; ++d) wd[d] = q4_pack((float)hlo[4 * d][qq >> 1][qq & 1], (float)hlo[4 * d + 1][qq >> 1][qq & 1], (float)hlo[4 * d + 2][qq >> 1][qq & 1], (float)hlo[4 * d + 3][qq >> 1][qq & 1], inv);
#pragma unroll
            for (int d = 0; d < 6; ++d) wd[10 + d] = q4_pack(v[4 * d][qq], v[4 * d + 1][qq], v[4 * d + 2][qq], v[4 * d + 3][qq], inv);
            dst[0] = (v4u){wd[0], wd[1], wd[2], wd[3]}; dst[1] = (v4u){wd[4], wd[5], wd[6], wd[7]}; dst[2] = (v4u){wd[8], wd[9], wd[10], wd[11]}; dst[3] = (v4u){wd[12], wd[13], wd[14], wd[15]};
        }
        __syncthreads();
        cur = nxt;
    }
    __syncthreads();
    return it;
}
__device__ __forceinline__ int conv_up_int8_queue(Frame& F, const float* wup, int qword = CW_QUPQ, int maxit = 0x7fffffff) { return conv_int8_queue<2, 4096>(F, wup, F.ws + WS_WUP, (float*)(F.ws + WS_SB), qword, maxit); }

__device__ __forceinline__ void p0_phase(Frame& F, const float* c, const float* cc, const float* wada, const float* win, const float* woa, const float* wob, const float* wout) {
    int tid = threadIdx.x; asm volatile("" : "+v"(tid)); const int lane = tid & 63, wave = __builtin_amdgcn_readfirstlane(tid >> 6); (void)lane; (void)wave;
    float* MODP = (float*)(F.ws + WS_MODP);
    if (blockIdx.x < 192) {
        const int chunk = blockIdx.x % 48, kg = blockIdx.x / 48;
        LAS float* s = (LAS float*)(F.lds);
        LAS float* red = (LAS float*)(F.lds + 40960);
        for (int i = tid; i < 5 * 2048; i += NWAVES * 64) { const int b = i >> 11, k = i & 2047; const float v = b < 4 ? c[b * 2048 + k] : cc[k]; s[i] = v / (1.0f + __expf(-v)); }
        __syncthreads();
        const float* W = wada + (size_t)(kg * 512 + wave * 64) * MODW + chunk * 256 + 4 * lane;
        const LAS float* sk = s + kg * 512 + wave * 64;
        f32x4 acc[5];
#pragma unroll
        for (int b = 0; b < 5; ++b) acc[b] = (f32x4){0.f, 0.f, 0.f, 0.f};
#pragma unroll 16
        for (int k = 0; k < 64; ++k) { const f32x4 w = *(const GAS f32x4*)(W + (size_t)k * MODW);
#pragma unroll
            for (int b = 0; b < 5; ++b) acc[b] += w * sk[b * 2048 + k]; }
#pragma unroll
        for (int b = 0; b < 5; ++b) *(LAS f32x4*)(red + (wave * 5 + b) * 256 + 4 * lane) = acc[b];
        __syncthreads();
        for (int i = tid; i < 1280; i += NWAVES * 64) { const int b = i >> 8, ci = i & 255; float t = 0.f;
#pragma unroll
            for (int w = 0; w < 8; ++w) t += red[(w * 5 + b) * 256 + ci];
            MODP[(size_t)(kg * 5 + b) * MODW + chunk * 256 + ci] = t; }
        __syncthreads();
    }
    if (F.G == 256) {
        const int bx = (int)blockIdx.x;
        if (bx >= 192) { conv_int8_task<1>(win, PROJ, 32 * (2 * (bx - 192)), F.ws + WS_WIN, (float*)(F.ws + WS_SBIN), (LAS float*)(F.lds + 1024), tid); conv_int8_task<1>(win, PROJ, 32 * (2 * (bx - 192) + 1), F.ws + WS_WIN, (float*)(F.ws + WS_SBIN), (LAS float*)(F.lds + 1024), tid); }
        else if (bx < PROJ / 32 - 128) conv_int8_task<1>(win, PROJ, 32 * (128 + bx), F.ws + WS_WIN, (float*)(F.ws + WS_SBIN), (LAS float*)(F.lds + 1024), tid);
    } else
    for (int tk = blockIdx.x; tk < PROJ / 32; tk += F.G)
        conv_int8_task<1>(win, PROJ, 32 * tk, F.ws + WS_WIN, (float*)(F.ws + WS_SBIN), (LAS float*)(F.lds + 1024), tid);
}
__device__ __forceinline__ void conv_mixer_out(Frame& F, const float* woa, const float* wob, const float* wout, int blk, int nblk) {
    int tid = threadIdx.x; asm volatile("" : "+v"(tid)); const int lane = tid & 63, wave = __builtin_amdgcn_readfirstlane(tid >> 6);
    for (int tk = blk; tk < 128; tk += nblk) {
        if (tk < 64) conv_int8_task<0, 1024>(woa, DM, 32 * tk, F.ws + WS_WOA, (float*)(F.ws + WS_SBOA), (LAS float*)(F.lds + 1024), tid);
        else conv_int8_task<0, 1024>(wob, DM, 32 * (tk - 64), F.ws + WS_WOB, (float*)(F.ws + WS_SBOB), (LAS float*)(F.lds + 1024), tid);
    }
    for (int tk = blk; tk < 64; tk += nblk) conv_int8_task<0>(wout, DM, 32 * tk, F.ws + WS_WOUT, (float*)(F.ws + WS_SBOUT), (LAS float*)(F.lds + 1024), tid);
    (void)lane; (void)wave;
}
__device__ __forceinline__ void p1_phase(Frame& F, const float* bada) {
    int tid = threadIdx.x; asm volatile("" : "+v"(tid)); const int lane = tid & 63, wave = __builtin_amdgcn_readfirstlane(tid >> 6); (void)lane; (void)wave;
    const float* MODP = (const float*)(F.ws + WS_MODP); float* MOD = (float*)(F.ws + WS_MOD);
    for (int i = blockIdx.x * (NWAVES * 64) + tid; i < 5 * MODW; i += F.G * NWAVES * 64) { const int n = i % MODW;
        MOD[i] = bada[n] + ((MODP[i] + MODP[i + 5 * MODW]) + (MODP[i + 10 * MODW] + MODP[i + 15 * MODW])); }
}
__device__ __forceinline__ void p2_phase(Frame& F, const float* x, const float* ctx, const float* bada) {
    int tid = threadIdx.x; asm volatile("" : "+v"(tid)); const int lane = tid & 63, wave = __builtin_amdgcn_readfirstlane(tid >> 6); (void)lane; (void)wave;
    const float* MOD = (const float*)(F.ws + WS_MOD); unsigned* HQ = (unsigned*)(F.ws + WS_H); float* SH = (float*)(F.ws + WS_SH);
    LAS f32x4* mv = (LAS f32x4*)F.lds;
    {
        const GAS f32x4* P4 = (const GAS f32x4*)(F.ws + WS_MODP); const GAS f32x4* b4 = (const GAS f32x4*)bada; constexpr int Q = 5 * MODW / 4, RW = MODW / 4;
        for (int i = tid; i < 5 * 1024; i += NWAVES * 64) { const int o = (i >> 10) * RW + (i & 1023); mv[i] = b4[i & 1023] + ((P4[o] + P4[o + Q]) + (P4[o + 2 * Q] + P4[o + 3 * Q])); }
        GAS f32x4* M4 = (GAS f32x4*)(F.ws + WS_MOD);
        for (int i = blockIdx.x * (NWAVES * 64) + tid; i < Q; i += F.G * NWAVES * 64) M4[i] = b4[i % RW] + ((P4[i] + P4[i + Q]) + (P4[i + 2 * Q] + P4[i + 3 * Q]));
    }
    __syncthreads();
    const int gw = F.vcu * NWAVES + wave, NGW = F.G * NWAVES;
    f32x4 xn[8];
    if (gw < MH) { const GAS f32x4* x4 = (const GAS f32x4*)(gw < MT ? x + (size_t)gw * DM : ctx + (size_t)(gw - MT) * DM) + lane;
#pragma unroll
        for (int j = 0; j < 8; ++j) xn[j] = x4[64 * j]; }
    for (int m = gw; m < MH; m += NGW) {
        const int b = m < MT ? (m >> 12) : 4; const LAS f32x4* sh4 = mv + b * 1024 + lane; const LAS f32x4* sc4 = sh4 + 512;
        f32x4 o[8]; float amax = 0.f;
#pragma unroll
        for (int j = 0; j < 8; ++j) { o[j] = xn[j] * (sc4[64 * j] + 1.0f) + sh4[64 * j];
            amax = fmaxf(amax, fmaxf(fmaxf(fabsf(o[j][0]), fabsf(o[j][1])), fmaxf(fabsf(o[j][2]), fabsf(o[j][3])))); }
        const int m2 = m + NGW;
        if (m2 < MH) { const GAS f32x4* x4 = (const GAS f32x4*)(m2 < MT ? x + (size_t)m2 * DM : ctx + (size_t)(m2 - MT) * DM) + lane;
#pragma unroll
            for (int j = 0; j < 8; ++j) xn[j] = x4[64 * j]; }
#pragma unroll
        for (int q = 1; q < 64; q <<= 1) amax = fmaxf(amax, __shfl_xor(amax, q));
        const float qinv = amax > 0.f ? 127.0f / amax : 0.f;
        if (lane == 0) SH[m] = amax * (1.0f / 127.0f);
        GAS unsigned* ho = (GAS unsigned*)(HQ + (size_t)m * (DM / 4)) + lane;
#pragma unroll
        for (int j = 0; j < 8; ++j) ho[64 * j] = q4_pack(o[j][0], o[j][1], o[j][2], o[j][3], qinv);
    }
    __syncthreads();
}
struct CfgA { static constexpr int QP = 1024, KP = 1024, VP = 1024, OP = 2048; static constexpr bool MASK = false; };
struct CfgB { static constexpr int QP = 1024, KP = 128, VP = 128, OP = 1024; static constexpr bool MASK = true; };
__device__ __forceinline__ void p4_phase(Frame& F, char* lds_generic, const float* sinks, int rank, int W) {
    using abf = attn_body::bf16;
    const abf* QA = (const abf*)(F.ws + WS_QA); const abf* KA = (const abf*)(F.ws + WS_KA); const abf* VA = (const abf*)(F.ws + WS_VA);
    const abf* QB = (const abf*)(F.ws + WS_QB); const abf* KB = (const abf*)(F.ws + WS_KB); const abf* VB = (const abf*)(F.ws + WS_VB);
    abf* O4 = (abf*)(F.ws + WS_O4); abf* OB = (abf*)(F.ws + WS_OB);
    for (int u = rank; u < 1024; u += W) {
        const int b = u >> 8, h = (u >> 5) & 7, j = (u >> 4) & 1, qb = u & 15; const size_t qrow = (size_t)b * SEQ + qb * 256, krow = (size_t)b * KVR;
        attn_body::AttnArgs aa; aa.Qw0 = QA + qrow * 1024 + (2 * h + j) * 64; aa.Kh = KA + krow * 1024 + (2 * h + j) * 64; aa.Vh = VA + krow * 1024 + h * 128;
        aa.Ow0 = O4 + qrow * 2048 + (h * 2 + j) * 128; aa.NT = KVR / 64; aa.win0 = 0; aa.qpos0 = 0; aa.sinkl2 = 0.f;
        attn_body::attn_unit128<CfgA, 8>(aa, lds_generic);
    }
    for (int u = rank; u < 1024; u += W) {
        const int b = u >> 8, qh = (u >> 4) & 15, qb = u & 15, kvh = qh >> 3; const size_t qrow = (size_t)b * SEQ + qb * 256, krow = (size_t)b * KVR;
        const int w0 = qb == 0 ? 0 : 256 * qb - 128, w1 = qb == 15 ? SEQ : 256 * qb + 384;
        attn_body::AttnArgs aa; aa.Qw0 = QB + qrow * 1024 + qh * 64; aa.Kh = KB + krow * 128 + kvh * 64; aa.Vh = VB + krow * 128 + kvh * 64; aa.Ow0 = OB + qrow * 1024 + qh * 64;
        aa.NT = 4 + (w1 - w0) / 64; aa.win0 = w0; aa.qpos0 = 256 * qb; aa.sinkl2 = sinks[qh] * 1.4426950408889634f;
        attn_body::attn_unit<CfgB, 8>(aa, lds_generic);
    }
}
__device__ __forceinline__ void p4c_phase(Frame& F, const float* lq1, const float* lk1, const float* lq2, const float* lk2, const float* subw) {
    int tid = threadIdx.x; asm volatile("" : "+v"(tid)); const int lane = tid & 63, wave = __builtin_amdgcn_readfirstlane(tid >> 6);
    const bf16* O4 = (const bf16*)(F.ws + WS_O4); unsigned char* OA = F.ws + WS_OA; float* SOA = (float*)(F.ws + WS_SOA);
    const bf16* OB = (const bf16*)(F.ws + WS_OB); unsigned char* OBQ = F.ws + WS_OBQ; float* SOB = (float*)(F.ws + WS_SOB);
    float lam; { const float a1 = lq1[lane] * lk1[lane], a2 = lq2[lane] * lk2[lane]; lam = __expf(wave_sum(a1)) - __expf(wave_sum(a2)) + LAM_INIT; }
    const int h = lane >> 3, part = lane & 7; float sw[16];
#pragma unroll
    for (int i = 0; i < 16; ++i) sw[i] = subw[part * 16 + i] * (1.0f - LAM_INIT);
    const int gw = F.vcu * NWAVES + wave, NGW = F.G * NWAVES;
    v4u na0, na1, nb0, nb1, nc0, nc1;
#define P4C_LOAD(mm) do { const GAS v4u* o0_ = (const GAS v4u*)(O4 + (size_t)(mm) * 2048 + h * 256 + part * 16); const GAS v4u* o1_ = (const GAS v4u*)(O4 + (size_t)(mm) * 2048 + h * 256 + 128 + part * 16); \
        const GAS v4u* bp_ = (const GAS v4u*)(OB + (size_t)(mm) * 1024 + lane * 16); na0 = o0_[0]; na1 = o0_[1]; nb0 = o1_[0]; nb1 = o1_[1]; nc0 = bp_[0]; nc1 = bp_[1]; } while (0)
    if (gw < MT) P4C_LOAD(gw);
    for (int m = gw; m < MT; m += NGW) {
        const v4u a0 = na0, a1 = na1, b0 = nb0, b1 = nb1, c0 = nc0, c1 = nc1;
        const unsigned aw[8] = {a0.x, a0.y, a0.z, a0.w, a1.x, a1.y, a1.z, a1.w}, bw[8] = {b0.x, b0.y, b0.z, b0.w, b1.x, b1.y, b1.z, b1.w};
        float d[16]; float ss = 0.f;
#pragma unroll
        for (int q = 0; q < 8; ++q) { d[2 * q] = pg8::bf_lo(aw[q]) - lam * pg8::bf_lo(bw[q]); d[2 * q + 1] = pg8::bf_hi(aw[q]) - lam * pg8::bf_hi(bw[q]); ss += d[2 * q] * d[2 * q] + d[2 * q + 1] * d[2 * q + 1]; }
        ss += __shfl_xor(ss, 1); ss += __shfl_xor(ss, 2); ss += __shfl_xor(ss, 4);
        const float rs = 1.0f / sqrtf(ss * (1.0f / 128.0f) + LN_EPS);
        float amax = 0.f;
#pragma unroll
        for (int q = 0; q < 16; ++q) { d[q] = d[q] * rs * sw[q]; amax = fmaxf(amax, fabsf(d[q])); }
        const unsigned cw[8] = {c0.x, c0.y, c0.z, c0.w, c1.x, c1.y, c1.z, c1.w}; float e[16]; float bmax = 0.f;
#pragma unroll
        for (int q = 0; q < 8; ++q) { e[2 * q] = pg8::bf_lo(cw[q]); e[2 * q + 1] = pg8::bf_hi(cw[q]); bmax = fmaxf(bmax, fmaxf(fabsf(e[2 * q]), fabsf(e[2 * q + 1]))); }
#pragma unroll
        for (int o = 1; o < 64; o <<= 1) { amax = fmaxf(amax, __shfl_xor(amax, o)); bmax = fmaxf(bmax, __shfl_xor(bmax, o)); }
        const float ai = amax > 0.f ? 127.0f / amax : 0.f, bi = bmax > 0.f ? 127.0f / bmax : 0.f;
        if (m + NGW < MT) P4C_LOAD(m + NGW);
        if (lane == 0) { SOA[m] = amax * (1.0f / 127.0f); SOB[m] = bmax * (1.0f / 127.0f); }
        *(GAS v4u*)(OA + (size_t)m * 1024 + h * 128 + part * 16) = (v4u){q4_pack(d[0], d[1], d[2], d[3], ai), q4_pack(d[4], d[5], d[6], d[7], ai), q4_pack(d[8], d[9], d[10], d[11], ai), q4_pack(d[12], d[13], d[14], d[15], ai)};
        *(GAS v4u*)(OBQ + (size_t)m * 1024 + lane * 16) = (v4u){q4_pack(e[0], e[1], e[2], e[3], bi), q4_pack(e[4], e[5], e[6], e[7], bi), q4_pack(e[8], e[9], e[10], e[11], bi), q4_pack(e[12], e[13], e[14], e[15], bi)};
    }
}
#undef P4C_LOAD
__device__ __forceinline__ void p7_phase(Frame& F, const float* g1n, const float* b1n, const float* wrt, const float* brt) {
    int tid = threadIdx.x; asm volatile("" : "+v"(tid)); const int lane = tid & 63, wave = __builtin_amdgcn_readfirstlane(tid >> 6); (void)lane; (void)wave;
    typedef float f32x16 __attribute__((ext_vector_type(16)));
    const float* R = (const float*)(F.ws + WS_R); float* STATS = (float*)(F.ws + WS_STATS); unsigned* HMQ = (unsigned*)(F.ws + WS_HM); float* SA = (float*)(F.ws + WS_SA);     const float* MOD = (const float*)(F.ws + WS_MOD);
    int* PSLOT = (int*)(F.ws + WS_PSLOT); float* PGATE = (float*)(F.ws + WS_PGATE);
    LAS float* part = (LAS float*)F.lds;
    LAS float* lg = (LAS float*)(F.lds + 34816);
    LAS int* cntL = (LAS int*)(F.lds + 40960);
    LAS int* baseL = cntL + 32;
    LAS float* stL = (LAS float*)(F.lds + 41472);
    LAS f32x4* vecL = (LAS f32x4*)(F.lds + 49152);
    for (int tile = blockIdx.x; tile < MT / 32; tile += F.G) {
        const int R0 = tile * 32; const float* modb = MOD + (size_t)(R0 >> 12) * MODW;
        if (tid < 32) cntL[tid] = 0;
        for (int i = tid; i < 2048; i += NWAVES * 64) { const int w = i >> 9, d = i & 511; const float* src = w == 0 ? g1n : w == 1 ? b1n : w == 2 ? modb + 4 * DM : modb + 3 * DM; vecL[i] = ((const GAS f32x4*)src)[d]; }
        f32x4 vv[4][8];
#pragma unroll
        for (int i = 0; i < 4; ++i) { const GAS f32x4* r4 = (const GAS f32x4*)(R + (size_t)(R0 + 4 * wave + i) * DM) + lane;
#pragma unroll
            for (int j = 0; j < 8; ++j) vv[i][j] = r4[64 * j]; }
        __syncthreads();
#pragma unroll
        for (int i = 0; i < 4; ++i) {
            const size_t row = R0 + 4 * wave + i;
            f32x4 v[8]; float s = 0.f;
#pragma unroll
            for (int j = 0; j < 8; ++j) { v[j] = vv[i][j]; s += (v[j][0] + v[j][1]) + (v[j][2] + v[j][3]); }
            const float mean = wave_sum(s) * (1.0f / DM); float s2 = 0.f;
#pragma unroll
            for (int j = 0; j < 8; ++j) { v[j] = v[j] - mean; s2 += (v[j][0] * v[j][0] + v[j][1] * v[j][1]) + (v[j][2] * v[j][2] + v[j][3] * v[j][3]); }
            const float rstd = 1.0f / sqrtf(wave_sum(s2) * (1.0f / DM) + LN_EPS);
            if (lane == 0) { STATS[row * 2] = mean; STATS[row * 2 + 1] = rstd; stL[(4 * wave + i) * 2] = mean; stL[(4 * wave + i) * 2 + 1] = rstd; }
            float amax = 0.f;
#pragma unroll
            for (int j = 0; j < 8; ++j) { const int d4 = lane + 64 * j;
                const f32x4 g = vecL[d4], bb = vecL[512 + d4], sc = vecL[1024 + d4], sh = vecL[1536 + d4];
                const f32x4 x1 = v[j] * rstd * g + bb; v[j] = x1 * (sc + 1.0f) + sh;
                amax = fmaxf(amax, fmaxf(fmaxf(fabsf(v[j][0]), fabsf(v[j][1])), fmaxf(fabsf(v[j][2]), fabsf(v[j][3])))); }
#pragma unroll
            for (int o = 1; o < 64; o <<= 1) amax = fmaxf(amax, __shfl_xor(amax, o));
            const float qinv = amax > 0.f ? 127.0f / amax : 0.f;
            if (lane == 0) SA[row] = amax * (1.0f / 127.0f);
            GAS unsigned* ho = (GAS unsigned*)(HMQ + row * (DM / 4)) + lane;
#pragma unroll
            for (int j = 0; j < 8; ++j) ho[64 * j] = q4_pack(v[j][0], v[j][1], v[j][2], v[j][3], qinv);
        }
        VM_WAIT(); __syncthreads();
        {
            const int rw = lane & 31, hf = lane >> 5;
            const float* xr = R + (size_t)(R0 + rw) * DM + 256 * wave + 4 * hf; const float mu = stL[rw * 2], rs = stL[rw * 2 + 1];
            const float* wp = wrt + (size_t)(256 * wave + 4 * hf) * NE + rw;
            const LAS f32x4* vl = vecL + 64 * wave + hf;
            f32x16 acc;
#pragma unroll
            for (int q = 0; q < 16; ++q) acc[q] = 0.f;
#pragma unroll 8
            for (int c = 0; c < 32; ++c) {
                const f32x4 r4 = *(const GAS f32x4*)(xr + 8 * c), g4 = vl[2 * c], b4 = vl[512 + 2 * c], s4 = vl[1024 + 2 * c], h4 = vl[1536 + 2 * c];
                const f32x4 x4 = (r4 - mu) * rs * g4 + b4; const f32x4 hm = x4 * (s4 + 1.0f) + h4;
#pragma unroll
                for (int i = 0; i < 4; ++i) acc = __builtin_amdgcn_mfma_f32_32x32x2f32(hm[i], wp[(size_t)(8 * c + i) * NE], acc, 0, 0, 0);
            }
#pragma unroll
            for (int q = 0; q < 16; ++q) part[(wave * 32 + (q & 3) + 8 * (q >> 2) + 4 * hf) * 33 + rw] = acc[q];
        }
        __syncthreads();
        for (int p = tid; p < 1024; p += NWAVES * 64) { const int rr = p >> 5, e = p & 31; float t = brt[e];
#pragma unroll
            for (int w = 0; w < 8; ++w) t += part[(w * 32 + rr) * 33 + e];
            lg[rr * 33 + e] = t; }
        __syncthreads();
        int sel0 = 0, sel1 = 0, sel2 = 0, sel3 = 0, lr0 = 0, lr1 = 0, lr2 = 0, lr3 = 0; float gt0 = 0.f, gt1 = 0.f, gt2 = 0.f, gt3 = 0.f;
        if (tid < 32) {
            float val[4]; int sel[4];
#pragma unroll
            for (int k = 0; k < 4; ++k) { float best = -INFINITY; int bi = 0;
                for (int e = 0; e < NE; ++e) { const float vv = lg[tid * 33 + e]; if (vv > best) { best = vv; bi = e; } }
                sel[k] = bi; val[k] = best; lg[tid * 33 + bi] = -INFINITY; }
            const float p1 = __expf(val[1] - val[0]), p2 = __expf(val[2] - val[0]), p3 = __expf(val[3] - val[0]); const float inv = 1.0f / (1.0f + p1 + p2 + p3);
            gt0 = inv; gt1 = p1 * inv; gt2 = p2 * inv; gt3 = p3 * inv;
            sel0 = sel[0]; sel1 = sel[1]; sel2 = sel[2]; sel3 = sel[3];
            lr0 = atomicAdd((int*)(cntL + sel0), 1); lr1 = atomicAdd((int*)(cntL + sel1), 1); lr2 = atomicAdd((int*)(cntL + sel2), 1); lr3 = atomicAdd((int*)(cntL + sel3), 1);
        }
        __syncthreads();
        if (tid < 32) { const int cl = cntL[tid]; baseL[tid] = cl ? (int)__hip_atomic_fetch_add((unsigned*)(F.ctl + CW_CNT + tid), (unsigned)cl, __ATOMIC_RELAXED, __HIP_MEMORY_SCOPE_AGENT) : 0; }
        __syncthreads();
        if (tid < 32) { const int a0 = (R0 + tid) * 4;
            const int v0 = sel0 * 16384 + ((baseL[sel0] + lr0) & 16383), v1 = sel1 * 16384 + ((baseL[sel1] + lr1) & 16383), v2 = sel2 * 16384 + ((baseL[sel2] + lr2) & 16383), v3 = sel3 * 16384 + ((baseL[sel3] + lr3) & 16383);
            PSLOT[v0] = a0; PSLOT[v1] = a0 + 1; PSLOT[v2] = a0 + 2; PSLOT[v3] = a0 + 3; *(GAS v4u*)((int*)(F.ws + WS_INV) + a0) = (v4u){(unsigned)v0, (unsigned)v1, (unsigned)v2, (unsigned)v3}; PGATE[v0] = gt0; PGATE[v1] = gt1; PGATE[v2] = gt2; PGATE[v3] = gt3; }
        __syncthreads();
    }
}
__device__ __forceinline__ void p8_phase(Frame& F) {
    int tid = threadIdx.x; asm volatile("" : "+v"(tid)); const int lane = tid & 63, wave = __builtin_amdgcn_readfirstlane(tid >> 6); (void)lane; (void)wave;
    LAS int* cnt = (LAS int*)(F.lds + TBL_OFF); LAS int* pstart = cnt + 32; LAS int* nmt = cnt + 96; LAS int* mt_e = cnt + 128;
    if (tid < 32) cnt[tid] = (int)__hip_atomic_load((unsigned*)(F.ctl + CW_CNT + tid), RLX_AGENT);
    __syncthreads();
    if (tid == 0) { int acc = 0, nt = 0;
        for (int e = 0; e < NE; ++e) { pstart[e] = acc; const int t = (cnt[e] + 255) >> 8; for (int j = 0; j < t && nt < MAXMT; ++j) mt_e[nt++] = e; acc += t * 256; }
        pstart[32] = acc; nmt[0] = nt; }
    __syncthreads();
}
__device__ __forceinline__ unsigned requant4(unsigned w, float ratio) {
    return pg8::q4p((float)(int)(signed char)(w & 255u), (float)(int)(signed char)((w >> 8) & 255u), (float)(int)(signed char)((w >> 16) & 255u), (float)((int)w >> 24), ratio);
}
__device__ __forceinline__ void p9b_phase(Frame& F, int nrows, const float* RMAXP, unsigned char* ACTQ, float* SACT) {
    int tid = threadIdx.x; asm volatile("" : "+v"(tid)); const int lane = tid & 63, wave = __builtin_amdgcn_readfirstlane(tid >> 6);
    const int gw = F.vcu * NWAVES + wave, NGW = F.G * NWAVES;
    float nml = 0.f; v4u nw0 = (v4u){0u, 0u, 0u, 0u}, nw1 = nw0;
#define P9B_LOAD(rr) do { nml = RMAXP[(size_t)(rr) * 64 + lane]; const GAS v4u* p_ = (const GAS v4u*)(ACTQ + (size_t)(rr) * DM) + 2 * lane; nw0 = p_[0]; nw1 = p_[1]; } while (0)
    if (gw < nrows) P9B_LOAD(gw);
    for (int r = gw; r < nrows; r += NGW) {
        float ml = nml; const v4u w0 = nw0, w1 = nw1;
        GAS v4u* p = (GAS v4u*)(ACTQ + (size_t)r * DM) + 2 * lane;
        if (!(ml < 1e30f)) ml = 0.f;
        float mx = ml;
#pragma unroll
        for (int o = 1; o < 64; o <<= 1) mx = fmaxf(mx, __shfl_xor(mx, o));
        const float ratio = mx > 0.f ? ml / mx : 0.f;
        const v4u o0 = (v4u){requant4(w0.x, ratio), requant4(w0.y, ratio), requant4(w0.z, ratio), requant4(w0.w, ratio)}, o1 = (v4u){requant4(w1.x, ratio), requant4(w1.y, ratio), requant4(w1.z, ratio), requant4(w1.w, ratio)};
        if (r + NGW < nrows) P9B_LOAD(r + NGW);
        if (lane == 0) SACT[r] = mx * (1.0f / 127.0f);
        p[0] = o0; p[1] = o1;
    }
#undef P9B_LOAD
}
__device__ __forceinline__ void p11_phase(Frame& F, const float* g1n, const float* b1n, const float* g2n, const float* b2n) {
    int tid = threadIdx.x; asm volatile("" : "+v"(tid)); const int lane0 = tid & 63, wave = __builtin_amdgcn_readfirstlane(tid >> 6); (void)wave;
    const float* R = (const float*)(F.ws + WS_R); const float* STATS = (const float*)(F.ws + WS_STATS); const bf16* YS = (const bf16*)(F.ws + WS_YSG); const float* MOD = (const float*)(F.ws + WS_MOD);
    const int* INV = (const int*)(F.ws + WS_INV); const LAS int* t_ps = (const LAS int*)(F.lds + TBL_OFF) + 32;
    LAS f32x4* vec = (LAS f32x4*)F.lds;
    for (int i = tid; i < 4096; i += NWAVES * 64) { const int w = i >> 9, d = i & 511; const float* src = w == 0 ? g1n : w == 1 ? b1n : w == 2 ? g2n : w == 3 ? b2n : MOD + (size_t)(w - 4) * MODW + 5 * DM; vec[i] = ((const GAS f32x4*)src)[d]; }
    __syncthreads();
    const int gw = F.vcu * NWAVES + wave, NGW = F.G * NWAVES;
    f32x4 nv[8]; u32x2 nyw[4][8]; float nmu = 0.f, nrs = 0.f; int iv[4] = {0, 0, 0, 0};
#define P11_INV(mm) do { _Pragma("unroll") for (int k_ = 0; k_ < 4; ++k_) iv[k_] = INV[4 * (mm) + k_]; } while (0)
#define P11_LOAD(mm) do { int ln_ = lane0; asm volatile("" : "+v"(ln_)); const GAS f32x4* x4_ = (const GAS f32x4*)(R + (size_t)(mm) * DM) + ln_; nmu = STATS[(size_t)(mm) * 2]; nrs = STATS[(size_t)(mm) * 2 + 1]; \
        const GAS u32x2* y8_[4]; _Pragma("unroll") for (int k_ = 0; k_ < 4; ++k_) { const int v_ = __builtin_amdgcn_readfirstlane(iv[k_]); y8_[k_] = (const GAS u32x2*)(YS + (size_t)(t_ps[v_ >> 14] + (v_ & 16383)) * DM) + ln_; } \
        _Pragma("unroll") for (int j_ = 0; j_ < 8; ++j_) { nv[j_] = x4_[64 * j_]; _Pragma("unroll") for (int k_ = 0; k_ < 4; ++k_) nyw[k_][j_] = y8_[k_][64 * j_]; } } while (0)
    if (gw < MT) { P11_INV(gw); P11_LOAD(gw); if (gw + NGW < MT) P11_INV(gw + NGW); }
    for (int m = gw; m < MT; m += NGW) {
        int lane = lane0; asm volatile("" : "+v"(lane));
        const float mu = nmu, rs = nrs; const LAS f32x4* g2v = vec + 2048 + (m >> 12) * 512;
        f32x4 v[8]; float s = 0.f;
#pragma unroll
        for (int j = 0; j < 8; ++j) { f32x4 mo = (f32x4){0.f, 0.f, 0.f, 0.f};
#pragma unroll
            for (int k = 0; k < 4; ++k) { const u32x2 w = nyw[k][j]; mo += (f32x4){pg8::bf_lo(w.x), pg8::bf_hi(w.x), pg8::bf_lo(w.y), pg8::bf_hi(w.y)}; }
            const f32x4 x1 = (nv[j] - mu) * rs * vec[lane + 64 * j] + vec[512 + lane + 64 * j];
            v[j] = x1 * DN_ALPHA + g2v[lane + 64 * j] * mo; s += (v[j][0] + v[j][1]) + (v[j][2] + v[j][3]);
            if (j & 1) __builtin_amdgcn_sched_barrier(0); }
        const float mean = wave_sum(s) * (1.0f / DM); float s2 = 0.f;
#pragma unroll
        for (int j = 0; j < 8; ++j) { v[j] = v[j] - mean; s2 += (v[j][0] * v[j][0] + v[j][1] * v[j][1]) + (v[j][2] * v[j][2] + v[j][3] * v[j][3]); }
        const float rstd = 1.0f / sqrtf(wave_sum(s2) * (1.0f / DM) + LN_EPS);
        if (m + NGW < MT) { P11_LOAD(m + NGW); if (m + 2 * NGW < MT) P11_INV(m + 2 * NGW); }
        __builtin_amdgcn_sched_barrier(0);
        GAS f32x4* o4 = (GAS f32x4*)(F.out + (size_t)m * DM) + lane;
#pragma unroll
        for (int j = 0; j < 8; ++j) o4[64 * j] = v[j] * rstd * vec[1024 + lane + 64 * j] + vec[1536 + lane + 64 * j];
    }
#undef P11_INV
#undef P11_LOAD
}

#ifndef PROBE
#define PROBE 0
#endif
struct Args { const float* in[26]; float* out; unsigned char* ws; };
__global__ void __launch_bounds__(NWAVES * 64, 2) mega_fwd(Args args) {
    extern __shared__ __attribute__((aligned(16))) unsigned char lds[];
    Frame F;
    F.lds = (LAS unsigned char*)lds;
    F.MISC = (volatile LAS unsigned*)(F.lds + MISC_OFF);
    F.tid = threadIdx.x; F.lane = F.tid & 63; F.wave = __builtin_amdgcn_readfirstlane(F.tid >> 6);
    F.G = gridDim.x; { const int bx = blockIdx.x; F.vcu = (F.G % 8 == 0) ? (bx % 8) * (F.G / 8) + bx / 8 : bx; }
    F.ws = args.ws; F.ctl = (gu32*)(args.ws + WS_CTL); F.out = args.out;
    for (int u = F.tid; u < (LDS_BYTES - LDSCTL_OFF) / 4; u += NWAVES * 64) ((LAS unsigned*)(F.lds + LDSCTL_OFF))[u] = 0u;
    __syncthreads();
    XcdBarrier bar = xcd_barrier_post((unsigned*)(F.ctl + CW_BAR), F.MISC + 8);
#define GRID_BAR() xcd_barrier(bar)
    unsigned char* ws = args.ws;
    pg8::bf16_t* WIN = (pg8::bf16_t*)(ws + WS_WIN);

    p0_phase(F, args.in[1], args.in[3], args.in[4], args.in[6], args.in[13], args.in[14], args.in[15]); GRID_BAR();
    p2_phase(F, args.in[0], args.in[2], args.in[5]); GRID_BAR();
    const bool split = (F.G == 256); const int NWRK = split ? NWORK : F.G; const bool conv_role = split && (int)blockIdx.x >= NWORK;
    if (conv_role) (void)xcd_barrier_arrive(bar);
    else {
        pg8::Gemm g{(const pg8::bf16_t*)(ws + WS_H), WIN, MH, PROJ, DM / 2}; pg8::InProjOrder S{NWRK, (int)blockIdx.x};
        pg8::EpiInProj E{(const float*)(ws + WS_SH), (const float*)(ws + WS_SBIN), (pg8::bf16_t*)(ws + WS_QA), (pg8::bf16_t*)(ws + WS_KA), (pg8::bf16_t*)(ws + WS_VA), (pg8::bf16_t*)(ws + WS_QB), (pg8::bf16_t*)(ws + WS_KB), (pg8::bf16_t*)(ws + WS_VB),
                          (pg8::bf16_t*)(ws + WS_GA), (pg8::bf16_t*)(ws + WS_GB), attn_body::C2, (LAS float*)(F.lds + TOK_OFF)};
        pg8::gemm_phase<pg8::EpiInProj, pg8::InProjOrder, PG8_ALIGN, PG8_SP2>(F.lds + RING_OFF, g, S, E);
    }
    if (conv_role) { conv_mixer_out(F, args.in[13], args.in[14], args.in[15], (int)blockIdx.x - NWORK, F.G - NWORK);
        conv_up_int8_queue(F, args.in[20]); conv_int8_queue<0, 2048>(F, args.in[22], F.ws + WS_WDN, (float*)(F.ws + WS_SBD), CW_QDNQ); xcd_barrier_wait(bar); }
    else if (split) {
        (void)xcd_barrier_arrive(bar);
        for (;;) {
            if (xcd_barrier_test(bar)) break;
            int done = conv_up_int8_queue(F, args.in[20], CW_QUPQ, 1);
            if (!done) done = conv_int8_queue<0, 2048>(F, args.in[22], F.ws + WS_WDN, (float*)(F.ws + WS_SBD), CW_QDNQ, 1);
            if (!done) { xcd_barrier_wait(bar); break; }
        }
    } else GRID_BAR();
    if (!conv_role) p4_phase(F, (char*)lds + RING_OFF, args.in[12], split ? (int)((blockIdx.x & 7) * (NWORK / 8) + (blockIdx.x >> 3)) : F.vcu, NWRK);
    if (!split) conv_mixer_out(F, args.in[13], args.in[14], args.in[15], (int)blockIdx.x, F.G);
    conv_up_int8_queue(F, args.in[20]);
    conv_int8_queue<0, 2048>(F, args.in[22], F.ws + WS_WDN, (float*)(F.ws + WS_SBD), CW_QDNQ);
    GRID_BAR();
    p4c_phase(F, args.in[7], args.in[8], args.in[9], args.in[10], args.in[11]);
    GRID_BAR();
    {
        pg8::Gemm g{(const pg8::bf16_t*)(ws + WS_OA), (const pg8::bf16_t*)(ws + WS_WOA), MT, DM, 512}; pg8::StaticOrder S; S.init(MT, DM, F.G, (int)blockIdx.x);
        pg8::EpiGate1Q E{(const pg8::bf16_t*)(ws + WS_GA), (float*)(ws + WS_Y1), (const float*)(ws + WS_SOA), (const float*)(ws + WS_SBOA), (LAS float*)(F.lds + TOK_OFF)};
        pg8::gemm_phase<pg8::EpiGate1Q, pg8::StaticOrder, PG8_ALIGN, PG8_SP2>(F.lds + RING_OFF, g, S, E);
    }
    VM_WAIT(); __syncthreads();
    {
        pg8::Gemm g{(const pg8::bf16_t*)(ws + WS_OBQ), (const pg8::bf16_t*)(ws + WS_WOB), MT, DM, 512}; pg8::StaticOrder S; S.init(MT, DM, F.G, (int)blockIdx.x);
        pg8::EpiGate2Q E{(const pg8::bf16_t*)(ws + WS_GB), (const float*)(ws + WS_Y1), ws + WS_Y, (float*)(ws + WS_RMAXY), (const float*)(ws + WS_SOB), (const float*)(ws + WS_SBOB), (LAS float*)(F.lds + TOK_OFF)};
        pg8::gemm_phase<pg8::EpiGate2Q, pg8::StaticOrder, PG8_ALIGN, PG8_SP2>(F.lds + RING_OFF, g, S, E);
    }
    GRID_BAR();
    {
        p9b_phase(F, MT, (const float*)(ws + WS_RMAXY), ws + WS_Y, (float*)(ws + WS_SY)); GRID_BAR();
        pg8::Gemm g{(const pg8::bf16_t*)(ws + WS_Y), (const pg8::bf16_t*)(ws + WS_WOUT), MT, DM, DM / 2}; pg8::StaticOrder S; S.init(MT, DM, F.G, (int)blockIdx.x);
        pg8::EpiOutQ E{args.in[0], (const float*)(ws + WS_MOD), (float*)(ws + WS_R), DN_ALPHA, (const float*)(ws + WS_SY), (const float*)(ws + WS_SBOUT), (LAS float*)(F.lds + TOK_OFF)};
        pg8::gemm_phase<pg8::EpiOutQ, pg8::StaticOrder, PG8_ALIGN, PG8_SP2>(F.lds + RING_OFF, g, S, E);
    }
    GRID_BAR();
    p7_phase(F, args.in[16], args.in[17], args.in[18], args.in[19]); GRID_BAR();
    p8_phase(F);
    const LAS int* t_cnt = (const LAS int*)(F.lds + TBL_OFF); const LAS int* t_pstart = t_cnt + 32; const LAS int* t_mte = t_cnt + 128; const int nMt = t_cnt[96];
    {
        pg8::Gemm g{(const pg8::bf16_t*)(ws + WS_HM), (const pg8::bf16_t*)(ws + WS_WUP), MT, NE * 4096, DM / 2}; pg8::MoeOrder S;     S.init(nMt, 16, F.G, (int)blockIdx.x, t_mte, t_cnt, t_pstart);
        LAS unsigned short* tokl = (LAS unsigned short*)(F.lds + TOK_OFF); LAS float* sclL = (LAS float*)(F.lds + TOK_OFF + 9216);
        if (F.wave < 4) {
            const int* PSL = (const int*)(ws + WS_PSLOT); const float* SAp = (const float*)(ws + WS_SA); int tl_ = threadIdx.x; asm volatile("" : "+v"(tl_));
            int tkv[18]; bool okv[18];
#pragma unroll
            for (int i = 0; i < 18; ++i) { pg8::Unit u; u.pm = 0; const bool has = S.next(i, u); const int pm = has ? u.pm : 0, e = t_mte[pm], q = pm * 256 + tl_ - t_pstart[e];
                okv[i] = has && q < t_cnt[e]; tkv[i] = PSL[okv[i] ? e * 16384 + q : 0]; }
            float sav[18];
#pragma unroll
            for (int i = 0; i < 18; ++i) { tkv[i] = okv[i] ? ((tkv[i] >> 2) & 16383) : 0; sav[i] = SAp[tkv[i]]; }
#pragma unroll
            for (int i = 0; i < 18; ++i) { tokl[i * 256 + tl_] = (unsigned short)tkv[i]; sclL[i * 256 + tl_] = okv[i] ? sav[i] : 0.f; }
        }
        __syncthreads();
        pg8::EpiUpQ E{args.in[21], ws + WS_ACTQ, (const float*)(ws + WS_SA), (const float*)(ws + WS_SB), (const int*)(ws + WS_PSLOT), t_cnt, t_pstart, (float*)(ws + WS_RMAXP), sclL, (LAS float*)(F.lds + EPL_OFF)};
        pg8::gemm_phase<pg8::EpiUpQ, pg8::MoeOrder, PG8_ALIGN, PG8_SP2, true, false>(F.lds + RING_OFF, g, S, E, tokl);
    }
    GRID_BAR();
    {
        p9b_phase(F, nMt * 256, (const float*)(ws + WS_RMAXP), ws + WS_ACTQ, (float*)(ws + WS_SACT)); GRID_BAR();
        pg8::Gemm g{(const pg8::bf16_t*)(ws + WS_ACTQ), (const pg8::bf16_t*)(ws + WS_WDN), MAXMT * 256, NE * DM, DM / 2}; pg8::MoeOrder S; S.init(nMt, 8, F.G, (int)blockIdx.x, t_mte, t_cnt, t_pstart);
        pg8::EpiDownQ E{args.in[23], (pg8::bf16_t*)(ws + WS_YSG), (const int*)(ws + WS_PSLOT), (const float*)(ws + WS_PGATE), t_cnt, t_pstart, (const float*)(ws + WS_SACT), (const float*)(ws + WS_SBD), (LAS float*)(F.lds + TOK_OFF)};
        pg8::gemm_phase<pg8::EpiDownQ, pg8::MoeOrder, PG8_ALIGN, PG8_SP2, false, false>(F.lds + RING_OFF, g, S, E);
    }
    GRID_BAR();
#if PROBE == 3 || PROBE == 4
    {
        pg8::Gemm g{(const pg8::bf16_t*)(ws + WS_HM), (const pg8::bf16_t*)(ws + WS_WUP), MT, NE * 4096, DM / 2}; pg8::MoeOrder S;     S.init(nMt, 16, F.G, (int)blockIdx.x, t_mte, t_cnt, t_pstart);
        LAS unsigned short* tokl = (LAS unsigned short*)(F.lds + TOK_OFF); LAS float* sclL = (LAS float*)(F.lds + TOK_OFF + 9216);
        { const int* PSL = (const int*)(ws + WS_PSLOT); pg8::Unit u;
          for (int i = 0; i < 18 && S.next(i, u); ++i) if (F.tid < 256) { const int e = t_mte[u.pm], q = u.pm * 256 + F.tid - t_pstart[e];
              const int tk = q < t_cnt[e] ? ((PSL[e * 16384 + q] >> 2) & 16383) : 0; tokl[i * 256 + F.tid] = (unsigned short)tk; sclL[i * 256 + F.tid] = q < t_cnt[e] ? ((const float*)(ws + WS_SA))[tk] : 0.f; } }
        __syncthreads();
        pg8::EpiUpQ E{args.in[21], ws + WS_ACTQ, (const float*)(ws + WS_SA), (const float*)(ws + WS_SB), (const int*)(ws + WS_PSLOT), t_cnt, t_pstart, (float*)(ws + WS_RMAXP), sclL, (LAS float*)(F.lds + EPL_OFF)};
        pg8::gemm_phase<pg8::EpiUpQ, pg8::MoeOrder, PG8_ALIGN, PG8_SP2, true, false>(F.lds + RING_OFF, g, S, E, tokl);
    }
    GRID_BAR();
#endif
#if PROBE == 3 || PROBE == 5 || PROBE == 6
    {
#if PROBE != 5
        p9b_phase(F, nMt * 256, (const float*)(ws + WS_RMAXP), ws + WS_ACTQ, (float*)(ws + WS_SACT)); GRID_BAR();
#endif
#if PROBE != 6
        pg8::Gemm g{(const pg8::bf16_t*)(ws + WS_ACTQ), (const pg8::bf16_t*)(ws + WS_WDN), MAXMT * 256, NE * DM, DM / 2}; pg8::MoeOrder S; S.init(nMt, 8, F.G, (int)blockIdx.x, t_mte, t_cnt, t_pstart);
        pg8::EpiDownQ E{args.in[23], (pg8::bf16_t*)(ws + WS_YSG), (const int*)(ws + WS_PSLOT), (const float*)(ws + WS_PGATE), t_cnt, t_pstart, (const float*)(ws + WS_SACT), (const float*)(ws + WS_SBD), (LAS float*)(F.lds + TOK_OFF)};
        pg8::gemm_phase<pg8::EpiDownQ, pg8::MoeOrder, PG8_ALIGN, PG8_SP2, false, false>(F.lds + RING_OFF, g, S, E);
#endif
    }
    GRID_BAR();
#endif
    p11_phase(F, args.in[16], args.in[17], args.in[24], args.in[25]);
#if PROBE == 8
    GRID_BAR(); p11_phase(F, args.in[16], args.in[17], args.in[24], args.in[25]);
#endif
#undef GRID_BAR
}

extern "C" void kernel_launch(void* const* d_in, const int* in_sizes, int n_in, void* d_out, int out_size, void* d_ws, size_t ws_size, hipStream_t stream) {
    static int grid = 0;
    if (grid == 0) {
        if (n_in != 26 || out_size != MT * DM || ws_size < WS_END) { fprintf(stderr, "kernel_launch: unexpected shapes (n_in %d, out %d, ws %zu); nothing launched\n", n_in, out_size, ws_size); grid = -1; return; }
        int dev = 0, cus = 0, per_cu = 0;
        if (hipGetDevice(&dev) != hipSuccess || hipDeviceGetAttribute(&cus, hipDeviceAttributeMultiprocessorCount, dev) != hipSuccess) { grid = -1; return; }
        if (hipFuncSetAttribute((const void*)mega_fwd, hipFuncAttributeMaxDynamicSharedMemorySize, LDS_BYTES) != hipSuccess) { fprintf(stderr, "kernel_launch: hipFuncSetAttribute failed\n"); grid = -1; return; }
        if (hipOccupancyMaxActiveBlocksPerMultiprocessor(&per_cu, (const void*)mega_fwd, NWAVES * 64, LDS_BYTES) != hipSuccess || per_cu < 1) fprintf(stderr, "kernel_launch: occupancy query reports %d\n", per_cu);
        (void)hipGetLastError();
        grid = cus;
    }
    if (grid < 0) return;
    if (hipMemsetAsync((char*)d_ws + WS_CTL, 0, CTL_ZERO_BYTES, stream) != hipSuccess) return;
    Args a{};
    for (int i = 0; i < 26; ++i) a.in[i] = (const float*)d_in[i];
    a.out = (float*)d_out; a.ws = (unsigned char*)d_ws;
    hipLaunchKernelGGL(mega_fwd, dim3(grid), dim3(NWAVES * 64), LDS_BYTES, stream, a);
}
```

```cpp
#include <hip/hip_runtime.h>
#include <cstdio>
#include <cstdint>
namespace pg8 {
#define PG8_LAS __attribute__((address_space(3)))
typedef unsigned short bf16_t;
typedef short bf16x8 __attribute__((ext_vector_type(8)));
typedef float f32x4 __attribute__((ext_vector_type(4)));
typedef unsigned u32x4 __attribute__((ext_vector_type(4)));
typedef int i32x4 __attribute__((ext_vector_type(4)));
template <class AccT> __device__ __forceinline__ AccT pg8_mma(bf16x8 b, bf16x8 a, AccT c);
template <> __device__ __forceinline__ f32x4 pg8_mma<f32x4>(bf16x8 b, bf16x8 a, f32x4 c) { return __builtin_amdgcn_mfma_f32_16x16x32_bf16(b, a, c, 0, 0, 0); }
template <> __device__ __forceinline__ i32x4 pg8_mma<i32x4>(bf16x8 b, bf16x8 a, i32x4 c) { return __builtin_amdgcn_mfma_i32_16x16x64_i8(__builtin_bit_cast(i32x4, b), __builtin_bit_cast(i32x4, a), c, 0, 0, 0); }
constexpr int BM = 256, BK = 64, HALF = 128, HTB = HALF * BK * 2  , STAGE_BYTES = 8 * HTB, NXCD = 8, WGM = 8;

__host__ __device__ __forceinline__ int lds_byte(int r, int c) { const int st = (r >> 4) * 2 + (c >> 5), rr = r & 15, cc = c & 31, ob = rr * 64 + cc * 2; return st * 1024 + (ob ^ (((ob >> 9) & 1) << 5)); }
__host__ __device__ __forceinline__ void stage_rc(int b, int& R, int& C) { const int st = b / 1024, sb = b % 1024, swz = sb ^ (((sb >> 9) & 1) << 5); R = (st >> 1) * 16 + swz / 64; C = (st & 1) * 32 + (swz % 64) / 2; }
__host__ __device__ __forceinline__ int perm32(int rho) { const int n = rho >> 4, i = rho & 15; return 8 * (i >> 2) + 4 * n + (i & 3); }

struct Unit { int pm, pn, pb, half, ord; };
struct Gemm { const bf16_t* A; const bf16_t* Bt; int M, N, K; };

struct StaticOrder {
    int nM, nN, nwg, G, c;
    __host__ __device__ __forceinline__ void init(int M, int N, int G_, int c_) { nM = M / BM; nN = N / BM; nwg = nM * nN; G = G_; c = c_; }
    __host__ __device__ __forceinline__ bool next(int i, Unit& u) const {
        const long L = (long)i * G + c; if (L >= nwg) return false;
        int wgid = (int)L; { const int q = nwg / NXCD, r = nwg % NXCD, xcd = wgid % NXCD, off = wgid / NXCD; wgid = (xcd < r ? xcd * (q + 1) : r * (q + 1) + (xcd - r) * q) + off; }
        const int nig = WGM * nN, gid = wgid / nig, fm = gid * WGM, gsz = (nM - fm) < WGM ? (nM - fm) : WGM;
        u.pm = fm + ((wgid % nig) % gsz); u.pn = (wgid % nig) / gsz; u.pb = u.pn; u.half = 0; u.ord = i; return true;
    }
    __device__ __forceinline__ void a_ready(const Unit&) const {}
    __device__ __forceinline__ void done(const Unit&) const {}
};

__device__ __forceinline__ unsigned cvt_pk_bf16(float lo, float hi) { unsigned r; asm volatile("v_cvt_pk_bf16_f32 %0, %1, %2" : "=v"(r) : "v"(lo), "v"(hi)); return r; }
typedef float f32x2 __attribute__((ext_vector_type(2)));
__device__ __forceinline__ f32x2 gelu_pk(f32x2 v) {
    const f32x2 av = __builtin_elementwise_abs(v), d = av * 0.2316418882f + 1.0f;
    f32x2 t; t.x = __builtin_amdgcn_rcpf(d.x); t.y = __builtin_amdgcn_rcpf(d.y);
    f32x2 q = t * 0.5307027145f + (-0.7265760135f); q = q * t + 0.7107068705f; q = q * t + (-0.142248368f); q = q * t + 0.127414796f; q = q * t;
    const f32x2 s = (v * v) * (-0.72134752044f);
    f32x2 e; e.x = __builtin_amdgcn_exp2f(s.x); e.y = __builtin_amdgcn_exp2f(s.y);
    const f32x2 m = v * (q * e), r = v - m;
    f32x2 o; o.x = v.x < 0.f ? m.x : r.x; o.y = v.y < 0.f ? m.y : r.y; return o;
}

template <int ACT  > struct EpiBf16 {
    typedef f32x4 AccT; static constexpr bool PERM = true, AFTER_DRAIN = false; static_assert(ACT == 0 || ACT == 1, "EpiBf16: ACT is 0 (none) or 1 (gelu_pk)");
    bf16_t* O; int ldc; const float* bias; int split_cols; size_t split_stride; float scale0;
    __device__ __forceinline__ void operator()(const f32x4 (&acc)[2][2][4][2], const Unit& u, int wr, int wc, int fr, int fq) const {
        const int row0 = u.pm * BM + wr * 64 + fr; int colt = u.pn * BM; bf16_t* base = O;
        float sc = 1.f; if (split_cols) { const int t = colt / split_cols; base += (size_t)t * split_stride; colt -= t * split_cols; if (t == 0) sc = scale0; }
        const int col0 = colt + wc * 32 + 8 * fq, bcol0 = u.pn * BM + wc * 32 + 8 * fq;
        f32x4 bv[2][2];
#pragma unroll
        for (int bj = 0; bj < 2; ++bj)
#pragma unroll
            for (int n = 0; n < 2; ++n) bv[bj][n] = bias ? *(const f32x4*)(bias + bcol0 + bj * HALF + 4 * n) : (f32x4){0.f, 0.f, 0.f, 0.f};
#pragma unroll
        for (int ai = 0; ai < 2; ++ai)
#pragma unroll
            for (int m = 0; m < 4; ++m) { bf16_t* rowp = base + (size_t)(row0 + ai * HALF + m * 16) * ldc + col0;
#pragma unroll
                for (int bj = 0; bj < 2; ++bj) { f32x4 v0 = acc[ai][bj][m][0] + bv[bj][0], v1 = acc[ai][bj][m][1] + bv[bj][1];
                    if (ACT == 1) { f32x2 a = gelu_pk((f32x2){v0[0], v0[1]}), b = gelu_pk((f32x2){v0[2], v0[3]}), c = gelu_pk((f32x2){v1[0], v1[1]}), d = gelu_pk((f32x2){v1[2], v1[3]});
                        v0 = (f32x4){a.x, a.y, b.x, b.y}; v1 = (f32x4){c.x, c.y, d.x, d.y}; }
                    v0 = v0 * sc; v1 = v1 * sc; u32x4 w; w.x = cvt_pk_bf16(v0[0], v0[1]); w.y = cvt_pk_bf16(v0[2], v0[3]); w.z = cvt_pk_bf16(v1[0], v1[1]); w.w = cvt_pk_bf16(v1[2], v1[3]);
                    *(u32x4*)(rowp + bj * HALF) = w; } }
    }
};

template <class Epi, class Sched, bool ALIGN_EPI = false, bool SP2 = false, bool GATHER = false, bool HALFU = false>
__device__ __forceinline__ void gemm_phase(PG8_LAS unsigned char* lds, const Gemm g, const Sched& S, const Epi& E, const PG8_LAS unsigned short* tokl = nullptr) {
    int tid_ = threadIdx.x; asm volatile("" : "+v"(tid_));
    const int tid = tid_, wid = __builtin_amdgcn_readfirstlane(tid >> 6), lane = tid & 63, wr = wid >> 2, wc = wid & 3, fr = lane & 15, fq = lane >> 4;
    const int K = g.K, nt = K / BK;
    unsigned voffA[2], voffB[2]; int rA_[2]; unsigned cA2_[2];
#pragma unroll
    for (int i = 0; i < 2; ++i) { int R, C; stage_rc(tid * 16 + i * 8192, R, C); const int Rb = Epi::PERM ? ((R & ~31) + perm32(R & 31)) : R;
        voffA[i] = (unsigned)(R * K + C) * 2u; voffB[i] = (unsigned)(Rb * K + C) * 2u; rA_[i] = R; cA2_[i] = (unsigned)C * 2u; }
    unsigned gc[2][2], gn[2][2];
#define PG8_GOFF(dst, ord) do { _Pragma("unroll") for (int h_ = 0; h_ < 2; ++h_) _Pragma("unroll") for (int i_ = 0; i_ < 2; ++i_) dst[h_][i_] = (unsigned)tokl[(ord) * 256 + h_ * 128 + rA_[i_]] * (unsigned)(K * 2) + cA2_[i_]; } while (0)
#define PG8_GCOPY(dst, src) do { dst[0][0] = src[0][0]; dst[0][1] = src[0][1]; dst[1][0] = src[1][0]; dst[1][1] = src[1][1]; } while (0)
    const size_t kstep = (size_t)(BK * 2);
    const size_t hstep = (size_t)HALF * K * 2;
    const size_t tstep = 2 * hstep;
    const unsigned ldsw = (unsigned)wid * 1024u;
    const int aoff = lds_byte(wr * 64 + fr, fq * 8), boff = lds_byte(wc * 32 + fr, fq * 8);
#define PG8_SA(b, h) (((b) * 2 + (h)) * HTB)
#define PG8_SB(b, h) ((4 + (b) * 2 + (h)) * HTB)
#define PG8_STAGE(bufoff, gbase, voff) do { _Pragma("unroll") for (int _i = 0; _i < 2; ++_i) \
        __builtin_amdgcn_global_load_lds((const unsigned*)((const char*)(gbase) + (voff)[_i]), (PG8_LAS unsigned*)(lds + (bufoff) + ldsw + _i * 8192), 16, 0, 0); } while (0)
#define PG8_STAGE_A(bufoff, gbase, h, nx) do { _Pragma("unroll") for (int _i = 0; _i < 2; ++_i) { const unsigned vo_ = GATHER ? ((nx) ? gn[h][_i] : gc[h][_i]) : voffA[_i]; \
        __builtin_amdgcn_global_load_lds((const unsigned*)((const char*)(gbase) + (GATHER ? (size_t)0 : (size_t)(h) * hstep) + vo_), (PG8_LAS unsigned*)(lds + (bufoff) + ldsw + _i * 8192), 16, 0, 0); } } while (0)
#define PG8_LDA(dst, b, h) do { _Pragma("unroll") for (int m = 0; m < 4; ++m) _Pragma("unroll") for (int k = 0; k < 2; ++k) dst[m][k] = *(const PG8_LAS bf16x8*)(lds + PG8_SA(b, h) + aoff + m * 2048 + k * 1024); } while (0)
#define PG8_LDB(dst, b, h) do { _Pragma("unroll") for (int n = 0; n < 2; ++n) _Pragma("unroll") for (int k = 0; k < 2; ++k) dst[n][k] = *(const PG8_LAS bf16x8*)(lds + PG8_SB(b, h) + boff + n * 2048 + k * 1024); } while (0)
#define PG8_MMA(ai, bj, At, Bt) do { __builtin_amdgcn_s_setprio(1); _Pragma("unroll") for (int m = 0; m < 4; ++m) _Pragma("unroll") for (int n = 0; n < 2; ++n) _Pragma("unroll") for (int k = 0; k < 2; ++k) \
        acc[ai][bj][m][n] = pg8_mma<typename Epi::AccT>(Bt[n][k], At[m][k], acc[ai][bj][m][n]); __builtin_amdgcn_s_setprio(0); } while (0)
#define PG8_WAIT_V(n) asm volatile("s_waitcnt vmcnt(" #n ")" ::: "memory")
#define PG8_WAIT_L(n) asm volatile("s_waitcnt lgkmcnt(" #n ")" ::: "memory")
#define PG8_BAR __builtin_amdgcn_s_barrier()
#define PG8_SCHED __builtin_amdgcn_sched_barrier(0)
    Unit cur, nxt; int ui = 0;
    if (!S.next(0, cur)) return;
    typedef typename Epi::AccT acc_t; acc_t acc[2][2][4][2];
#pragma unroll
    for (int a = 0; a < 2; ++a)
#pragma unroll
        for (int b = 0; b < 2; ++b)
#pragma unroll
            for (int m = 0; m < 4; ++m)
#pragma unroll
                for (int n = 0; n < 2; ++n) acc[a][b][m][n] = acc_t{};
    bf16x8 At[4][2], B0[2][2], B1[2][2];
    const char* cA = (const char*)g.A + (GATHER ? (size_t)0 : (size_t)cur.pm * tstep); const char* cB = (const char*)g.Bt + (size_t)cur.pb * tstep;
    if (GATHER) { PG8_GOFF(gc, cur.ord); PG8_GCOPY(gn, gc); }
    S.a_ready(cur);
    if constexpr (SP2) {
        PG8_STAGE(PG8_SB(0, 0), cB, voffB); PG8_STAGE(PG8_SB(0, 1), cB + hstep, voffB); PG8_STAGE_A(PG8_SA(0, 0), cA, 0, false); PG8_STAGE_A(PG8_SA(0, 1), cA, 1, false);
        if (wr == 1) PG8_BAR;
        PG8_WAIT_V(2); PG8_BAR;
        PG8_STAGE(PG8_SB(1, 0), cB + kstep, voffB); PG8_STAGE_A(PG8_SA(1, 0), cA + kstep, 0, false); PG8_STAGE(PG8_SB(1, 1), cB + hstep + kstep, voffB);
        PG8_WAIT_V(6); PG8_BAR;
    } else {
        PG8_STAGE(PG8_SB(0, 0), cB, voffB); PG8_STAGE_A(PG8_SA(0, 0), cA, 0, false); PG8_STAGE(PG8_SB(0, 1), cB + hstep, voffB); PG8_STAGE_A(PG8_SA(0, 1), cA, 1, false);
        if (wr == 1) PG8_BAR;
        PG8_WAIT_V(4); PG8_BAR;
        PG8_STAGE(PG8_SB(1, 0), cB + kstep, voffB); PG8_STAGE_A(PG8_SA(1, 0), cA + kstep, 0, false); PG8_STAGE(PG8_SB(1, 1), cB + hstep + kstep, voffB);
        PG8_WAIT_V(6); PG8_BAR;
    }
    for (;;) {
        const bool has_next = S.next(ui + 1, nxt);
        if (GATHER) { if (has_next) PG8_GOFF(gn, nxt.ord); else PG8_GCOPY(gn, gc); }
        const char* nA = (has_next && !GATHER) ? (const char*)g.A + (size_t)nxt.pm * tstep : cA; const char* nB = has_next ? (const char*)g.Bt + (size_t)nxt.pb * tstep : cB;
        for (int t = 0; t < nt; t += 2) {
            const bool last = (t == nt - 2);
            const char* a1 = cA + (size_t)(t + 1) * kstep;
            const char* a2 = last ? nA : cA + (size_t)(t + 2) * kstep; const char* b2 = last ? nB : cB + (size_t)(t + 2) * kstep;
            const char* a3 = a2 + kstep; const char* b3 = b2 + kstep;
            if (last && has_next) S.a_ready(nxt);
            if (last) { int ln_ = fq * 16 + fr; asm volatile("" : "+v"(ln_)); E.stage(cur, wid, ln_); }
            if constexpr (SP2) {
            PG8_LDB(B0, 0, 0); PG8_LDB(B1, 0, 1); PG8_SCHED; PG8_LDA(At, 0, 0); PG8_STAGE_A(PG8_SA(1, 1), a1, 1, false);
            PG8_WAIT_V(8); PG8_WAIT_L(0); PG8_BAR; if (!(HALFU && cur.half == 2)) { PG8_MMA(0, 0, At, B0); PG8_MMA(0, 1, At, B1); } PG8_BAR; PG8_SCHED;
            PG8_LDA(At, 0, 1); PG8_STAGE(PG8_SB(0, 0), b2, voffB); PG8_STAGE(PG8_SB(0, 1), b2 + hstep, voffB); PG8_STAGE_A(PG8_SA(0, 0), a2, 0, last);
            PG8_WAIT_V(8); PG8_WAIT_L(0); PG8_BAR; if (!(HALFU && cur.half == 1)) { PG8_MMA(1, 0, At, B0); PG8_MMA(1, 1, At, B1); } PG8_BAR; PG8_SCHED;
            PG8_LDB(B0, 1, 0); PG8_LDB(B1, 1, 1); PG8_SCHED; PG8_LDA(At, 1, 0); PG8_STAGE_A(PG8_SA(0, 1), a2, 1, last);
            PG8_WAIT_V(8); PG8_WAIT_L(0); PG8_BAR; if (!(HALFU && cur.half == 2)) { PG8_MMA(0, 0, At, B0); PG8_MMA(0, 1, At, B1); } PG8_BAR; PG8_SCHED;
            PG8_LDA(At, 1, 1); PG8_STAGE(PG8_SB(1, 0), b3, voffB); PG8_STAGE(PG8_SB(1, 1), b3 + hstep, voffB); PG8_STAGE_A(PG8_SA(1, 0), a3, 0, last);
            PG8_WAIT_V(8); PG8_WAIT_L(0); PG8_BAR; if (!(HALFU && cur.half == 1)) { PG8_MMA(1, 0, At, B0); PG8_MMA(1, 1, At, B1); } PG8_BAR; PG8_SCHED;
            } else {
            PG8_LDB(B0, 0, 0); PG8_SCHED; PG8_LDA(At, 0, 0); PG8_STAGE_A(PG8_SA(1, 1), a1, 1, false);
            PG8_WAIT_L(8); PG8_BAR; PG8_WAIT_L(0); PG8_MMA(0, 0, At, B0); PG8_BAR; PG8_SCHED;
            PG8_LDB(B1, 0, 1); PG8_STAGE(PG8_SB(0, 0), b2, voffB);
            PG8_BAR; PG8_WAIT_L(0); PG8_MMA(0, 1, At, B1); PG8_BAR;
            PG8_LDA(At, 0, 1); PG8_STAGE_A(PG8_SA(0, 0), a2, 0, last);
            PG8_BAR; PG8_WAIT_L(0); PG8_MMA(1, 0, At, B0); PG8_BAR; PG8_SCHED;
            PG8_STAGE(PG8_SB(0, 1), b2 + hstep, voffB);
            PG8_WAIT_V(6); PG8_BAR; PG8_MMA(1, 1, At, B1); PG8_BAR;
            PG8_LDB(B0, 1, 0); PG8_SCHED; PG8_LDA(At, 1, 0); PG8_STAGE_A(PG8_SA(0, 1), a2, 1, last);
            PG8_WAIT_L(8); PG8_BAR; PG8_WAIT_L(0); PG8_MMA(0, 0, At, B0); PG8_BAR; PG8_SCHED;
            PG8_LDB(B1, 1, 1); PG8_STAGE(PG8_SB(1, 0), b3, voffB);
            PG8_BAR; PG8_WAIT_L(0); PG8_MMA(0, 1, At, B1); PG8_BAR;
            PG8_LDA(At, 1, 1); PG8_STAGE_A(PG8_SA(1, 0), a3, 0, last);
            PG8_BAR; PG8_WAIT_L(0); PG8_MMA(1, 0, At, B0); PG8_BAR; PG8_SCHED;
            PG8_STAGE(PG8_SB(1, 1), b3 + hstep, voffB);
            PG8_WAIT_V(6); PG8_BAR; PG8_MMA(1, 1, At, B1); PG8_BAR;
            }
        }
        if constexpr (ALIGN_EPI) { if (wr == 0) PG8_BAR; }
        if constexpr (!Epi::AFTER_DRAIN) { E(acc, cur, wr, wc, fr, fq); S.done(cur); }
        if (!has_next) break;
#pragma unroll
        for (int a = 0; a < 2; ++a)
#pragma unroll
            for (int b = 0; b < 2; ++b)
#pragma unroll
                for (int m = 0; m < 4; ++m)
#pragma unroll
                    for (int n = 0; n < 2; ++n) acc[a][b][m][n] = acc_t{};
        cur = nxt; cA = nA; cB = nB; ++ui; if (GATHER) PG8_GCOPY(gc, gn);
        if constexpr (ALIGN_EPI) { if (wr == 1) PG8_BAR; }
    }
    PG8_WAIT_V(0);
    if constexpr (!ALIGN_EPI) { if (wr == 0) PG8_BAR; }
    PG8_BAR;
    if constexpr (Epi::AFTER_DRAIN) { E.fused(acc, cur, wr, wc, fr, fq, lds, wid, lane); S.done(cur); }
#undef PG8_SA
#undef PG8_SB
#undef PG8_STAGE
#undef PG8_STAGE_A
#undef PG8_GOFF
#undef PG8_GCOPY
#undef PG8_LDA
#undef PG8_LDB
#undef PG8_MMA
#undef PG8_WAIT_V
#undef PG8_WAIT_L
#undef PG8_BAR
#undef PG8_SCHED
}
}

#ifndef PG8_SP2
#define PG8_SP2 true
#endif
#ifndef PG8_ALIGN
#define PG8_ALIGN true
#endif
#include <hip/hip_bf16.h>
#include <cmath>
namespace pg8 {
__device__ __forceinline__ float bf_lo(unsigned w) { return __uint_as_float(w << 16); }
__device__ __forceinline__ float bf_hi(unsigned w) { return __uint_as_float(w & 0xffff0000u); }
__device__ __forceinline__ u32x4 pack8(const f32x4 v0, const f32x4 v1) { u32x4 w; w.x = cvt_pk_bf16(v0[0], v0[1]); w.y = cvt_pk_bf16(v0[2], v0[3]); w.z = cvt_pk_bf16(v1[0], v1[1]); w.w = cvt_pk_bf16(v1[2], v1[3]); return w; }
__device__ __forceinline__ unsigned q4p(float a, float b, float c, float d, float inv) {
    const float M = 12582912.0f;
    const unsigned b0 = __float_as_uint(fmaf(a, inv, M)), b1 = __float_as_uint(fmaf(b, inv, M)), b2 = __float_as_uint(fmaf(c, inv, M)), b3 = __float_as_uint(fmaf(d, inv, M));
    return __builtin_amdgcn_perm(__builtin_amdgcn_perm(b3, b2, 0x0c0c0400u), __builtin_amdgcn_perm(b1, b0, 0x0c0c0400u), 0x05040100u);
}
__device__ __forceinline__ float lane_max_16_32(float v) {
    { auto r = __builtin_amdgcn_permlane16_swap(__float_as_uint(v), __float_as_uint(v), false, false); v = fmaxf(__uint_as_float(r[0]), __uint_as_float(r[1])); }
    { auto r = __builtin_amdgcn_permlane32_swap(__float_as_uint(v), __float_as_uint(v), false, false); v = fmaxf(__uint_as_float(r[0]), __uint_as_float(r[1])); }
    return v;
}
__device__ __forceinline__ float sigmoidf_fast(float x) { return __builtin_amdgcn_rcpf(1.0f + __builtin_amdgcn_exp2f(-1.4426950408889634f * x)); }

struct InProjOrder {
    int G, c;
    __device__ __forceinline__ bool next(int i, Unit& u) const {
        constexpr int NMAIN = 64 * 33, NWG = NMAIN + 36;
        const int L = i * G + c; if (L >= NWG) return false;
        int wgid = L; { const int q = NWG / NXCD, r = NWG % NXCD, xcd = wgid % NXCD, off = wgid / NXCD; wgid = (xcd < r ? xcd * (q + 1) : r * (q + 1) + (xcd - r) * q) + off; }
        if (wgid < NMAIN) { const int nig = WGM * 33, gid = wgid / nig, fm = gid * WGM; u.pm = fm + ((wgid % nig) % WGM); u.pn = (wgid % nig) / WGM; }
        else { const int idx = wgid - NMAIN, j = idx >> 2; u.pm = 64 + (idx & 3); u.pn = j < 8 ? 4 + j : 16; }
        u.pb = u.pn; u.half = 0; u.ord = i; return true;
    }
    __device__ __forceinline__ void a_ready(const Unit&) const {}
    __device__ __forceinline__ void done(const Unit&) const {}
};
struct MoeOrder {
    int nM, nN, nwg, G, c; const PG8_LAS int* mt_e; const PG8_LAS int* cnt; const PG8_LAS int* pstart;
    int mode = 0;
    __device__ __forceinline__ void init(int nM_, int nN_, int G_, int c_, const PG8_LAS int* t, const PG8_LAS int* cn, const PG8_LAS int* ps) { nM = nM_; nN = nN_; nwg = nM * nN; G = G_; c = c_; mt_e = t; cnt = cn; pstart = ps; }
    __device__ __forceinline__ bool next(int i, Unit& u) const {
        const int full = (nwg / G) * G, tail = nwg - full; const bool sp = tail > 0 && 2 * tail <= G; long L; int hf = 0;
        if (mode == 2) { if (!sp || i != 0 || c >= 2 * tail) return false; L = full + (c >> 1); hf = 1 + (c & 1); }
        else { L = (long)i * G + c; if (L >= ((mode == 1 && sp) ? full : nwg)) return false; }
        int wgid = (int)L; { const int q = nwg / NXCD, r = nwg % NXCD, xcd = wgid % NXCD, off = wgid / NXCD; wgid = (xcd < r ? xcd * (q + 1) : r * (q + 1) + (xcd - r) * q) + off; }
        constexpr int WG_ = 4;     const int nig = WG_ * nN, gid = wgid / nig, fm = gid * WG_, gsz = (nM - fm) < WG_ ? (nM - fm) : WG_;
        u.pm = fm + ((wgid % nig) % gsz); u.pn = (wgid % nig) / gsz;
        const int e = __builtin_amdgcn_readfirstlane(mt_e[u.pm]); u.pb = e * nN + u.pn;
        u.half = hf; u.ord = (mode == 2) ? nwg / G : i; return true;
    }
    __device__ __forceinline__ void a_ready(const Unit&) const {}
    __device__ __forceinline__ void done(const Unit&) const {}
};

struct EpiInProj {
    typedef i32x4 AccT; static constexpr bool PERM = true, AFTER_DRAIN = false;
    const float* SH; const float* SBc; bf16_t *QA, *KA, *VA, *QB, *KB, *VB, *GA, *GB; float c2; PG8_LAS float* epl;
    __device__ __forceinline__ void stage(const Unit& u, int wid, int lane) const { const float* p = wid < 4 ? SH + u.pm * 256 + wid * 64 : SBc + u.pn * 256 + (wid - 4) * 64;
        __builtin_amdgcn_global_load_lds((const unsigned*)(p + (unsigned)lane), (PG8_LAS unsigned*)(epl + wid * 64), 4, 0, 0); }
    __device__ __forceinline__ void operator()(const i32x4 (&acc)[2][2][4][2], const Unit& u, int wr, int wc, int fr, int fq) const {
        const int pm = u.pm, pn = u.pn; const bool ctx = pm >= 64;
        const int b = ctx ? pm - 64 : (pm >> 4);
        const int krow0 = ctx ? b * 4352 + 4096 : b * 4352 + (pm & 15) * 256, qrow0 = pm * 256;
        float sa8[2][4];
#pragma unroll
        for (int ai = 0; ai < 2; ++ai)
#pragma unroll
            for (int m = 0; m < 4; ++m) sa8[ai][m] = epl[ai * HALF + wr * 64 + m * 16 + fr];
        float invf[4];
#pragma unroll
        for (int i = 0; i < 4; ++i) invf[i] = __builtin_amdgcn_exp2f(-(float)(4 * fq + i) * (13.287712379549449f / 16.0f)) * 0.15915494309189535f;
#pragma unroll
        for (int bj = 0; bj < 2; ++bj) {
            const int colt = 128 * bj + 32 * wc + 8 * fq;
            const f32x4 sb0 = *(const PG8_LAS f32x4*)(epl + 256 + colt), sb1 = *(const PG8_LAS f32x4*)(epl + 256 + colt + 4);
            bf16_t* base; int pitch, row0, mode; float scl = 1.f;
            if (pn < 4)        { base = QA + (pn * 256 + colt);        pitch = 1024; row0 = qrow0; mode = 1; scl = c2; }
            else if (pn < 8)   { base = KA + ((pn - 4) * 256 + colt);  pitch = 1024; row0 = krow0; mode = ctx ? 0 : 1; }
            else if (pn < 12)  { base = VA + ((pn - 8) * 256 + colt);  pitch = 1024; row0 = krow0; mode = 0; }
            else if (pn < 16)  { base = QB + ((pn - 12) * 256 + colt); pitch = 1024; row0 = qrow0; mode = 1; scl = c2; }
            else if (pn == 16) { if (bj == 0) { base = KB + (32 * wc + 8 * fq); mode = ctx ? 0 : 1; } else { base = VB + (32 * wc + 8 * fq); mode = 0; } pitch = 128; row0 = krow0; }
            else if (pn < 25)  { base = GA + ((pn - 17) * 256 + colt); pitch = 2048; row0 = qrow0; mode = 2; }
            else               { base = GB + ((pn - 25) * 256 + colt); pitch = 2048; row0 = qrow0; mode = 2; }
#pragma unroll
            for (int ai = 0; ai < 2; ++ai)
#pragma unroll
                for (int m = 0; m < 4; ++m) {
                    const int row = ai * HALF + wr * 64 + m * 16 + fr;
                    const float sa = sa8[ai][m];
                    f32x4 v0 = __builtin_convertvector(acc[ai][bj][m][0], f32x4) * (sb0 * sa), v1 = __builtin_convertvector(acc[ai][bj][m][1], f32x4) * (sb1 * sa);
                    if (mode == 1) {
                        const float pos = (wc & 1) ? (float)(16 * m + fr) : (float)((pm & 15) * 4 + 2 * ai + wr);
#pragma unroll
                        for (int i = 0; i < 4; ++i) { float rev = pos * invf[i]; rev -= floorf(rev); const float cs = __builtin_amdgcn_cosf(rev), sn = __builtin_amdgcn_sinf(rev);
                            const float x1 = v0[i], x2 = v1[i]; v0[i] = x1 * cs - x2 * sn; v1[i] = x2 * cs + x1 * sn; }
                    } else if (mode == 2) {
#pragma unroll
                        for (int i = 0; i < 4; ++i) { v0[i] = sigmoidf_fast(v0[i]); v1[i] = sigmoidf_fast(v1[i]); }
                    }
                    v0 = v0 * scl; v1 = v1 * scl;
                    *(u32x4*)(base + (size_t)(row0 + row) * pitch) = pack8(v0, v1);
                }
        }
    }
};
struct EpiGate1 {
    typedef f32x4 AccT; static constexpr bool PERM = true, AFTER_DRAIN = false;
    __device__ __forceinline__ void stage(const Unit&, int, int) const {}
    const bf16_t* G; float* Y1;
    __device__ __forceinline__ void operator()(const f32x4 (&acc)[2][2][4][2], const Unit& u, int wr, int wc, int fr, int fq) const {
        u32x4 g[2][4][2];
#pragma unroll
        for (int ai = 0; ai < 2; ++ai)
#pragma unroll
            for (int m = 0; m < 4; ++m)
#pragma unroll
                for (int bj = 0; bj < 2; ++bj) g[ai][m][bj] = *(const u32x4*)(G + (size_t)(u.pm * BM + ai * HALF + wr * 64 + m * 16 + fr) * 2048 + (u.pn * BM + bj * HALF + wc * 32 + 8 * fq));
#pragma unroll
        for (int ai = 0; ai < 2; ++ai)
#pragma unroll
            for (int m = 0; m < 4; ++m)
#pragma unroll
                for (int bj = 0; bj < 2; ++bj) {
                    const size_t off = (size_t)(u.pm * BM + ai * HALF + wr * 64 + m * 16 + fr) * 2048 + (u.pn * BM + bj * HALF + wc * 32 + 8 * fq);
                    const u32x4 gg = g[ai][m][bj];
                    const f32x4 a0 = acc[ai][bj][m][0], a1 = acc[ai][bj][m][1];
                    f32x4 o0, o1; o0[0] = a0[0] * bf_lo(gg.x); o0[1] = a0[1] * bf_hi(gg.x); o0[2] = a0[2] * bf_lo(gg.y); o0[3] = a0[3] * bf_hi(gg.y);
                    o1[0] = a1[0] * bf_lo(gg.z); o1[1] = a1[1] * bf_hi(gg.z); o1[2] = a1[2] * bf_lo(gg.w); o1[3] = a1[3] * bf_hi(gg.w);
                    *(f32x4*)(Y1 + off) = o0; *(f32x4*)(Y1 + off + 4) = o1;
                }
    }
};
struct EpiGate2 {
    typedef f32x4 AccT; static constexpr bool PERM = true, AFTER_DRAIN = false;
    __device__ __forceinline__ void stage(const Unit&, int, int) const {}
    const bf16_t* G; const float* Y1; bf16_t* Y;
    __device__ __forceinline__ void operator()(const f32x4 (&acc)[2][2][4][2], const Unit& u, int wr, int wc, int fr, int fq) const {
#pragma unroll
        for (int ai = 0; ai < 2; ++ai)
#pragma unroll
            for (int mh = 0; mh < 2; ++mh) {
                u32x4 g[2][2]; f32x4 ya[2][2], yb[2][2];
#pragma unroll
                for (int mm = 0; mm < 2; ++mm)
#pragma unroll
                    for (int bj = 0; bj < 2; ++bj) { const size_t off = (size_t)(u.pm * BM + ai * HALF + wr * 64 + (2 * mh + mm) * 16 + fr) * 2048 + (u.pn * BM + bj * HALF + wc * 32 + 8 * fq);
                        g[mm][bj] = *(const u32x4*)(G + off); ya[mm][bj] = *(const f32x4*)(Y1 + off); yb[mm][bj] = *(const f32x4*)(Y1 + off + 4); }
#pragma unroll
                for (int mm = 0; mm < 2; ++mm)
#pragma unroll
                    for (int bj = 0; bj < 2; ++bj) { const int m = 2 * mh + mm; const size_t off = (size_t)(u.pm * BM + ai * HALF + wr * 64 + m * 16 + fr) * 2048 + (u.pn * BM + bj * HALF + wc * 32 + 8 * fq);
                        const u32x4 gg = g[mm][bj]; const f32x4 y0 = ya[mm][bj], y1 = yb[mm][bj], a0 = acc[ai][bj][m][0], a1 = acc[ai][bj][m][1];
                        f32x4 o0, o1; o0[0] = y0[0] + a0[0] * bf_lo(gg.x); o0[1] = y0[1] + a0[1] * bf_hi(gg.x); o0[2] = y0[2] + a0[2] * bf_lo(gg.y); o0[3] = y0[3] + a0[3] * bf_hi(gg.y);
                        o1[0] = y1[0] + a1[0] * bf_lo(gg.z); o1[1] = y1[1] + a1[1] * bf_hi(gg.z); o1[2] = y1[2] + a1[2] * bf_lo(gg.w); o1[3] = y1[3] + a1[3] * bf_hi(gg.w);
                        *(u32x4*)(Y + off) = pack8(o0, o1); }
            }
    }
};
struct EpiGate1Q {
    typedef i32x4 AccT; static constexpr bool PERM = true, AFTER_DRAIN = false;
    const bf16_t* G; float* Y1;
    const float* SR; const float* SC; PG8_LAS float* epl;
    __device__ __forceinline__ void stage(const Unit& u, int wid, int lane) const { const float* p = wid < 4 ? SR + u.pm * 256 + wid * 64 : SC + u.pn * 256 + (wid - 4) * 64;
        __builtin_amdgcn_global_load_lds((const unsigned*)(p + (unsigned)lane), (PG8_LAS unsigned*)(epl + wid * 64), 4, 0, 0); }
    __device__ __forceinline__ void operator()(const i32x4 (&acc)[2][2][4][2], const Unit& u, int wr, int wc, int fr, int fq) const {
#pragma unroll
        for (int ai = 0; ai < 2; ++ai) {
            u32x4 g[4][2];
#pragma unroll
            for (int m = 0; m < 4; ++m)
#pragma unroll
                for (int bj = 0; bj < 2; ++bj) g[m][bj] = *(const u32x4*)(G + (size_t)(u.pm * BM + ai * HALF + wr * 64 + m * 16 + fr) * 2048 + (u.pn * BM + bj * HALF + wc * 32 + 8 * fq));
#pragma unroll
            for (int m = 0; m < 4; ++m) {
                const float sa = epl[ai * HALF + wr * 64 + m * 16 + fr];
#pragma unroll
                for (int bj = 0; bj < 2; ++bj) {
                    const size_t off = (size_t)(u.pm * BM + ai * HALF + wr * 64 + m * 16 + fr) * 2048 + (u.pn * BM + bj * HALF + wc * 32 + 8 * fq);
                    const u32x4 gg = g[m][bj]; const PG8_LAS float* ec = epl + 256 + bj * HALF + wc * 32 + 8 * fq;
                    const f32x4 a0 = __builtin_convertvector(acc[ai][bj][m][0], f32x4) * (*(const PG8_LAS f32x4*)ec * sa), a1 = __builtin_convertvector(acc[ai][bj][m][1], f32x4) * (*(const PG8_LAS f32x4*)(ec + 4) * sa);
                    f32x4 o0, o1; o0[0] = a0[0] * bf_lo(gg.x); o0[1] = a0[1] * bf_hi(gg.x); o0[2] = a0[2] * bf_lo(gg.y); o0[3] = a0[3] * bf_hi(gg.y);
                    o1[0] = a1[0] * bf_lo(gg.z); o1[1] = a1[1] * bf_hi(gg.z); o1[2] = a1[2] * bf_lo(gg.w); o1[3] = a1[3] * bf_hi(gg.w);
                    *(f32x4*)(Y1 + off) = o0; *(f32x4*)(Y1 + off + 4) = o1;
                }
            }
        }
    }
};
struct EpiGate2Q {
    typedef i32x4 AccT; static constexpr bool PERM = true, AFTER_DRAIN = false;
    const bf16_t* G; const float* Y1; unsigned char* YQ; float* RMAXY;
    const float* SR; const float* SC; PG8_LAS float* epl;
    __device__ __forceinline__ void stage(const Unit& u, int wid, int lane) const { const float* p = wid < 4 ? SR + u.pm * 256 + wid * 64 : SC + u.pn * 256 + (wid - 4) * 64;
        __builtin_amdgcn_global_load_lds((const unsigned*)(p + (unsigned)lane), (PG8_LAS unsigned*)(epl + wid * 64), 4, 0, 0); }
    __device__ __forceinline__ void operator()(const i32x4 (&acc)[2][2][4][2], const Unit& u, int wr, int wc, int fr, int fq) const {
#pragma unroll
        for (int ai = 0; ai < 2; ++ai)
#pragma unroll
            for (int mh = 0; mh < 2; ++mh) {
                u32x4 g[2][2]; f32x4 ya[2][2], yb[2][2];
#pragma unroll
                for (int mm = 0; mm < 2; ++mm)
#pragma unroll
                    for (int bj = 0; bj < 2; ++bj) { const size_t off = (size_t)(u.pm * BM + ai * HALF + wr * 64 + (2 * mh + mm) * 16 + fr) * 2048 + (u.pn * BM + bj * HALF + wc * 32 + 8 * fq);
                        g[mm][bj] = *(const u32x4*)(G + off); ya[mm][bj] = *(const f32x4*)(Y1 + off); yb[mm][bj] = *(const f32x4*)(Y1 + off + 4); }
#pragma unroll
                for (int mm = 0; mm < 2; ++mm)
#pragma unroll
                    for (int bj = 0; bj < 2; ++bj) { const int m = 2 * mh + mm; const size_t off = (size_t)(u.pm * BM + ai * HALF + wr * 64 + m * 16 + fr) * 2048 + (u.pn * BM + bj * HALF + wc * 32 + 8 * fq);
                        const u32x4 gg = g[mm][bj]; const float sa = epl[ai * HALF + wr * 64 + m * 16 + fr]; const PG8_LAS float* ec = epl + 256 + bj * HALF + wc * 32 + 8 * fq;
                        const f32x4 y0 = ya[mm][bj], y1 = yb[mm][bj], a0 = __builtin_convertvector(acc[ai][bj][m][0], f32x4) * (*(const PG8_LAS f32x4*)ec * sa), a1 = __builtin_convertvector(acc[ai][bj][m][1], f32x4) * (*(const PG8_LAS f32x4*)(ec + 4) * sa);
                        f32x4 o0, o1; o0[0] = y0[0] + a0[0] * bf_lo(gg.x); o0[1] = y0[1] + a0[1] * bf_hi(gg.x); o0[2] = y0[2] + a0[2] * bf_lo(gg.y); o0[3] = y0[3] + a0[3] * bf_hi(gg.y);
                        o1[0] = y1[0] + a1[0] * bf_lo(gg.z); o1[1] = y1[1] + a1[1] * bf_hi(gg.z); o1[2] = y1[2] + a1[2] * bf_lo(gg.w); o1[3] = y1[3] + a1[3] * bf_hi(gg.w);
                        float mx = fmaxf(fmaxf(fmaxf(fabsf(o0[0]), fabsf(o0[1])), fmaxf(fabsf(o0[2]), fabsf(o0[3]))), fmaxf(fmaxf(fabsf(o1[0]), fabsf(o1[1])), fmaxf(fabsf(o1[2]), fabsf(o1[3]))));
                        mx = lane_max_16_32(mx);
                        const float qi = mx > 0.f ? 127.0f * __builtin_amdgcn_rcpf(mx) : 0.f;
                        typedef unsigned u2_t __attribute__((ext_vector_type(2))); u2_t w; w.x = q4p(o0[0], o0[1], o0[2], o0[3], qi); w.y = q4p(o1[0], o1[1], o1[2], o1[3], qi);
                        *(u2_t*)(YQ + off) = w;
                        if (fq == 0) RMAXY[(size_t)(u.pm * BM + ai * HALF + wr * 64 + m * 16 + fr) * 64 + u.pn * 8 + bj * 4 + wc] = mx; }
            }
    }
};
struct EpiOut {
    typedef f32x4 AccT; static constexpr bool PERM = true, AFTER_DRAIN = false;
    __device__ __forceinline__ void stage(const Unit&, int, int) const {}
    const float* X; const float* mod; float* R; float alpha;
    __device__ __forceinline__ void operator()(const f32x4 (&acc)[2][2][4][2], const Unit& u, int wr, int wc, int fr, int fq) const {
        const float* g1 = mod + (size_t)(u.pm >> 4) * 12288 + 4096;
#pragma unroll
        for (int bj = 0; bj < 2; ++bj) {
            const int col = u.pn * BM + bj * HALF + wc * 32 + 8 * fq;
            const f32x4 ga = *(const f32x4*)(g1 + col), gb = *(const f32x4*)(g1 + col + 4);
#pragma unroll
            for (int ai = 0; ai < 2; ++ai) {
                f32x4 xa[4], xb[4];
#pragma unroll
                for (int m = 0; m < 4; ++m) { const size_t off = (size_t)(u.pm * BM + ai * HALF + wr * 64 + m * 16 + fr) * 2048 + col; xa[m] = *(const f32x4*)(X + off); xb[m] = *(const f32x4*)(X + off + 4); }
#pragma unroll
                for (int m = 0; m < 4; ++m) {
                    const size_t off = (size_t)(u.pm * BM + ai * HALF + wr * 64 + m * 16 + fr) * 2048 + col;
                    *(f32x4*)(R + off) = xa[m] * alpha + ga * acc[ai][bj][m][0]; *(f32x4*)(R + off + 4) = xb[m] * alpha + gb * acc[ai][bj][m][1];
                }
            }
        }
    }
};
struct EpiOutQ {
    typedef i32x4 AccT; static constexpr bool PERM = true, AFTER_DRAIN = false;
    const float* X; const float* mod; float* R; float alpha;
    const float* SR; const float* SC; PG8_LAS float* epl;
    __device__ __forceinline__ void stage(const Unit& u, int wid, int lane) const { const float* p = wid < 4 ? SR + u.pm * 256 + wid * 64 : SC + u.pn * 256 + (wid - 4) * 64;
        __builtin_amdgcn_global_load_lds((const unsigned*)(p + (unsigned)lane), (PG8_LAS unsigned*)(epl + wid * 64), 4, 0, 0); }
    __device__ __forceinline__ void operator()(const i32x4 (&acc)[2][2][4][2], const Unit& u, int wr, int wc, int fr, int fq) const {
        const float* g1 = mod + (size_t)(u.pm >> 4) * 12288 + 4096;
#pragma unroll
        for (int bj = 0; bj < 2; ++bj) {
            const int col = u.pn * BM + bj * HALF + wc * 32 + 8 * fq;
            const PG8_LAS float* ec = epl + 256 + bj * HALF + wc * 32 + 8 * fq;
            const f32x4 ga = *(const f32x4*)(g1 + col) * *(const PG8_LAS f32x4*)ec, gb = *(const f32x4*)(g1 + col + 4) * *(const PG8_LAS f32x4*)(ec + 4);
#pragma unroll
            for (int ai = 0; ai < 2; ++ai) {
                f32x4 xa[4], xb[4];
#pragma unroll
                for (int m = 0; m < 4; ++m) { const size_t off = (size_t)(u.pm * BM + ai * HALF + wr * 64 + m * 16 + fr) * 2048 + col; xa[m] = *(const f32x4*)(X + off); xb[m] = *(const f32x4*)(X + off + 4); }
#pragma unroll
                for (int m = 0; m < 4; ++m) {
                    const size_t off = (size_t)(u.pm * BM + ai * HALF + wr * 64 + m * 16 + fr) * 2048 + col;
                    const float sa = epl[ai * HALF + wr * 64 + m * 16 + fr];
                    *(f32x4*)(R + off) = xa[m] * alpha + (ga * sa) * __builtin_convertvector(acc[ai][bj][m][0], f32x4); *(f32x4*)(R + off + 4) = xb[m] * alpha + (gb * sa) * __builtin_convertvector(acc[ai][bj][m][1], f32x4);
                }
            }
        }
    }
};
struct EpiUp {
    typedef f32x4 AccT; static constexpr bool PERM = true, AFTER_DRAIN = false;
    __device__ __forceinline__ void stage(const Unit&, int, int) const {}
    const float* bup; bf16_t* ACT;
    __device__ __forceinline__ void operator()(const f32x4 (&acc)[2][2][4][2], const Unit& u, int wr, int wc, int fr, int fq) const {
        const int e = u.pb >> 4, col = u.pn * 128 + wc * 32 + 8 * fq;
        const float* bg = bup + (size_t)e * 4096 + col; const float* bl = bg + 2048;
        const f32x4 bg0 = *(const f32x4*)bg, bg1 = *(const f32x4*)(bg + 4), bl0 = *(const f32x4*)bl, bl1 = *(const f32x4*)(bl + 4);
#pragma unroll
        for (int ai = 0; ai < 2; ++ai)
#pragma unroll
            for (int m = 0; m < 4; ++m) {
                const size_t off = (size_t)(u.pm * BM + ai * HALF + wr * 64 + m * 16 + fr) * 2048 + col;
                f32x4 g0 = acc[ai][0][m][0] + bg0, g1 = acc[ai][0][m][1] + bg1, l0 = acc[ai][1][m][0] + bl0, l1 = acc[ai][1][m][1] + bl1, o0, o1;
#pragma unroll
                for (int i = 0; i < 4; ++i) {
                    const float xg0 = fminf(g0[i], 7.0f), xl0 = fminf(fmaxf(l0[i], -7.0f), 7.0f); o0[i] = xg0 * sigmoidf_fast(1.702f * xg0) * (xl0 + 1.0f);
                    const float xg1 = fminf(g1[i], 7.0f), xl1 = fminf(fmaxf(l1[i], -7.0f), 7.0f); o1[i] = xg1 * sigmoidf_fast(1.702f * xg1) * (xl1 + 1.0f);
                }
                *(u32x4*)(ACT + off) = pack8(o0, o1);
            }
    }
};
struct EpiUpQ {
    typedef i32x4 AccT; static constexpr bool PERM = true, AFTER_DRAIN = false;
    const float* bup; unsigned char* ACTP; const float* SA; const float* SB; const int* pos_slot; const PG8_LAS int* cnt; const PG8_LAS int* pstart; float* RMAXP; const PG8_LAS float* sclL; PG8_LAS float* epl;
    __device__ __forceinline__ void stage(const Unit& u, int wid, int lane) const { const int e = u.pb >> 4;
        const float* p = wid < 2 ? bup + (size_t)e * 4096 + u.pn * 128 + wid * 64 : wid < 4 ? bup + (size_t)e * 4096 + 2048 + u.pn * 128 + (wid - 2) * 64 : SB + (size_t)e * 4096 + u.pn * 256 + (wid - 4) * 64;
        __builtin_amdgcn_global_load_lds((const unsigned*)(p + (unsigned)lane), (PG8_LAS unsigned*)(epl + wid * 64), 4, 0, 0); }
    __device__ __forceinline__ void operator()(const i32x4 (&acc)[2][2][4][2], const Unit& u, int wr, int wc, int fr, int fq) const {
        const int e = u.pb >> 4, col = u.pn * 128 + wc * 32 + 8 * fq, lim = pstart[e] + cnt[e], vb = e * 16384 - pstart[e]; (void)e;
        const PG8_LAS float* ec = epl + wc * 32 + 8 * fq;
        const f32x4 bg0 = *(const PG8_LAS f32x4*)ec, bg1 = *(const PG8_LAS f32x4*)(ec + 4), bl0 = *(const PG8_LAS f32x4*)(ec + 128), bl1 = *(const PG8_LAS f32x4*)(ec + 132);
        const f32x4 sg0 = *(const PG8_LAS f32x4*)(ec + 256), sg1 = *(const PG8_LAS f32x4*)(ec + 260), sl0 = *(const PG8_LAS f32x4*)(ec + 384), sl1 = *(const PG8_LAS f32x4*)(ec + 388);
#pragma unroll
        for (int ai = 0; ai < 2; ++ai) if (!(u.half && ai != u.half - 1))
#pragma unroll
            for (int m = 0; m < 4; ++m) {
                const int pos = u.pm * BM + ai * HALF + wr * 64 + m * 16 + fr; const size_t off = (size_t)pos * 2048 + col;
                const float sa = sclL[u.ord * 256 + ai * HALF + wr * 64 + m * 16 + fr]; (void)lim; (void)vb;
                const f32x4 g0 = __builtin_convertvector(acc[ai][0][m][0], f32x4) * (sg0 * sa) + bg0, g1 = __builtin_convertvector(acc[ai][0][m][1], f32x4) * (sg1 * sa) + bg1;
                const f32x4 l0 = __builtin_convertvector(acc[ai][1][m][0], f32x4) * (sl0 * sa) + bl0, l1 = __builtin_convertvector(acc[ai][1][m][1], f32x4) * (sl1 * sa) + bl1;
                f32x4 xg0, xg1, xl0, xl1;
#pragma unroll
                for (int i = 0; i < 4; ++i) { xg0[i] = fminf(g0[i], 7.0f); xg1[i] = fminf(g1[i], 7.0f); xl0[i] = __builtin_amdgcn_fmed3f(l0[i], -7.0f, 7.0f); xl1[i] = __builtin_amdgcn_fmed3f(l1[i], -7.0f, 7.0f); }
                const f32x4 t0 = xg0 * -2.4554669595930157f, t1 = xg1 * -2.4554669595930157f;
                f32x4 e0, e1;
#pragma unroll
                for (int i = 0; i < 4; ++i) { e0[i] = __builtin_amdgcn_exp2f(t0[i]); e1[i] = __builtin_amdgcn_exp2f(t1[i]); }
                const f32x4 d0 = e0 + 1.0f, d1 = e1 + 1.0f;
                f32x4 r0, r1;
#pragma unroll
                for (int i = 0; i < 4; ++i) { r0[i] = __builtin_amdgcn_rcpf(d0[i]); r1[i] = __builtin_amdgcn_rcpf(d1[i]); }
                const f32x4 o0 = (xg0 * r0) * (xl0 + 1.0f), o1 = (xg1 * r1) * (xl1 + 1.0f);
                float mx = fmaxf(fmaxf(fmaxf(fabsf(o0[0]), fabsf(o0[1])), fmaxf(fabsf(o0[2]), fabsf(o0[3]))), fmaxf(fmaxf(fabsf(o1[0]), fabsf(o1[1])), fmaxf(fabsf(o1[2]), fabsf(o1[3]))));
                mx = lane_max_16_32(mx);
                const float qi = mx > 0.f ? 127.0f * __builtin_amdgcn_rcpf(mx) : 0.f;
                const f32x4 q0 = o0 * qi + 12582912.0f, q1 = o1 * qi + 12582912.0f;
                typedef unsigned u2_t __attribute__((ext_vector_type(2))); u2_t w;
                w.x = __builtin_amdgcn_perm(__builtin_amdgcn_perm(__float_as_uint(q0[3]), __float_as_uint(q0[2]), 0x0c0c0400u), __builtin_amdgcn_perm(__float_as_uint(q0[1]), __float_as_uint(q0[0]), 0x0c0c0400u), 0x05040100u);
                w.y = __builtin_amdgcn_perm(__builtin_amdgcn_perm(__float_as_uint(q1[3]), __float_as_uint(q1[2]), 0x0c0c0400u), __builtin_amdgcn_perm(__float_as_uint(q1[1]), __float_as_uint(q1[0]), 0x0c0c0400u), 0x05040100u);
                *(u2_t*)(ACTP + off) = w;
                if (fq == 0) RMAXP[((size_t)pos * 16 + u.pn) * 4 + wc] = mx;
            }
    }
};
struct EpiDown {
    typedef f32x4 AccT; static constexpr bool PERM = true, AFTER_DRAIN = false;
    __device__ __forceinline__ void stage(const Unit&, int, int) const {}
    const float* bdn; bf16_t* YS; const int* pos_slot; const float* pos_gate; const PG8_LAS int* cnt; const PG8_LAS int* pstart;
    __device__ __forceinline__ void operator()(const f32x4 (&acc)[2][2][4][2], const Unit& u, int wr, int wc, int fr, int fq) const {
        const int e = u.pb >> 3; const int lim = pstart[e] + cnt[e], vb = e * 16384 - pstart[e];
        f32x4 bv[2][2];
#pragma unroll
        for (int bj = 0; bj < 2; ++bj) { const float* bp = bdn + (size_t)e * 2048 + u.pn * BM + bj * HALF + wc * 32 + 8 * fq; bv[bj][0] = *(const f32x4*)bp; bv[bj][1] = *(const f32x4*)(bp + 4); }
#pragma unroll
        for (int ai = 0; ai < 2; ++ai)
#pragma unroll
            for (int m = 0; m < 4; ++m) {
                const int pos = u.pm * BM + ai * HALF + wr * 64 + m * 16 + fr;
                if (pos < lim) {
                    const int slot = pos_slot[vb + pos]; const float gt = pos_gate[vb + pos];
#pragma unroll
                    for (int bj = 0; bj < 2; ++bj) {
                        const f32x4 o0 = (acc[ai][bj][m][0] + bv[bj][0]) * gt, o1 = (acc[ai][bj][m][1] + bv[bj][1]) * gt;
                        *(u32x4*)(YS + (size_t)slot * 2048 + u.pn * BM + bj * HALF + wc * 32 + 8 * fq) = pack8(o0, o1);
                    }
                }
            }
    }
};
struct EpiDownQ {
    typedef i32x4 AccT; static constexpr bool PERM = true, AFTER_DRAIN = false;
    const float* bdn; bf16_t* YS; const int* pos_slot; const float* pos_gate; const PG8_LAS int* cnt; const PG8_LAS int* pstart; const float* SACT; const float* SBD; PG8_LAS float* epl; int probe_skip = 0;
    __device__ __forceinline__ void stage(const Unit& u, int wid, int lane) const { const int e = u.pb >> 3;
        if (wid < 4) { const int lim = pstart[e] + cnt[e], r0 = u.pm * BM + wid * 64; const int row = min(r0 + lane, lim - 1); const size_t vb = (size_t)(e * 16384 - pstart[e]);
            __builtin_amdgcn_global_load_lds((const unsigned*)(pos_gate + vb) + (unsigned)row, (PG8_LAS unsigned*)(epl + wid * 64), 4, 0, 0);
            __builtin_amdgcn_global_load_lds((const unsigned*)SACT + (unsigned)row, (PG8_LAS unsigned*)(epl + 256 + wid * 64), 4, 0, 0); }
        else { const size_t ci = (size_t)e * 2048 + u.pn * BM + (wid - 4) * 64;
            __builtin_amdgcn_global_load_lds((const unsigned*)(bdn + ci) + (unsigned)lane, (PG8_LAS unsigned*)(epl + 512 + (wid - 4) * 64), 4, 0, 0);
            __builtin_amdgcn_global_load_lds((const unsigned*)(SBD + ci) + (unsigned)lane, (PG8_LAS unsigned*)(epl + 768 + (wid - 4) * 64), 4, 0, 0); } }
    __device__ __forceinline__ void operator()(const i32x4 (&acc)[2][2][4][2], const Unit& u, int wr, int wc, int fr, int fq) const {
        if (probe_skip) return;
        f32x4 bv[2][2], sv[2][2];
#pragma unroll
        for (int bj = 0; bj < 2; ++bj) { const PG8_LAS float* ec = epl + 512 + bj * HALF + wc * 32 + 8 * fq; bv[bj][0] = *(const PG8_LAS f32x4*)ec; bv[bj][1] = *(const PG8_LAS f32x4*)(ec + 4);
            sv[bj][0] = *(const PG8_LAS f32x4*)(ec + 256); sv[bj][1] = *(const PG8_LAS f32x4*)(ec + 260); }
#pragma unroll
        for (int ai = 0; ai < 2; ++ai) if (!(u.half && ai != u.half - 1))
#pragma unroll
            for (int m = 0; m < 4; ++m) {
                const int r = ai * HALF + wr * 64 + m * 16 + fr; const float gt = epl[r], sa = epl[256 + r];
                bf16_t* yr = YS + (size_t)(u.pm * BM + r) * 2048 + u.pn * BM + wc * 32 + 8 * fq;
#pragma unroll
                for (int bj = 0; bj < 2; ++bj) {
                    const f32x4 o0 = (__builtin_convertvector(acc[ai][bj][m][0], f32x4) * (sv[bj][0] * sa) + bv[bj][0]) * gt, o1 = (__builtin_convertvector(acc[ai][bj][m][1], f32x4) * (sv[bj][1] * sa) + bv[bj][1]) * gt;
                    *(u32x4*)(yr + bj * HALF) = pack8(o0, o1);
                }
            }
    }
};
}
namespace attn_body {
using bf16=__hip_bfloat16;
using bf16x8=__attribute__((ext_vector_type(8)))short;
using s16x4=__attribute__((ext_vector_type(4)))short;
using f32x16=__attribute__((ext_vector_type(16)))float;
using u32x4=__attribute__((ext_vector_type(4)))unsigned;
constexpr int D=64;
constexpr int NW=8,QBLK=32,QB=QBLK*NW,KVBLK=64;
constexpr int ATTN_UNIT_ROWS=QB;
__device__ __forceinline__ int crow(int r,int hi){return (r&3)+8*(r>>2)+4*hi;}
#define SBAR() __builtin_amdgcn_sched_barrier(0)
__device__ __forceinline__ void wmask(f32x16&p0,f32x16&p1,int kpos0,int qpos,int hi){
  const float NEG=-INFINITY; const int kb=kpos0+4*hi-qpos;
  #pragma unroll
  for(int r=0;r<16;++r){const int d=kb+(r&3)+8*(r>>2); if(d>128||d<-128)p0[r]=NEG; if(d+32>128||d+32<-128)p1[r]=NEG;}
}
constexpr int NSLOT=3, SLOTB=8192;
constexpr int LDS_K=0, LDS_V=NSLOT*SLOTB, LDS_WS=2*NSLOT*SLOTB, LDS_OST=LDS_WS+NW*64*4, LDS_BYTES=LDS_OST+NW*4096;
constexpr float C2=0.125f*1.4426950408889634f;
__device__ __forceinline__ void glds16(const void*gsrc,unsigned lds_dst){unsigned keep;
  asm volatile("s_mov_b32 %0, m0\n\ts_mov_b32 m0, %2\n\ts_nop 0\n\tglobal_load_lds_dwordx4 %1, off\n\ts_mov_b32 m0, %0":"=&s"(keep):"v"(gsrc),"s"(lds_dst):"memory");}
__device__ __forceinline__ float max3f(float a,float b,float c){float r;asm("v_max3_f32 %0, %1, %2, %3":"=v"(r):"v"(a),"v"(b),"v"(c));return r;}
__device__ __forceinline__ float max2f(float a,float b){float r;asm("v_max_f32_e32 %0, %1, %2":"=v"(r):"v"(a),"v"(b));return r;}
__device__ __forceinline__ float fadd_s(float a,float b){float r;asm("v_add_f32_e32 %0, %1, %2":"=v"(r):"v"(a),"v"(b));return r;}
__device__ __forceinline__ float fsub_s(float a,float b){float r;asm("v_sub_f32_e32 %0, %1, %2":"=v"(r):"v"(a),"v"(b));return r;}
typedef float f32x2_t __attribute__((ext_vector_type(2))); typedef __bf16 bf16x2_t __attribute__((ext_vector_type(2)));
__device__ __forceinline__ unsigned cvtpk_s(float lo,float hi){f32x2_t v={lo,hi};bf16x2_t b=__builtin_convertvector(v,bf16x2_t);return __builtin_bit_cast(unsigned,b);}
#define WAIT_BAR(N) asm volatile("s_waitcnt vmcnt(" #N ") lgkmcnt(0)\n\ts_barrier":::"memory")

__device__ __forceinline__ void qkt(f32x16&p0,f32x16&p1,const char*Kslot,const bf16x8*qr,const f32x16&negm,int r32,int hi){
  const char*kb=Kslot+hi*1024+r32*16;
  #pragma unroll
  for(int d0=0;d0<4;++d0){
    const bf16x8 b0=*reinterpret_cast<const bf16x8*>(kb+d0*2048);
    const bf16x8 b1=*reinterpret_cast<const bf16x8*>(kb+d0*2048+512);
    if(d0==0){p0=__builtin_amdgcn_mfma_f32_32x32x16_bf16(b0,qr[0],negm,0,0,0);p1=__builtin_amdgcn_mfma_f32_32x32x16_bf16(b1,qr[0],negm,0,0,0);}
    else{p0=__builtin_amdgcn_mfma_f32_32x32x16_bf16(b0,qr[d0],p0,0,0,0);p1=__builtin_amdgcn_mfma_f32_32x32x16_bf16(b1,qr[d0],p1,0,0,0);}}
}
typedef __attribute__((address_space(3))) const char* lds_cptr;
typedef short v4i16_t __attribute__((ext_vector_type(4)));
__device__ __forceinline__ void kload8(bf16x8*kf,lds_cptr kp){
  kf[0]=*(const __attribute__((address_space(3))) bf16x8*)(kp);      kf[1]=*(const __attribute__((address_space(3))) bf16x8*)(kp+512);
  kf[2]=*(const __attribute__((address_space(3))) bf16x8*)(kp+2048); kf[3]=*(const __attribute__((address_space(3))) bf16x8*)(kp+2560);
  kf[4]=*(const __attribute__((address_space(3))) bf16x8*)(kp+4096); kf[5]=*(const __attribute__((address_space(3))) bf16x8*)(kp+4608);
  kf[6]=*(const __attribute__((address_space(3))) bf16x8*)(kp+6144); kf[7]=*(const __attribute__((address_space(3))) bf16x8*)(kp+6656);
}
__device__ __forceinline__ void kload2(bf16x8*kf,lds_cptr kp,int j){ kf[2*j]=*(const __attribute__((address_space(3))) bf16x8*)(kp+j*2048); kf[2*j+1]=*(const __attribute__((address_space(3))) bf16x8*)(kp+j*2048+512); }
__device__ __forceinline__ s16x4 vtr(lds_cptr p){ return __builtin_bit_cast(s16x4,__builtin_amdgcn_ds_read_tr16_b64_v4i16((__attribute__((address_space(3))) v4i16_t*)p)); }
__device__ __forceinline__ float rowmax(const f32x16&p0,const f32x16&p1){
  float a=max3f(p0[0],p0[1],p1[0]),b=max3f(p0[2],p0[3],p1[1]);a=max3f(a,p1[2],p1[3]);
  #pragma unroll
  for(int r=4;r<16;r+=4){a=max3f(a,p0[r],p0[r+1]);b=max3f(b,p0[r+2],p0[r+3]);a=max3f(a,p1[r],p1[r+1]);b=max3f(b,p1[r+2],p1[r+3]);}
  const float m=max2f(a,b);
  auto rr=__builtin_amdgcn_permlane32_swap(__float_as_uint(m),__float_as_uint(m),false,false);
  return max2f(__uint_as_float(rr[0]),__uint_as_float(rr[1]));
}
__device__ __forceinline__ void pv(f32x16*o,int vb,bf16x8 pa0,bf16x8 pa1,bf16x8 pa2,bf16x8 pa3){
  #pragma unroll
  for(int d0=0;d0<2;++d0){s16x4 lo[4],hi[4];
    #pragma unroll
    for(int ks=0;ks<4;++ks){
      asm volatile("ds_read_b64_tr_b16 %0,%1 offset:%c2":"=&v"(lo[ks]):"v"(vb),"i"(d0*4096+ks*1024):"memory");
      asm volatile("ds_read_b64_tr_b16 %0,%1 offset:%c2":"=&v"(hi[ks]):"v"(vb),"i"(d0*4096+ks*1024+512):"memory");}
    asm volatile("s_waitcnt lgkmcnt(0)":::"memory");SBAR();
    #define PK(k) (bf16x8){lo[k][0],lo[k][1],lo[k][2],lo[k][3],hi[k][0],hi[k][1],hi[k][2],hi[k][3]}
    o[d0]=__builtin_amdgcn_mfma_f32_32x32x16_bf16(pa0,PK(0),o[d0],0,0,0);
    o[d0]=__builtin_amdgcn_mfma_f32_32x32x16_bf16(pa1,PK(1),o[d0],0,0,0);
    o[d0]=__builtin_amdgcn_mfma_f32_32x32x16_bf16(pa2,PK(2),o[d0],0,0,0);
    o[d0]=__builtin_amdgcn_mfma_f32_32x32x16_bf16(pa3,PK(3),o[d0],0,0,0);
    #undef PK
  }
}

#ifndef ATTN_STORE16
#define ATTN_STORE16(p,v) (*(u32x4*)(p)=(v))
#endif
struct AttnArgs { const bf16* Qw0; const bf16* Kh; const bf16* Vh; bf16* Ow0; int NT; int win0; int qpos0; float sinkl2; };
template<class C,int THRL> __device__ __forceinline__ void attn_unit(const AttnArgs& aa,char*shm){
  int tid_=threadIdx.x; asm volatile("":"+v"(tid_)); const int tid=tid_,lane=tid&63,r32=lane&31,hi=lane>>5; const int wid=__builtin_amdgcn_readfirstlane(tid>>6);
  const bf16*Qw=aa.Qw0+(long)(wid*QBLK)*C::QP;
  const bf16*Kh=aa.Kh,*Vh=aa.Vh; const int win0=aa.win0;
  const unsigned lds0=(unsigned)(uintptr_t)shm;
  float*wsf=(float*)(shm+LDS_WS)+wid*64;
  const bf16*ksrc=Kh+(long)lane*C::KP+wid*8;
  const bf16*vsrc=Vh+(long)(16*(wid&3)+(lane>>2))*C::VP+(wid>>2)*32+(lane&3)*8;
  const unsigned kdst=lds0+LDS_K+wid*1024, vdst=lds0+LDS_V+wid*1024;
  #define KROW(t) (C::MASK ? ((t)<4 ? 4096+64*(t) : win0+64*((t)-4)) : 64*(t))
  #define DMA_K(t,slot) glds16(ksrc+(long)KROW(t)*C::KP,(unsigned)__builtin_amdgcn_readfirstlane(kdst+(slot)))
  #define DMA_V(t,slot) glds16(vsrc+(long)KROW(t)*C::VP,(unsigned)__builtin_amdgcn_readfirstlane(vdst+(slot)))
  const int vb0=(int)(lds0+LDS_V)+((lane>>4)&1)*32+(lane&3)*8+(4*hi+((lane&15)>>2))*64;
  const char*Kbase=shm+LDS_K; bf16x8 kf[8];
  const lds_cptr shm3=(lds_cptr)shm; const lds_cptr kp0=shm3+LDS_K+hi*1024+r32*16; const lds_cptr vp0=shm3+LDS_V+((lane>>4)&1)*32+(lane&3)*8+(4*hi+((lane&15)>>2))*64;
  const int NT=aa.NT;
  DMA_K(0,0);DMA_V(0,0);DMA_K(1,SLOTB);
  bf16x8 qr[4];
  #pragma unroll
  for(int d0=0;d0<4;++d0)qr[d0]=*reinterpret_cast<const bf16x8*>(&Qw[(long)r32*C::QP+d0*16+hi*8]);
  float mhat=0.f,l_reg=0.f;f32x16 o[2];o[0]=f32x16{};o[1]=f32x16{};f32x16 negm=f32x16{};asm volatile("":"+v"(negm));
  const int qpos=aa.qpos0+wid*QBLK+r32;
  #define CMASK(P0,P1,t) do{ if(C::MASK){ if((t)>=4) wmask(P0,P1,win0+64*((t)-4),qpos,hi); } }while(0)
  bool resc=false;
  #define START(P0,P1) do{ const float rm=rowmax(P0,P1); resc=false; \
    { const float dl=rm; mhat=fadd_s(mhat,dl); \
      _Pragma("unroll") for(int r=0;r<16;++r){P0[r]=fsub_s(P0[r],dl);P1[r]=fsub_s(P1[r],dl);} \
      _Pragma("unroll") for(int r=0;r<16;++r)negm[r]=-mhat; asm volatile("":"+v"(negm)); } \
    _Pragma("unroll") for(int r=0;r<16;++r)P0[r]=__builtin_amdgcn_exp2f(P0[r]); }while(0)
  #define RESC() do{ if(resc){ asm volatile("s_waitcnt lgkmcnt(0)":::"memory"); \
      _Pragma("unroll") for(int d_=0;d_<2;++d_) _Pragma("unroll") for(int r=0;r<16;++r)o[d_][r]*=wsf[crow(r,hi)]; } }while(0)
  f32x16 pA0,pA1,pB0,pB1;
  int sl_prev=0,sl_cur=0,sl_next=SLOTB;
  #define ROT() do{sl_prev=sl_cur;sl_cur=sl_next;sl_next=(sl_next==(NSLOT-1)*SLOTB)?0:sl_next+SLOTB;}while(0)
  DMA_K(2,2*SLOTB);
  WAIT_BAR(3);
  qkt(pA0,pA1,Kbase,qr,negm,r32,hi);asm volatile("s_nop 15\n\ts_nop 7":"+v"(pA0),"+v"(pA1));CMASK(pA0,pA1,0);
  START(pA0,pA1);
  _Pragma("unroll") for(int r=0;r<16;++r)pA1[r]=__builtin_amdgcn_exp2f(pA1[r]);
  WAIT_BAR(0);
  DMA_K(3,0);DMA_V(1,SLOTB);
  ROT();
  kload8(kf,kp0+sl_cur);
  WAIT_BAR(2);
  s16x4 vlo[8],vhi[8]; u32x4 pw0,pw1,pw2,pw3;
  #define PKW(P,B) cvtpk_s(P[B],P[B+1])
  #define PAF(k) __builtin_bit_cast(bf16x8,pw##k)
  #define VFR(i) (bf16x8){vlo[i][0],vlo[i][1],vlo[i][2],vlo[i][3],vhi[i][0],vhi[i][1],vhi[i][2],vhi[i][3]}
  #define PIN(x) asm volatile("":"+v"(x))
  #define MX3(a,b,c) __builtin_fmaxf(__builtin_fmaxf((a),(b)),(c))
  #define GAPA(MF,A0,A1,A2,A3,W0,W1,PW) do{ MF; sacc+=A0; sacc+=A1; sacc+=A2; sacc+=A3; PIN(sacc); W0; W1; PIN(PW); SBAR(); }while(0)
  #define EX(v) __builtin_amdgcn_exp2f(v)
  #define GAPB(MF,X,B) do{ MF; X[B]=EX(X[B]); X[B+1]=EX(X[B+1]); X[B+2]=EX(X[B+2]); X[B+3]=EX(X[B+3]); PIN(X); SBAR(); }while(0)
  #define VRD(i) do{ vlo[i]=vtr(vp_+(((i)>>2)*4096+((i)&3)*1024)); vhi[i]=vtr(vp_+(((i)>>2)*4096+((i)&3)*1024+512)); }while(0)
  #define KRD(G,j) do{ if(G){ kload2(kf,kp0+sl_next,j); SBAR(); } }while(0)
  #define STEP(C0,C1,P0,P1,t,GK,GV,GL) do{ SBAR(); \
    const lds_cptr vp_=vp0+sl_prev; \
    VRD(0); SBAR(); float sacc=(P0[0]+P0[1]); \
    GAPA(C0=__builtin_amdgcn_mfma_f32_32x32x16_bf16(kf[0],qr[0],negm,0,0,0), P0[2],P0[3],P0[4],P0[5],     pw0[0]=PKW(P0,0), pw0[1]=PKW(P0,2), pw0); \
    VRD(4); SBAR(); GAPA(C1=__builtin_amdgcn_mfma_f32_32x32x16_bf16(kf[1],qr[0],negm,0,0,0), P0[6],P0[7],P0[8],P0[9],     pw0[2]=PKW(P0,4), pw0[3]=PKW(P0,6), pw0); \
    VRD(1); SBAR(); GAPA(C0=__builtin_amdgcn_mfma_f32_32x32x16_bf16(kf[2],qr[1],C0,0,0,0),   P0[10],P0[11],P0[12],P0[13], pw1[0]=PKW(P0,8), pw1[1]=PKW(P0,10), pw1); \
    VRD(5); SBAR(); GAPA(C1=__builtin_amdgcn_mfma_f32_32x32x16_bf16(kf[3],qr[1],C1,0,0,0),   P0[14],P0[15],P1[0],P1[1],   pw1[2]=PKW(P0,12),pw1[3]=PKW(P0,14), pw1); \
    VRD(2); SBAR(); GAPA(C0=__builtin_amdgcn_mfma_f32_32x32x16_bf16(kf[4],qr[2],C0,0,0,0),   P1[2],P1[3],P1[4],P1[5],     pw2[0]=PKW(P1,0), pw2[1]=PKW(P1,2), pw2); \
    VRD(6); SBAR(); GAPA(C1=__builtin_amdgcn_mfma_f32_32x32x16_bf16(kf[5],qr[2],C1,0,0,0),   P1[6],P1[7],P1[8],P1[9],     pw2[2]=PKW(P1,4), pw2[3]=PKW(P1,6), pw2); \
    VRD(3); SBAR(); GAPA(C0=__builtin_amdgcn_mfma_f32_32x32x16_bf16(kf[6],qr[3],C0,0,0,0),   P1[10],P1[11],P1[12],P1[13], pw3[0]=PKW(P1,8), pw3[1]=PKW(P1,10), pw3); \
    VRD(7); SBAR(); GAPA(C1=__builtin_amdgcn_mfma_f32_32x32x16_bf16(kf[7],qr[3],C1,0,0,0),   P1[14],P1[15],0.f,0.f,       pw3[2]=PKW(P1,12),pw3[3]=PKW(P1,14), pw3); \
    l_reg+=sacc; \
    if(GK){DMA_K((t)+3,sl_cur);} if(GV){DMA_V((t)+1,sl_next);} \
    CMASK(C0,C1,t); \
    { float a=MX3(C0[0],C0[1],C1[0]),b=MX3(C0[2],C0[3],C1[1]); a=MX3(a,C1[2],C1[3]); \
      _Pragma("unroll") for(int r=4;r<16;r+=4){a=MX3(a,C0[r],C0[r+1]);b=MX3(b,C0[r+2],C0[r+3]);a=MX3(a,C1[r],C1[r+1]);b=MX3(b,C1[r+2],C1[r+3]);} \
      float rm=__builtin_fmaxf(a,b); { auto rr=__builtin_amdgcn_permlane32_swap(__float_as_uint(rm),__float_as_uint(rm),false,false); rm=__builtin_fmaxf(__uint_as_float(rr[0]),__uint_as_float(rr[1])); } \
      resc=false; \
      if(__builtin_expect(__any(rm>(float)THRL),0)){ const float dl=__builtin_fmaxf(rm,0.f); mhat+=dl; \
        _Pragma("unroll") for(int r=0;r<16;++r){C0[r]-=dl;C1[r]-=dl;} \
        _Pragma("unroll") for(int r=0;r<16;++r)negm[r]=-mhat; asm volatile("":"+v"(negm)); \
        const float f=__builtin_amdgcn_exp2f(-dl); l_reg*=f; if(hi==0)wsf[r32]=f; resc=true; } } \
    SBAR(); \
    GAPB(o[0]=__builtin_amdgcn_mfma_f32_32x32x16_bf16(PAF(0),VFR(0),o[0],0,0,0), C0,0); \
    GAPB(o[1]=__builtin_amdgcn_mfma_f32_32x32x16_bf16(PAF(0),VFR(4),o[1],0,0,0), C0,4); \
    KRD(GL,0); GAPB(o[0]=__builtin_amdgcn_mfma_f32_32x32x16_bf16(PAF(1),VFR(1),o[0],0,0,0), C0,8); \
    KRD(GL,1); GAPB(o[1]=__builtin_amdgcn_mfma_f32_32x32x16_bf16(PAF(1),VFR(5),o[1],0,0,0), C0,12); \
    KRD(GL,2); GAPB(o[0]=__builtin_amdgcn_mfma_f32_32x32x16_bf16(PAF(2),VFR(2),o[0],0,0,0), C1,0); \
    KRD(GL,3); GAPB(o[1]=__builtin_amdgcn_mfma_f32_32x32x16_bf16(PAF(2),VFR(6),o[1],0,0,0), C1,4); \
    GAPB(o[0]=__builtin_amdgcn_mfma_f32_32x32x16_bf16(PAF(3),VFR(3),o[0],0,0,0), C1,8); \
    GAPB(o[1]=__builtin_amdgcn_mfma_f32_32x32x16_bf16(PAF(3),VFR(7),o[1],0,0,0), C1,12); \
    }while(0)
  int t=1;
  #undef CMASK
  #define CMASK(P0,P1,t) do{ if(C::MASK){ if((t)>=4) wmask(P0,P1,win0+64*((t)-4),qpos,hi); } }while(0)
  for(;t+5<NT;t+=2){
    STEP(pB0,pB1,pA0,pA1,t,true,true,true);     WAIT_BAR(2); RESC(); ROT();
    STEP(pA0,pA1,pB0,pB1,t+1,true,true,true);   WAIT_BAR(2); RESC(); ROT();
  }
  #undef CMASK
  #define CMASK(P0,P1,t) do{ if(C::MASK){ if((t)>=4) wmask(P0,P1,win0+64*((t)-4),qpos,hi); } }while(0)
  #define ENDW(tt) do{ if((tt)+3<NT){WAIT_BAR(2);} else if((tt)+2<NT){WAIT_BAR(1);} else {WAIT_BAR(0);} }while(0)
  for(;t+1<NT;t+=2){
    STEP(pB0,pB1,pA0,pA1,t,(t+3<NT),(t+1<NT),(t+1<NT));       ENDW(t);   RESC(); ROT();
    STEP(pA0,pA1,pB0,pB1,t+1,(t+4<NT),(t+2<NT),(t+2<NT));     ENDW(t+1); RESC(); ROT();
  }
  STEP(pB0,pB1,pA0,pA1,NT-1,false,false,false); RESC();
  { float sacc=pB0[0]+pB0[1]; _Pragma("unroll") for(int r=2;r<16;++r)sacc+=pB0[r]; _Pragma("unroll") for(int r=0;r<16;++r)sacc+=pB1[r]; l_reg+=sacc;
    pw0=(u32x4){PKW(pB0,0),PKW(pB0,2),PKW(pB0,4),PKW(pB0,6)};pw1=(u32x4){PKW(pB0,8),PKW(pB0,10),PKW(pB0,12),PKW(pB0,14)};pw2=(u32x4){PKW(pB1,0),PKW(pB1,2),PKW(pB1,4),PKW(pB1,6)};pw3=(u32x4){PKW(pB1,8),PKW(pB1,10),PKW(pB1,12),PKW(pB1,14)};
    SBAR(); pv(o,vb0+sl_cur,PAF(0),PAF(1),PAF(2),PAF(3)); }
  #undef PKW
  #undef PAF
  #undef VFR
  #undef PIN
  #undef MX3
  #undef GAPA
  #undef GAPB
  #undef EX
  #undef VRD
  #undef KRD
  #undef STEP
  #undef ENDW
  {auto rr=__builtin_amdgcn_permlane32_swap(__float_as_uint(l_reg),__float_as_uint(l_reg),false,false);l_reg=__uint_as_float(rr[0])+__uint_as_float(rr[1]);}
  if(C::MASK) l_reg+=__builtin_amdgcn_exp2f(aa.sinkl2-mhat);
  if(hi==0)wsf[32+r32]=l_reg;asm volatile("s_waitcnt lgkmcnt(0)":::"memory");
  float rli[16];
  #pragma unroll
  for(int r=0;r<16;++r)rli[r]=__builtin_amdgcn_rcpf(wsf[32+crow(r,hi)]);
  bf16*Ow=aa.Ow0+(long)(wid*QBLK)*C::OP;
  { bf16*stg=(bf16*)(shm+LDS_OST)+wid*2048;
    #pragma unroll
    for(int r=0;r<16;++r){const int orow=crow(r,hi);
      #pragma unroll
      for(int d0=0;d0<2;++d0)stg[orow*64+d0*32+r32]=__float2bfloat16(o[d0][r]*rli[r]);}
    asm volatile("s_waitcnt lgkmcnt(0)":::"memory");
    #pragma unroll
    for(int i=0;i<4;++i){const int row=i*8+(lane>>3),ch=lane&7; const u32x4 v=*(const u32x4*)(stg+row*64+ch*8); ATTN_STORE16(Ow+(long)row*C::OP+ch*8,v);} }
  asm volatile("s_waitcnt lgkmcnt(0)\n\ts_barrier":::"memory");
  #undef DMA_K
  #undef KROW
  #undef DMA_V
  #undef CMASK
  #undef START
  #undef RESC
  #undef ROT
}
__device__ __forceinline__ void pv128(f32x16*o,int vb,bf16x8 pa0,bf16x8 pa1,bf16x8 pa2,bf16x8 pa3){
  #pragma unroll
  for(int d0=0;d0<4;++d0){s16x4 lo[4],hi[4];
    #pragma unroll
    for(int ks=0;ks<4;++ks){
      asm volatile("ds_read_b64_tr_b16 %0,%1 offset:%c2":"=&v"(lo[ks]):"v"(vb),"i"(d0*4096+ks*1024):"memory");
      asm volatile("ds_read_b64_tr_b16 %0,%1 offset:%c2":"=&v"(hi[ks]):"v"(vb),"i"(d0*4096+ks*1024+512):"memory");}
    asm volatile("s_waitcnt lgkmcnt(0)":::"memory");SBAR();
    #define PK(k) (bf16x8){lo[k][0],lo[k][1],lo[k][2],lo[k][3],hi[k][0],hi[k][1],hi[k][2],hi[k][3]}
    o[d0]=__builtin_amdgcn_mfma_f32_32x32x16_bf16(pa0,PK(0),o[d0],0,0,0);
    o[d0]=__builtin_amdgcn_mfma_f32_32x32x16_bf16(pa1,PK(1),o[d0],0,0,0);
    o[d0]=__builtin_amdgcn_mfma_f32_32x32x16_bf16(pa2,PK(2),o[d0],0,0,0);
    o[d0]=__builtin_amdgcn_mfma_f32_32x32x16_bf16(pa3,PK(3),o[d0],0,0,0);
    #undef PK
  }
}
template<class C,int THRL> __device__ __forceinline__ void attn_unit128(const AttnArgs& aa,char*shm){
  constexpr int LDS_K=0, LDS_V=NSLOT*SLOTB, LDS_WS=LDS_V+NSLOT*2*SLOTB, LDS_OST=LDS_WS+NW*64*4;

  int tid_=threadIdx.x; asm volatile("":"+v"(tid_)); const int tid=tid_,lane=tid&63,r32=lane&31,hi=lane>>5; const int wid=__builtin_amdgcn_readfirstlane(tid>>6);
  const bf16*Qw=aa.Qw0+(long)(wid*QBLK)*C::QP;
  const bf16*Kh=aa.Kh,*Vh=aa.Vh; const int win0=aa.win0;
  const unsigned lds0=(unsigned)(uintptr_t)shm;
  float*wsf=(float*)(shm+LDS_WS)+wid*64;
  const bf16*ksrc=Kh+(long)lane*C::KP+wid*8;
  const bf16*vsrc=Vh+(long)(16*(wid&3)+(lane>>2))*C::VP+(wid>>2)*32+(lane&3)*8;
  const unsigned kdst=lds0+LDS_K+wid*1024, vdst=lds0+LDS_V+wid*1024;
  #define KROW(t) (C::MASK ? ((t)<4 ? 4096+64*(t) : win0+64*((t)-4)) : 64*(t))
  #define DMA_K(t,slot) glds16(ksrc+(long)KROW(t)*C::KP,(unsigned)__builtin_amdgcn_readfirstlane(kdst+(slot)))
  #define DMA_V(t,slot) do{ glds16(vsrc+(long)KROW(t)*C::VP,(unsigned)__builtin_amdgcn_readfirstlane(vdst+2*(slot))); glds16(vsrc+(long)KROW(t)*C::VP+64,(unsigned)__builtin_amdgcn_readfirstlane(vdst+2*(slot)+8192)); }while(0)
  const int vb0=(int)(lds0+LDS_V)+((lane>>4)&1)*32+(lane&3)*8+(4*hi+((lane&15)>>2))*64;
  const char*Kbase=shm+LDS_K; bf16x8 kf[8];
  const lds_cptr shm3=(lds_cptr)shm; const lds_cptr kp0=shm3+LDS_K+hi*1024+r32*16; const lds_cptr vp0=shm3+LDS_V+((lane>>4)&1)*32+(lane&3)*8+(4*hi+((lane&15)>>2))*64;
  const int NT=aa.NT;
  DMA_K(0,0);DMA_V(0,0);DMA_K(1,SLOTB);
  bf16x8 qr[4];
  #pragma unroll
  for(int d0=0;d0<4;++d0)qr[d0]=*reinterpret_cast<const bf16x8*>(&Qw[(long)r32*C::QP+d0*16+hi*8]);
  float mhat=0.f,l_reg=0.f;f32x16 o[4];o[0]=f32x16{};o[1]=f32x16{};o[2]=f32x16{};o[3]=f32x16{};f32x16 negm=f32x16{};asm volatile("":"+v"(negm));
  const int qpos=aa.qpos0+wid*QBLK+r32;
  #define CMASK(P0,P1,t) do{ if(C::MASK){ if((t)>=4) wmask(P0,P1,win0+64*((t)-4),qpos,hi); } }while(0)
  bool resc=false;
  #define START(P0,P1) do{ const float rm=rowmax(P0,P1); resc=false; \
    { const float dl=rm; mhat=fadd_s(mhat,dl); \
      _Pragma("unroll") for(int r=0;r<16;++r){P0[r]=fsub_s(P0[r],dl);P1[r]=fsub_s(P1[r],dl);} \
      _Pragma("unroll") for(int r=0;r<16;++r)negm[r]=-mhat; asm volatile("":"+v"(negm)); } \
    _Pragma("unroll") for(int r=0;r<16;++r)P0[r]=__builtin_amdgcn_exp2f(P0[r]); }while(0)
  #define RESC() do{ if(resc){ asm volatile("s_waitcnt lgkmcnt(0)":::"memory"); \
      _Pragma("unroll") for(int d_=0;d_<4;++d_) _Pragma("unroll") for(int r=0;r<16;++r)o[d_][r]*=wsf[crow(r,hi)]; } }while(0)
  f32x16 pA0,pA1,pB0,pB1;
  int sl_prev=0,sl_cur=0,sl_next=SLOTB;
  #define ROT() do{sl_prev=sl_cur;sl_cur=sl_next;sl_next=(sl_next==(NSLOT-1)*SLOTB)?0:sl_next+SLOTB;}while(0)
  DMA_K(2,2*SLOTB);
  WAIT_BAR(3);
  qkt(pA0,pA1,Kbase,qr,negm,r32,hi);asm volatile("s_nop 15\n\ts_nop 7":"+v"(pA0),"+v"(pA1));CMASK(pA0,pA1,0);
  START(pA0,pA1);
  _Pragma("unroll") for(int r=0;r<16;++r)pA1[r]=__builtin_amdgcn_exp2f(pA1[r]);
  WAIT_BAR(0);
  DMA_K(3,0);DMA_V(1,SLOTB);
  ROT();
  kload8(kf,kp0+sl_cur);
  WAIT_BAR(3);
  s16x4 vlo[4],vhi[4]; u32x4 pw0,pw1,pw2,pw3;
  #define PKW(P,B) cvtpk_s(P[B],P[B+1])
  #define PAF(k) __builtin_bit_cast(bf16x8,pw##k)
  #define PIN(x) asm volatile("":"+v"(x))
  #define MX3(a,b,c) __builtin_fmaxf(__builtin_fmaxf((a),(b)),(c))
  #define GAPA(MF,A0,A1,A2,A3,W0,W1,PW) do{ MF; sacc+=A0; sacc+=A1; sacc+=A2; sacc+=A3; PIN(sacc); W0; W1; PIN(PW); SBAR(); }while(0)
  #define EX(v) __builtin_amdgcn_exp2f(v)
  #define GAPB(MF,X,B) do{ MF; X[B]=EX(X[B]); X[B+1]=EX(X[B+1]); PIN(X); SBAR(); }while(0)
  #define VRD(j) do{ vlo[(j)&3]=vtr(vp_+(((j)&3)*4096+((j)>>2)*1024)); vhi[(j)&3]=vtr(vp_+(((j)&3)*4096+((j)>>2)*1024+512)); SBAR(); }while(0)
  #define VFR(j) (bf16x8){vlo[(j)&3][0],vlo[(j)&3][1],vlo[(j)&3][2],vlo[(j)&3][3],vhi[(j)&3][0],vhi[(j)&3][1],vhi[(j)&3][2],vhi[(j)&3][3]}
  #define KRD(G,j) do{ if(G){ kload2(kf,kp0+sl_next,j); SBAR(); } }while(0)
  #define STEP(C0,C1,P0,P1,t,GK,GV,GL) do{ SBAR(); \
    const lds_cptr vp_=vp0+2*sl_prev; \
    float sacc=(P0[0]+P0[1]); \
    GAPA(C0=__builtin_amdgcn_mfma_f32_32x32x16_bf16(kf[0],qr[0],negm,0,0,0), P0[2],P0[3],P0[4],P0[5],     pw0[0]=PKW(P0,0), pw0[1]=PKW(P0,2), pw0); \
    GAPA(C1=__builtin_amdgcn_mfma_f32_32x32x16_bf16(kf[1],qr[0],negm,0,0,0), P0[6],P0[7],P0[8],P0[9],     pw0[2]=PKW(P0,4), pw0[3]=PKW(P0,6), pw0); \
    GAPA(C0=__builtin_amdgcn_mfma_f32_32x32x16_bf16(kf[2],qr[1],C0,0,0,0),   P0[10],P0[11],P0[12],P0[13], pw1[0]=PKW(P0,8), pw1[1]=PKW(P0,10), pw1); \
    GAPA(C1=__builtin_amdgcn_mfma_f32_32x32x16_bf16(kf[3],qr[1],C1,0,0,0),   P0[14],P0[15],P1[0],P1[1],   pw1[2]=PKW(P0,12),pw1[3]=PKW(P0,14), pw1); \
    GAPA(C0=__builtin_amdgcn_mfma_f32_32x32x16_bf16(kf[4],qr[2],C0,0,0,0),   P1[2],P1[3],P1[4],P1[5],     pw2[0]=PKW(P1,0), pw2[1]=PKW(P1,2), pw2); \
    GAPA(C1=__builtin_amdgcn_mfma_f32_32x32x16_bf16(kf[5],qr[2],C1,0,0,0),   P1[6],P1[7],P1[8],P1[9],     pw2[2]=PKW(P1,4), pw2[3]=PKW(P1,6), pw2); \
    VRD(0); GAPA(C0=__builtin_amdgcn_mfma_f32_32x32x16_bf16(kf[6],qr[3],C0,0,0,0),   P1[10],P1[11],P1[12],P1[13], pw3[0]=PKW(P1,8), pw3[1]=PKW(P1,10), pw3); \
    VRD(1); GAPA(C1=__builtin_amdgcn_mfma_f32_32x32x16_bf16(kf[7],qr[3],C1,0,0,0),   P1[14],P1[15],0.f,0.f,       pw3[2]=PKW(P1,12),pw3[3]=PKW(P1,14), pw3); \
    l_reg+=sacc; \
    if(GK){DMA_K((t)+3,sl_cur);} if(GV){DMA_V((t)+1,sl_next);} \
    CMASK(C0,C1,t); \
    { float a=MX3(C0[0],C0[1],C1[0]),b=MX3(C0[2],C0[3],C1[1]); a=MX3(a,C1[2],C1[3]); \
      _Pragma("unroll") for(int r=4;r<16;r+=4){a=MX3(a,C0[r],C0[r+1]);b=MX3(b,C0[r+2],C0[r+3]);a=MX3(a,C1[r],C1[r+1]);b=MX3(b,C1[r+2],C1[r+3]);} \
      float rm=__builtin_fmaxf(a,b); { auto rr=__builtin_amdgcn_permlane32_swap(__float_as_uint(rm),__float_as_uint(rm),false,false); rm=__builtin_fmaxf(__uint_as_float(rr[0]),__uint_as_float(rr[1])); } \
      resc=false; \
      if(__builtin_expect(__any(rm>(float)THRL),0)){ const float dl=__builtin_fmaxf(rm,0.f); mhat+=dl; \
        _Pragma("unroll") for(int r=0;r<16;++r){C0[r]-=dl;C1[r]-=dl;} \
        _Pragma("unroll") for(int r=0;r<16;++r)negm[r]=-mhat; asm volatile("":"+v"(negm)); \
        const float f=__builtin_amdgcn_exp2f(-dl); l_reg*=f; if(hi==0)wsf[r32]=f; resc=true; } } \
    SBAR(); \
    GAPB(o[0]=__builtin_amdgcn_mfma_f32_32x32x16_bf16(PAF(0),VFR(0),o[0],0,0,0),  C0,0);  VRD(2); \
    GAPB(o[1]=__builtin_amdgcn_mfma_f32_32x32x16_bf16(PAF(0),VFR(1),o[1],0,0,0),  C0,2);  VRD(3); \
    GAPB(o[2]=__builtin_amdgcn_mfma_f32_32x32x16_bf16(PAF(0),VFR(2),o[2],0,0,0),  C0,4);  VRD(4); \
    GAPB(o[3]=__builtin_amdgcn_mfma_f32_32x32x16_bf16(PAF(0),VFR(3),o[3],0,0,0),  C0,6);  VRD(5); \
    KRD(GL,0); GAPB(o[0]=__builtin_amdgcn_mfma_f32_32x32x16_bf16(PAF(1),VFR(4),o[0],0,0,0),  C0,8);  VRD(6); \
    GAPB(o[1]=__builtin_amdgcn_mfma_f32_32x32x16_bf16(PAF(1),VFR(5),o[1],0,0,0),  C0,10);  VRD(7); \
    KRD(GL,1); GAPB(o[2]=__builtin_amdgcn_mfma_f32_32x32x16_bf16(PAF(1),VFR(6),o[2],0,0,0),  C0,12);  VRD(8); \
    GAPB(o[3]=__builtin_amdgcn_mfma_f32_32x32x16_bf16(PAF(1),VFR(7),o[3],0,0,0),  C0,14);  VRD(9); \
    KRD(GL,2); GAPB(o[0]=__builtin_amdgcn_mfma_f32_32x32x16_bf16(PAF(2),VFR(8),o[0],0,0,0),  C1,0);  VRD(10); \
    GAPB(o[1]=__builtin_amdgcn_mfma_f32_32x32x16_bf16(PAF(2),VFR(9),o[1],0,0,0),  C1,2);  VRD(11); \
    KRD(GL,3); GAPB(o[2]=__builtin_amdgcn_mfma_f32_32x32x16_bf16(PAF(2),VFR(10),o[2],0,0,0), C1,4);  VRD(12); \
    GAPB(o[3]=__builtin_amdgcn_mfma_f32_32x32x16_bf16(PAF(2),VFR(11),o[3],0,0,0), C1,6);  VRD(13); \
    GAPB(o[0]=__builtin_amdgcn_mfma_f32_32x32x16_bf16(PAF(3),VFR(12),o[0],0,0,0), C1,8);  VRD(14); \
    GAPB(o[1]=__builtin_amdgcn_mfma_f32_32x32x16_bf16(PAF(3),VFR(13),o[1],0,0,0), C1,10);  VRD(15); \
    GAPB(o[2]=__builtin_amdgcn_mfma_f32_32x32x16_bf16(PAF(3),VFR(14),o[2],0,0,0), C1,12); \
    GAPB(o[3]=__builtin_amdgcn_mfma_f32_32x32x16_bf16(PAF(3),VFR(15),o[3],0,0,0), C1,14); \
    }while(0)
  int t=1;
  #undef CMASK
  #define CMASK(P0,P1,t) do{ if(C::MASK){ if((t)>=4) wmask(P0,P1,win0+64*((t)-4),qpos,hi); } }while(0)
  for(;t+5<NT;t+=2){
    STEP(pB0,pB1,pA0,pA1,t,true,true,true);     WAIT_BAR(3); RESC(); ROT();
    STEP(pA0,pA1,pB0,pB1,t+1,true,true,true);   WAIT_BAR(3); RESC(); ROT();
  }
  #undef CMASK
  #define CMASK(P0,P1,t) do{ if(C::MASK){ if((t)>=4) wmask(P0,P1,win0+64*((t)-4),qpos,hi); } }while(0)
  #define ENDW(tt) do{ if((tt)+3<NT){WAIT_BAR(3);} else if((tt)+2<NT){WAIT_BAR(2);} else {WAIT_BAR(0);} }while(0)
  for(;t+1<NT;t+=2){
    STEP(pB0,pB1,pA0,pA1,t,(t+3<NT),(t+1<NT),(t+1<NT));       ENDW(t);   RESC(); ROT();
    STEP(pA0,pA1,pB0,pB1,t+1,(t+4<NT),(t+2<NT),(t+2<NT));     ENDW(t+1); RESC(); ROT();
  }
  STEP(pB0,pB1,pA0,pA1,NT-1,false,false,false); RESC();
  { float sacc=pB0[0]+pB0[1]; _Pragma("unroll") for(int r=2;r<16;++r)sacc+=pB0[r]; _Pragma("unroll") for(int r=0;r<16;++r)sacc+=pB1[r]; l_reg+=sacc;
    pw0=(u32x4){PKW(pB0,0),PKW(pB0,2),PKW(pB0,4),PKW(pB0,6)};pw1=(u32x4){PKW(pB0,8),PKW(pB0,10),PKW(pB0,12),PKW(pB0,14)};pw2=(u32x4){PKW(pB1,0),PKW(pB1,2),PKW(pB1,4),PKW(pB1,6)};pw3=(u32x4){PKW(pB1,8),PKW(pB1,10),PKW(pB1,12),PKW(pB1,14)};
    SBAR(); pv128(o,vb0+2*sl_cur,PAF(0),PAF(1),PAF(2),PAF(3)); }
  #undef PKW
  #undef PAF
  #undef VFR
  #undef PIN
  #undef MX3
  #undef GAPA
  #undef GAPB
  #undef EX
  #undef VRD
  #undef KRD
  #undef STEP
  #undef ENDW
  {auto rr=__builtin_amdgcn_permlane32_swap(__float_as_uint(l_reg),__float_as_uint(l_reg),false,false);l_reg=__uint_as_float(rr[0])+__uint_as_float(rr[1]);}
  if(C::MASK) l_reg+=__builtin_amdgcn_exp2f(aa.sinkl2-mhat);
  if(hi==0)wsf[32+r32]=l_reg;asm volatile("s_waitcnt lgkmcnt(0)":::"memory");
  float rli[16];
  #pragma unroll
  for(int r=0;r<16;++r)rli[r]=__builtin_amdgcn_rcpf(wsf[32+crow(r,hi)]);
  bf16*Ow=aa.Ow0+(long)(wid*QBLK)*C::OP;
  { bf16*stg=(bf16*)(shm+LDS_OST)+wid*2048;
    #pragma unroll
    for(int hp=0;hp<2;++hp){
      #pragma unroll
      for(int r=0;r<16;++r){const int orow=crow(r,hi);
        #pragma unroll
        for(int d0=0;d0<2;++d0)stg[orow*64+d0*32+r32]=__float2bfloat16(o[2*hp+d0][r]*rli[r]);}
      asm volatile("s_waitcnt lgkmcnt(0)":::"memory");
      #pragma unroll
      for(int i=0;i<4;++i){const int row=i*8+(lane>>3),ch=lane&7; const u32x4 v=*(const u32x4*)(stg+row*64+ch*8); ATTN_STORE16(Ow+(long)row*C::OP+hp*64+ch*8,v);}
      asm volatile("s_waitcnt lgkmcnt(0)":::"memory");
    } }
  asm volatile("s_waitcnt lgkmcnt(0)\n\ts_barrier":::"memory");
  #undef DMA_K
  #undef KROW
  #undef DMA_V
  #undef CMASK
  #undef START
  #undef RESC
  #undef ROT
}
constexpr int ATTN_LDS_BYTES=LDS_BYTES;
#undef SBAR
#undef WAIT_BAR
}
constexpr int NWAVES = 8;
constexpr int DM = 2048, NBATCH = 4, SEQ = 4096, CTXL = 256;
constexpr int MT = NBATCH * SEQ, MC = NBATCH * CTXL, MH = MT + MC;
constexpr int KVR = SEQ + CTXL;
constexpr int PROJ = 8448, NE = 32, TOPK = 4;
constexpr int NASSIGN = MT * TOPK;
constexpr int MAXMT = NASSIGN / 256 + NE;
constexpr float LN_EPS = 1e-5f;
constexpr float DN_ALPHA = 1.189207115002721f;
constexpr float LAM_INIT = 0.2f;
constexpr int MODW = 6 * DM;

constexpr size_t MiB = 1u << 20;
constexpr size_t WS_CTL = 0, CTL_ZERO_BYTES = 64 * 1024;
constexpr size_t WS_MODP = 1 * MiB;
constexpr size_t WS_MOD = 2 * MiB;
constexpr size_t WS_PSLOT = 3 * MiB, WS_PGATE = 5 * MiB, WS_STATS = 7 * MiB, WS_SA = 7 * MiB + 256 * 1024, WS_SB = 7 * MiB + 512 * 1024, WS_SH = 7 * MiB + 128 * 1024, WS_SBIN = 7 * MiB + 320 * 1024;
constexpr size_t WS_WIN = 8 * MiB;
constexpr size_t WS_WOA = 42 * MiB, WS_WOB = 46 * MiB, WS_WOUT = 50 * MiB;
constexpr size_t WS_WUP = 64 * MiB;
constexpr size_t WS_WDN = 576 * MiB;
constexpr size_t WS_H = 832 * MiB;
constexpr size_t WS_QA = 900 * MiB, WS_KA = 932 * MiB, WS_VA = 966 * MiB, WS_QB = 1000 * MiB, WS_KB = 1032 * MiB, WS_VB = 1037 * MiB;
constexpr size_t WS_GA = 1042 * MiB, WS_GB = 1106 * MiB, WS_O4 = 1170 * MiB, WS_OA = 1234 * MiB, WS_OB = 1266 * MiB;
constexpr size_t WS_Y1 = 1298 * MiB, WS_Y = 1426 * MiB, WS_R = 1490 * MiB, WS_X1 = 1618 * MiB, WS_HM = 1746 * MiB;
constexpr size_t WS_XG = 1810 * MiB, WS_ACT = 2098 * MiB, WS_YS = 2386 * MiB, WS_ACTQ = 2642 * MiB, WS_RMAXP = 2794 * MiB, WS_SACT = 2814 * MiB, WS_SBD = 2815 * MiB, WS_END = 2816 * MiB;
constexpr size_t WS_YSG = WS_XG, WS_INV = WS_SBD + 512 * 1024;
constexpr size_t WS_OBQ = WS_X1, WS_SOA = WS_STATS + 384 * 1024, WS_SOB = WS_STATS + 448 * 1024, WS_SBOA = WS_SBD + 768 * 1024, WS_SBOB = WS_SBD + 776 * 1024;
constexpr size_t WS_RMAXY = WS_RMAXP, WS_SY = WS_SACT, WS_SBOUT = WS_SBD + 784 * 1024;
constexpr int CW_BAR = 4096;
constexpr int CW_CNT = 8192;
constexpr int CW_QDNQ = 8896;
constexpr int CW_QUPQ = 8512;
constexpr int CW_QCONV = 8448;
constexpr int NG_INPROJ = 144;
constexpr int NWORK = 208;

constexpr int RING_OFF = 0, RING_BYTES = 131072;
constexpr int LDSCTL_OFF = RING_BYTES, MISC_OFF = LDSCTL_OFF + 320;
constexpr int TOK_OFF = LDSCTL_OFF + 2816, EPL_OFF = TOK_OFF + 9216 + 18432;
constexpr int TBL_OFF = LDSCTL_OFF + 1024;
constexpr int LDS_BYTES = 163840;
#define GAS __attribute__((address_space(1)))
#define LAS __attribute__((address_space(3)))
typedef unsigned short bf16;
typedef unsigned v4u __attribute__((ext_vector_type(4)));
typedef float f32x4 __attribute__((ext_vector_type(4)));
typedef short bf16x8 __attribute__((ext_vector_type(8)));
typedef GAS unsigned gu32;
typedef GAS unsigned long long gu64;
#define RLX_AGENT __ATOMIC_RELAXED, __HIP_MEMORY_SCOPE_AGENT
#define LDS_WAIT() asm volatile("s_waitcnt lgkmcnt(0)" ::: "memory")
#define VM_WAIT() asm volatile("s_waitcnt vmcnt(0)" ::: "memory")
__device__ __forceinline__ unsigned long long rt() { return __builtin_amdgcn_s_memrealtime(); }
__device__ __forceinline__ unsigned f2bf(float f) { unsigned u = __builtin_bit_cast(unsigned, f); return (u + 0x7fffu + ((u >> 16) & 1u)) >> 16; }
__device__ __forceinline__ unsigned pk2(float lo, float hi) { return f2bf(lo) | (f2bf(hi) << 16); }

#define XB_TMO      128
#define XB_XCNT(j)  (256  + 64 * (j))
#define XB_XSUB(j)  (1280 + 64 * (j))
#define XB_XGEN(j)  (2304 + 64 * (j))
#define XB_TOP      3328
#define XB_TOPGEN   3392
#define XCD_BAR_WORDS 3456
#define XB_SPIN_CAP (1u << 18)

__device__ __forceinline__ unsigned xb_ld(unsigned* p)              { return __hip_atomic_load(p, __ATOMIC_RELAXED, __HIP_MEMORY_SCOPE_AGENT); }
__device__ __forceinline__ unsigned xb_add(unsigned* p, unsigned v) { return __hip_atomic_fetch_add(p, v, __ATOMIC_RELAXED, __HIP_MEMORY_SCOPE_AGENT); }
__device__ __forceinline__ unsigned xb_xcc_id() { return (unsigned)__builtin_amdgcn_s_getreg((3 << 11) | 20) & 0xFu; }
#define XB_SPIN(cond, bar) do { unsigned _sp = 0; while (cond) { __builtin_amdgcn_s_sleep(1); \
    if ((++_sp & 255u) == 0u) { if (xb_ld(&(bar)[XB_TMO])) break; if (_sp > XB_SPIN_CAP) { atomicAdd(&(bar)[XB_TMO], 1u); break; } } } } while (0)

struct XcdBarrier {
    unsigned* bar; unsigned x;
    volatile LAS unsigned* st;
};

__device__ __forceinline__ XcdBarrier xcd_barrier_post(unsigned* bar, volatile LAS unsigned* st) {
    XcdBarrier b; b.bar = bar; b.x = xb_xcc_id(); b.st = st;
    if (threadIdx.x == 0) (void)xb_add(&bar[XB_XCNT(b.x)], 1u);
    return b;
}
__device__ __forceinline__ void xcd_barrier_complete(unsigned* bar, unsigned x, unsigned& nloc, unsigned& nx) {
    const unsigned G = gridDim.x * gridDim.y * gridDim.z;
    unsigned sum, cnt, mine, sp = 0u;
    for (;;) {
        sum = 0u; cnt = 0u; mine = 0u;
#pragma unroll
        for (unsigned j = 0; j < 16; ++j) { const unsigned c = xb_ld(&bar[XB_XCNT(j)]); sum += c; cnt += (c > 0u) ? 1u : 0u; mine = (j == x) ? c : mine; }
        if (sum == G) break;
        __builtin_amdgcn_s_sleep(1);
        if ((++sp & 255u) == 0u) { if (xb_ld(&bar[XB_TMO])) break; if (sp > XB_SPIN_CAP) { atomicAdd(&bar[XB_TMO], 1u); break; } }
    }
    nloc = mine > 0u ? mine : 1u; nx = cnt > 0u ? cnt : 1u;
}

__device__ __forceinline__ void xcd_barrier(const XcdBarrier& b) {
    asm volatile("s_waitcnt vmcnt(0)" ::: "memory");
    __syncthreads();
    if (threadIdx.x == 0) {
        unsigned* bar = b.bar;
        __builtin_amdgcn_s_waitcnt(0);
        unsigned nloc = b.st[0], nx = b.st[1];
        if (nloc == 0u) { xcd_barrier_complete(bar, b.x, nloc, nx); b.st[0] = nloc; b.st[1] = nx; }
        const unsigned old = xb_add(&bar[XB_XSUB(b.x)], 1u);
        const unsigned gen = old / nloc;
        if (old + 1u == (gen + 1u) * nloc) {
            __builtin_amdgcn_fence(__ATOMIC_RELEASE, "agent");
            asm volatile("s_waitcnt vmcnt(0)" ::: "memory");
            const unsigned og = xb_add(&bar[XB_TOP], 1u);
            const unsigned tg = og / nx;
            if (og + 1u == (tg + 1u) * nx) xb_add(&bar[XB_TOPGEN], 1u);
            else XB_SPIN(xb_ld(&bar[XB_TOPGEN]) == tg, bar);
            __builtin_amdgcn_fence(__ATOMIC_ACQUIRE, "agent");
            xb_add(&bar[XB_XGEN(b.x)], 1u);
            asm volatile("s_waitcnt vmcnt(0)" ::: "memory");
        } else {
            XB_SPIN(xb_ld(&bar[XB_XGEN(b.x)]) == gen, bar);
            __builtin_amdgcn_fence(__ATOMIC_ACQUIRE, "agent");
            asm volatile("s_waitcnt vmcnt(0)" ::: "memory");
        }
    }
    __syncthreads();
}

__device__ __forceinline__ unsigned xcd_barrier_arrive(const XcdBarrier& b) {
    asm volatile("s_waitcnt vmcnt(0)" ::: "memory");
    __syncthreads();
    unsigned gen = 0u;
    if (threadIdx.x == 0) {
        unsigned* bar = b.bar;
        __builtin_amdgcn_s_waitcnt(0);
        unsigned nloc = b.st[0], nx = b.st[1];
        if (nloc == 0u) { xcd_barrier_complete(bar, b.x, nloc, nx); b.st[0] = nloc; b.st[1] = nx; }
        const unsigned old = xb_add(&bar[XB_XSUB(b.x)], 1u);
        gen = old / nloc;
        if (old + 1u == (gen + 1u) * nloc) {
            __builtin_amdgcn_fence(__ATOMIC_RELEASE, "agent");
            asm volatile("s_waitcnt vmcnt(0)" ::: "memory");
            const unsigned og = xb_add(&bar[XB_TOP], 1u);
            const unsigned tg = og / nx;
            if (og + 1u == (tg + 1u) * nx) xb_add(&bar[XB_TOPGEN], 1u);
            else XB_SPIN(xb_ld(&bar[XB_TOPGEN]) == tg, bar);
            __builtin_amdgcn_fence(__ATOMIC_ACQUIRE, "agent");
            xb_add(&bar[XB_XGEN(b.x)], 1u);
            asm volatile("s_waitcnt vmcnt(0)" ::: "memory");
        }
        b.st[2] = gen;
    }
    __syncthreads();
    return gen;
}
__device__ __forceinline__ bool xcd_barrier_test(const XcdBarrier& b) {
    if (threadIdx.x == 0) {
        const unsigned open_ = (xb_ld(&b.bar[XB_XGEN(b.x)]) != b.st[2]) ? 1u : 0u;
        if (open_) { __builtin_amdgcn_fence(__ATOMIC_ACQUIRE, "agent"); asm volatile("s_waitcnt vmcnt(0)" ::: "memory"); }
        b.st[3] = open_;
    }
    __syncthreads();
    const unsigned r = b.st[3];
    __syncthreads();
    return r != 0u;
}
__device__ __forceinline__ void xcd_barrier_wait(const XcdBarrier& b) {
    if (threadIdx.x == 0) {
        unsigned* bar = b.bar; const unsigned gen = b.st[2];
        XB_SPIN(xb_ld(&bar[XB_XGEN(b.x)]) == gen, bar);
        __builtin_amdgcn_fence(__ATOMIC_ACQUIRE, "agent");
        asm volatile("s_waitcnt vmcnt(0)" ::: "memory");
    }
    __syncthreads();
}
struct Frame {
    LAS unsigned char* lds;
    volatile LAS unsigned* MISC;
    gu32* ctl;
    int tid, lane, wave;
    int vcu, G;
    float* out;
    unsigned char* ws;
};
typedef float f32x2 __attribute__((ext_vector_type(2)));
typedef unsigned u32x2 __attribute__((ext_vector_type(2)));
__device__ __forceinline__ float wave_sum(float v) {
#pragma unroll
    for (int o = 1; o < 64; o <<= 1) v += __shfl_xor(v, o);
    return v;
}

template <int MODE> __device__ __forceinline__ int conv_rowmap(int n) {
    if (MODE == 1) {
        const bool rot = (n < 2048) || (n >= 3072 && n < 4224);
        if (!rot) return n;
        const int d = n & 63, g = 4 * (d >> 5) + ((d & 15) >> 2), j = 4 * ((d >> 4) & 1) + (d & 3);
        return (n & ~63) + 8 * g + j;
    }
    if (MODE == 2) { const int lin = n >= 2048 ? 1 : 0, m = n - 2048 * lin; return 256 * (m >> 7) + 128 * lin + (m & 127); }
    return n;
}
template <int MODE, int NI = 1> __device__ __forceinline__ void conv_item(const float* W, int K, int N, bf16* WT, LAS float* scr, int item, int lane) {
    (void)scr;
    const int nblk = N / 32, kb = item / nblk, nb = item % nblk, k0 = 64 * kb, n0 = 32 * nb, c = lane & 7, kg = lane >> 3;
    const float* src = W + (size_t)(k0 + 8 * kg) * N + n0 + 4 * c;
    f32x4 v[NI][8];
#pragma unroll
    for (int t = 0; t < NI; ++t)
#pragma unroll
        for (int i = 0; i < 8; ++i) v[t][i] = __builtin_nontemporal_load((const GAS f32x4*)(src + (size_t)i * N + 32 * t));
#pragma unroll
    for (int t = 0; t < NI; ++t)
#pragma unroll
        for (int q = 0; q < 4; ++q) { v4u o; o.x = pk2(v[t][0][q], v[t][1][q]); o.y = pk2(v[t][2][q], v[t][3][q]); o.z = pk2(v[t][4][q], v[t][5][q]); o.w = pk2(v[t][6][q], v[t][7][q]);
            *(GAS v4u*)(WT + (size_t)conv_rowmap<MODE>(n0 + 32 * t + 4 * c + q) * K + k0 + 8 * kg) = o; }
}
constexpr int CONV_I_UP = (DM / 64) * (4096 / 32), CONV_I_DN = (DM / 64) * (DM / 32), CONV_NCHUNK = NE * (CONV_I_UP + CONV_I_DN) / 16;
__device__ __forceinline__ void conv_pair_load(f32x4 (&v)[2][8], const float* src, int N) {
#pragma unroll
    for (int t = 0; t < 2; ++t)
#pragma unroll
        for (int i = 0; i < 8; ++i) v[t][i] = __builtin_nontemporal_load((const GAS f32x4*)(src + (size_t)i * N + 32 * t));
}
template <int MODE> __device__ __forceinline__ void conv_pair_store(const f32x4 (&v)[2][8], bf16* WT, int K, int ncol0, int kcol) {
#pragma unroll
    for (int t = 0; t < 2; ++t)
#pragma unroll
        for (int q = 0; q < 4; ++q) { v4u o; o.x = pk2(v[t][0][q], v[t][1][q]); o.y = pk2(v[t][2][q], v[t][3][q]); o.z = pk2(v[t][4][q], v[t][5][q]); o.w = pk2(v[t][6][q], v[t][7][q]);
            *(GAS v4u*)(WT + (size_t)conv_rowmap<MODE>(ncol0 + 32 * t + q) * K + kcol) = o; }
}
template <int MODE> __device__ __forceinline__ void conv_chunk(const float* W, int N, bf16* WT, int item0, int lane) {
    const int nblk = N / 32, kb = item0 / nblk, nb = item0 % nblk, k0 = 64 * kb, n0 = 32 * nb, c = lane & 7, kg = lane >> 3;
    const float* src = W + (size_t)(k0 + 8 * kg) * N + n0 + 4 * c; const int ncol = n0 + 4 * c, kcol = k0 + 8 * kg;
    f32x4 va[2][8], vb[2][8];
    conv_pair_load(va, src, N);
#pragma unroll
    for (int p = 0; p < 8; p += 2) {
        conv_pair_load(vb, src + 64 * (p + 1), N);
        conv_pair_store<MODE>(va, WT, DM, ncol + 64 * p, kcol);
        if (p + 2 < 8) conv_pair_load(va, src + 64 * (p + 2), N);
        conv_pair_store<MODE>(vb, WT, DM, ncol + 64 * (p + 1), kcol);
    }
}
__device__ __forceinline__ void conv_expert_queue(Frame& F, const float* wup, const float* wdn, int qword = CW_QCONV) {
    int tid = threadIdx.x; asm volatile("" : "+v"(tid)); const int lane = tid & 63;
    gu32* q = F.ctl + qword;
    unsigned nx = 0u; if (lane == 0) nx = __hip_atomic_fetch_add(q, 1u, RLX_AGENT);
    for (;;) {
        const unsigned ch = (unsigned)__builtin_amdgcn_readfirstlane((int)nx) + (unsigned)(NE * CONV_I_UP / 16);
        if (ch >= (unsigned)CONV_NCHUNK) break;
        if (lane == 0) nx = __hip_atomic_fetch_add(q, 1u, RLX_AGENT);
        const int it0 = (int)ch * 16;
        if (it0 < NE * CONV_I_UP) { const int e = it0 / CONV_I_UP, r = it0 % CONV_I_UP; conv_chunk<2>(wup + (size_t)e * DM * 4096, 4096, (bf16*)(F.ws + WS_WUP) + (size_t)e * 4096 * DM, r, lane); }
        else { const int qq = it0 - NE * CONV_I_UP, e = qq / CONV_I_DN, r = qq % CONV_I_DN; conv_chunk<0>(wdn + (size_t)e * DM * DM, DM, (bf16*)(F.ws + WS_WDN) + (size_t)e * DM * DM, r, lane); }
    }
}

__device__ __forceinline__ unsigned q4_pack(float a, float b, float c, float d, float inv);
template <int MODE, int KK = DM> __device__ __forceinline__ void conv_int8_task(const float* W, int N, int n0, unsigned char* WQ, float* SB, LAS float* red, int tid) {
    constexpr int RPL = KK / 64;
    const int lane = tid & 63, wave = __builtin_amdgcn_readfirstlane(tid >> 6), c = lane & 7, kg = lane >> 3;
    const float* src = W + (size_t)(8 * RPL * wave + RPL * kg) * N + n0 + 4 * c;
    f32x4 v[RPL];
#pragma unroll
    for (int i = 0; i < RPL; ++i) v[i] = __builtin_nontemporal_load((const GAS f32x4*)(src + (size_t)i * N));
    f32x4 mx = (f32x4){0.f, 0.f, 0.f, 0.f};
#pragma unroll
    for (int i = 0; i < RPL; ++i) { mx[0] = fmaxf(mx[0], fabsf(v[i][0])); mx[1] = fmaxf(mx[1], fabsf(v[i][1])); mx[2] = fmaxf(mx[2], fabsf(v[i][2])); mx[3] = fmaxf(mx[3], fabsf(v[i][3])); }
#pragma unroll
    for (int o = 8; o < 64; o <<= 1) { mx[0] = fmaxf(mx[0], __shfl_xor(mx[0], o)); mx[1] = fmaxf(mx[1], __shfl_xor(mx[1], o)); mx[2] = fmaxf(mx[2], __shfl_xor(mx[2], o)); mx[3] = fmaxf(mx[3], __shfl_xor(mx[3], o)); }
    if (kg == 0) *(LAS f32x4*)(red + wave * 32 + 4 * c) = mx;
    __syncthreads();
#pragma unroll
    for (int w = 0; w < 8; ++w) { const f32x4 t = *(const LAS f32x4*)(red + w * 32 + 4 * c); mx[0] = fmaxf(mx[0], t[0]); mx[1] = fmaxf(mx[1], t[1]); mx[2] = fmaxf(mx[2], t[2]); mx[3] = fmaxf(mx[3], t[3]); }
#pragma unroll
    for (int qq = 0; qq < 4; ++qq) {
        const float m = mx[qq], inv = m > 0.f ? 127.0f / m : 0.f; const int row = conv_rowmap<MODE>(n0 + 4 * c + qq);
        if (wave == 0 && kg == 0) SB[row] = m * (1.0f / 127.0f);
        unsigned wds[RPL / 4];
#pragma unroll
        for (int d = 0; d < RPL / 4; ++d) wds[d] = q4_pack(v[4 * d][qq], v[4 * d + 1][qq], v[4 * d + 2][qq], v[4 * d + 3][qq], inv);
        GAS v4u* dst = (GAS v4u*)(WQ + (size_t)row * KK + 8 * RPL * wave + RPL * kg);
#pragma unroll
        for (int d = 0; d < RPL / 16; ++d) dst[d] = (v4u){wds[4 * d], wds[4 * d + 1], wds[4 * d + 2], wds[4 * d + 3]};
    }
    __syncthreads();
}
__device__ __forceinline__ unsigned q4_pack(float a, float b, float c, float d, float inv) {
    const float M = 12582912.0f;
    const unsigned b0 = __float_as_uint(fmaf(a, inv, M)), b1 = __float_as_uint(fmaf(b, inv, M)), b2 = __float_as_uint(fmaf(c, inv, M)), b3 = __float_as_uint(fmaf(d, inv, M));
    return __builtin_amdgcn_perm(__builtin_amdgcn_perm(b3, b2, 0x0c0c0400u), __builtin_amdgcn_perm(b1, b0, 0x0c0c0400u), 0x05040100u);
}
typedef __fp16 h2_t __attribute__((ext_vector_type(2)));
template <int MODE, int N> __device__ __forceinline__ int conv_int8_queue(Frame& F, const float* W, unsigned char* WQ, float* SB, int qword, int maxit = 0x7fffffff) {
    int tid = threadIdx.x; asm volatile("" : "+v"(tid)); const int lane = tid & 63, wave = __builtin_amdgcn_readfirstlane(tid >> 6), c = lane & 15, kg = lane >> 4;
    constexpr int NCB = N / 64, NTASK = NE * NCB;
    gu32* q = F.ctl + qword; LAS float* red = (LAS float*)(F.lds + 1024); LAS unsigned* tkw = (LAS unsigned*)(F.lds);
    if (tid == 0) tkw[0] = __hip_atomic_fetch_add(q, 1u, RLX_AGENT);
    __syncthreads();
    unsigned cur = tkw[0];
    const size_t loff = (size_t)(256 * wave + 64 * kg) * N + 4 * c;
    int it = 0;
    for (; it < maxit && cur < (unsigned)NTASK; ++it) {
        if (tid == 0 && it + 1 < maxit) tkw[(it + 1) & 1] = __hip_atomic_fetch_add(q, 1u, RLX_AGENT);
        const int e = (int)(cur / NCB), n0 = 64 * (int)(cur % NCB);
        const float* src = W + (size_t)e * DM * N + loff + n0;
        f32x4 v[40]; h2_t hlo[40][2];
        f32x4 mx = (f32x4){0.f, 0.f, 0.f, 0.f};
#pragma unroll
        for (int i = 0; i < 40; ++i) v[i] = __builtin_nontemporal_load((const GAS f32x4*)(src + (size_t)i * N));
#pragma unroll
        for (int i = 0; i < 40; ++i) { mx[0] = fmaxf(mx[0], fabsf(v[i][0])); mx[1] = fmaxf(mx[1], fabsf(v[i][1])); mx[2] = fmaxf(mx[2], fabsf(v[i][2])); mx[3] = fmaxf(mx[3], fabsf(v[i][3]));
            hlo[i][0] = __builtin_amdgcn_cvt_pkrtz(v[i][0], v[i][1]); hlo[i][1] = __builtin_amdgcn_cvt_pkrtz(v[i][2], v[i][3]); }
#pragma unroll
        for (int i = 0; i < 40; ++i) { asm volatile("" : "+v"(hlo[i][0]), "+v"(hlo[i][1])); }
        __builtin_amdgcn_sched_barrier(0);
#pragma unroll
        for (int i = 0; i < 24; ++i) v[i] = __builtin_nontemporal_load((const GAS f32x4*)(src + (size_t)(40 + i) * N));
#pragma unroll
        for (int i = 0; i < 24; ++i) { mx[0] = fmaxf(mx[0], fabsf(v[i][0])); mx[1] = fmaxf(mx[1], fabsf(v[i][1])); mx[2] = fmaxf(mx[2], fabsf(v[i][2])); mx[3] = fmaxf(mx[3], fabsf(v[i][3])); }
#pragma unroll
        for (int o = 16; o < 64; o <<= 1) { mx[0] = fmaxf(mx[0], __shfl_xor(mx[0], o)); mx[1] = fmaxf(mx[1], __shfl_xor(mx[1], o)); mx[2] = fmaxf(mx[2], __shfl_xor(mx[2], o)); mx[3] = fmaxf(mx[3], __shfl_xor(mx[3], o)); }
        if (kg == 0) *(LAS f32x4*)(red + wave * 64 + 4 * c) = mx;
        __syncthreads();
        const unsigned nxt = tkw[(it + 1) & 1];
#pragma unroll
        for (int w = 0; w < 8; ++w) { const f32x4 t = *(const LAS f32x4*)(red + w * 64 + 4 * c); mx[0] = fmaxf(mx[0], t[0]); mx[1] = fmaxf(mx[1], t[1]); mx[2] = fmaxf(mx[2], t[2]); mx[3] = fmaxf(mx[3], t[3]); }
#pragma unroll
        for (int qq = 0; qq < 4; ++qq) {
            const float m = mx[qq], inv = m > 0.f ? 127.0f / m : 0.f; const int row = conv_rowmap<MODE>(n0 + 4 * c + qq);
            if (wave == 0 && kg == 0) SB[(size_t)e * N + row] = m * (1.0f / 127.0f);
            GAS v4u* dst = (GAS v4u*)(WQ + ((size_t)e * N + row) * DM + 256 * wave + 64 * kg);
            unsigned wd[16];
#pragma unroll
            for (int d = 0; d < 10; ++d) wd[d] = q4_pack((float)hlo[4 * d][qq >> 1][qq & 1], (float)hlo[4 * d + 1][qq >> 1][qq & 1], (float)hlo[4 * d + 2][qq >> 1][qq & 1], (float)hlo[4 * d + 3][qq >> 1][qq & 1], inv);
#pragma unroll
            for (int d = 0; d < 6; ++d) wd[10 + d] = q4_pack(v[4 * d][qq], v[4 * d + 1][qq], v[4 * d + 2][qq], v[4 * d + 3][qq], inv);
            dst[0] = (v4u){wd[0], wd[1], wd[2], wd[3]}; dst[1] = (v4u){wd[4], wd[5], wd[6], wd[7]}; dst[2] = (v4u){wd[8], wd[9], wd[10], wd[11]}; dst[3] = (v4u){wd[12], wd[13], wd[14], wd[15]};
        }
        __syncthreads();
        cur = nxt;
    }
    __syncthreads();
    return it;
}
__device__ __forceinline__ int conv_up_int8_queue(Frame& F, const float* wup, int qword = CW_QUPQ, int maxit = 0x7fffffff) { return conv_int8_queue<2, 4096>(F, wup, F.ws + WS_WUP, (float*)(F.ws + WS_SB), qword, maxit); }

__device__ __forceinline__ void p0_phase(Frame& F, const float* c, const float* cc, const float* wada, const float* win, const float* woa, const float* wob, const float* wout) {
    int tid = threadIdx.x; asm volatile("" : "+v"(tid)); const int lane = tid & 63, wave = __builtin_amdgcn_readfirstlane(tid >> 6); (void)lane; (void)wave;
    float* MODP = (float*)(F.ws + WS_MODP);
    if (blockIdx.x < 192) {
        const int chunk = blockIdx.x % 48, kg = blockIdx.x / 48;
        LAS float* s = (LAS float*)(F.lds);
        LAS float* red = (LAS float*)(F.lds + 40960);
        for (int i = tid; i < 5 * 2048; i += NWAVES * 64) { const int b = i >> 11, k = i & 2047; const float v = b < 4 ? c[b * 2048 + k] : cc[k]; s[i] = v / (1.0f + __expf(-v)); }
        __syncthreads();
        const float* W = wada + (size_t)(kg * 512 + wave * 64) * MODW + chunk * 256 + 4 * lane;
        const LAS float* sk = s + kg * 512 + wave * 64;
        f32x4 acc[5];
#pragma unroll
        for (int b = 0; b < 5; ++b) acc[b] = (f32x4){0.f, 0.f, 0.f, 0.f};
#pragma unroll 16
        for (int k = 0; k < 64; ++k) { const f32x4 w = *(const GAS f32x4*)(W + (size_t)k * MODW);
#pragma unroll
            for (int b = 0; b < 5; ++b) acc[b] += w * sk[b * 2048 + k]; }
#pragma unroll
        for (int b = 0; b < 5; ++b) *(LAS f32x4*)(red + (wave * 5 + b) * 256 + 4 * lane) = acc[b];
        __syncthreads();
        for (int i = tid; i < 1280; i += NWAVES * 64) { const int b = i >> 8, ci = i & 255; float t = 0.f;
#pragma unroll
            for (int w = 0; w < 8; ++w) t += red[(w * 5 + b) * 256 + ci];
            MODP[(size_t)(kg * 5 + b) * MODW + chunk * 256 + ci] = t; }
        __syncthreads();
    }
    if (F.G == 256) {
        const int bx = (int)blockIdx.x;
        if (bx >= 192) { conv_int8_task<1>(win, PROJ, 32 * (2 * (bx - 192)), F.ws + WS_WIN, (float*)(F.ws + WS_SBIN), (LAS float*)(F.lds + 1024), tid); conv_int8_task<1>(win, PROJ, 32 * (2 * (bx - 192) + 1), F.ws + WS_WIN, (float*)(F.ws + WS_SBIN), (LAS float*)(F.lds + 1024), tid); }
        else if (bx < PROJ / 32 - 128) conv_int8_task<1>(win, PROJ, 32 * (128 + bx), F.ws + WS_WIN, (float*)(F.ws + WS_SBIN), (LAS float*)(F.lds + 1024), tid);
    } else
    for (int tk = blockIdx.x; tk < PROJ / 32; tk += F.G)
        conv_int8_task<1>(win, PROJ, 32 * tk, F.ws + WS_WIN, (float*)(F.ws + WS_SBIN), (LAS float*)(F.lds + 1024), tid);
}
__device__ __forceinline__ void conv_mixer_out(Frame& F, const float* woa, const float* wob, const float* wout, int blk, int nblk) {
    int tid = threadIdx.x; asm volatile("" : "+v"(tid)); const int lane = tid & 63, wave = __builtin_amdgcn_readfirstlane(tid >> 6);
    for (int tk = blk; tk < 128; tk += nblk) {
        if (tk < 64) conv_int8_task<0, 1024>(woa, DM, 32 * tk, F.ws + WS_WOA, (float*)(F.ws + WS_SBOA), (LAS float*)(F.lds + 1024), tid);
        else conv_int8_task<0, 1024>(wob, DM, 32 * (tk - 64), F.ws + WS_WOB, (float*)(F.ws + WS_SBOB), (LAS float*)(F.lds + 1024), tid);
    }
    for (int tk = blk; tk < 64; tk += nblk) conv_int8_task<0>(wout, DM, 32 * tk, F.ws + WS_WOUT, (float*)(F.ws + WS_SBOUT), (LAS float*)(F.lds + 1024), tid);
    (void)lane; (void)wave;
}
__device__ __forceinline__ void p1_phase(Frame& F, const float* bada) {
    int tid = threadIdx.x; asm volatile("" : "+v"(tid)); const int lane = tid & 63, wave = __builtin_amdgcn_readfirstlane(tid >> 6); (void)lane; (void)wave;
    const float* MODP = (const float*)(F.ws + WS_MODP); float* MOD = (float*)(F.ws + WS_MOD);
    for (int i = blockIdx.x * (NWAVES * 64) + tid; i < 5 * MODW; i += F.G * NWAVES * 64) { const int n = i % MODW;
        MOD[i] = bada[n] + ((MODP[i] + MODP[i + 5 * MODW]) + (MODP[i + 10 * MODW] + MODP[i + 15 * MODW])); }
}
__device__ __forceinline__ void p2_phase(Frame& F, const float* x, const float* ctx, const float* bada) {
    int tid = threadIdx.x; asm volatile("" : "+v"(tid)); const int lane = tid & 63, wave = __builtin_amdgcn_readfirstlane(tid >> 6); (void)lane; (void)wave;
    const float* MOD = (const float*)(F.ws + WS_MOD); unsigned* HQ = (unsigned*)(F.ws + WS_H); float* SH = (float*)(F.ws + WS_SH);
    LAS f32x4* mv = (LAS f32x4*)F.lds;
    {
        const GAS f32x4* P4 = (const GAS f32x4*)(F.ws + WS_MODP); const GAS f32x4* b4 = (const GAS f32x4*)bada; constexpr int Q = 5 * MODW / 4, RW = MODW / 4;
        for (int i = tid; i < 5 * 1024; i += NWAVES * 64) { const int o = (i >> 10) * RW + (i & 1023); mv[i] = b4[i & 1023] + ((P4[o] + P4[o + Q]) + (P4[o + 2 * Q] + P4[o + 3 * Q])); }
        GAS f32x4* M4 = (GAS f32x4*)(F.ws + WS_MOD);
        for (int i = blockIdx.x * (NWAVES * 64) + tid; i < Q; i += F.G * NWAVES * 64) M4[i] = b4[i % RW] + ((P4[i] + P4[i + Q]) + (P4[i + 2 * Q] + P4[i + 3 * Q]));
    }
    __syncthreads();
    const int gw = F.vcu * NWAVES + wave, NGW = F.G * NWAVES;
    f32x4 xn[8];
    if (gw < MH) { const GAS f32x4* x4 = (const GAS f32x4*)(gw < MT ? x + (size_t)gw * DM : ctx + (size_t)(gw - MT) * DM) + lane;
#pragma unroll
        for (int j = 0; j < 8; ++j) xn[j] = x4[64 * j]; }
    for (int m = gw; m < MH; m += NGW) {
        const int b = m < MT ? (m >> 12) : 4; const LAS f32x4* sh4 = mv + b * 1024 + lane; const LAS f32x4* sc4 = sh4 + 512;
        f32x4 o[8]; float amax = 0.f;
#pragma unroll
        for (int j = 0; j < 8; ++j) { o[j] = xn[j] * (sc4[64 * j] + 1.0f) + sh4[64 * j];
            amax = fmaxf(amax, fmaxf(fmaxf(fabsf(o[j][0]), fabsf(o[j][1])), fmaxf(fabsf(o[j][2]), fabsf(o[j][3])))); }
        const int m2 = m + NGW;
        if (m2 < MH) { const GAS f32x4* x4 = (const GAS f32x4*)(m2 < MT ? x + (size_t)m2 * DM : ctx + (size_t)(m2 - MT) * DM) + lane;
#pragma unroll
            for (int j = 0; j < 8; ++j) xn[j] = x4[64 * j]; }
#pragma unroll
        for (int q = 1; q < 64; q <<= 1) amax = fmaxf(amax, __shfl_xor(amax, q));
        const float qinv = amax > 0.f ? 127.0f / amax : 0.f;
        if (lane == 0) SH[m] = amax * (1.0f / 127.0f);
        GAS unsigned* ho = (GAS unsigned*)(HQ + (size_t)m * (DM / 4)) + lane;
#pragma unroll
        for (int j = 0; j < 8; ++j) ho[64 * j] = q4_pack(o[j][0], o[j][1], o[j][2], o[j][3], qinv);
    }
    __syncthreads();
}
struct CfgA { static constexpr int QP = 1024, KP = 1024, VP = 1024, OP = 2048; static constexpr bool MASK = false; };
struct CfgB { static constexpr int QP = 1024, KP = 128, VP = 128, OP = 1024; static constexpr bool MASK = true; };
__device__ __forceinline__ void p4_phase(Frame& F, char* lds_generic, const float* sinks, int rank, int W) {
    using abf = attn_body::bf16;
    const abf* QA = (const abf*)(F.ws + WS_QA); const abf* KA = (const abf*)(F.ws + WS_KA); const abf* VA = (const abf*)(F.ws + WS_VA);
    const abf* QB = (const abf*)(F.ws + WS_QB); const abf* KB = (const abf*)(F.ws + WS_KB); const abf* VB = (const abf*)(F.ws + WS_VB);
    abf* O4 = (abf*)(F.ws + WS_O4); abf* OB = (abf*)(F.ws + WS_OB);
    for (int u = rank; u < 1024; u += W) {
        const int b = u >> 8, h = (u >> 5) & 7, j = (u >> 4) & 1, qb = u & 15; const size_t qrow = (size_t)b * SEQ + qb * 256, krow = (size_t)b * KVR;
        attn_body::AttnArgs aa; aa.Qw0 = QA + qrow * 1024 + (2 * h + j) * 64; aa.Kh = KA + krow * 1024 + (2 * h + j) * 64; aa.Vh = VA + krow * 1024 + h * 128;
        aa.Ow0 = O4 + qrow * 2048 + (h * 2 + j) * 128; aa.NT = KVR / 64; aa.win0 = 0; aa.qpos0 = 0; aa.sinkl2 = 0.f;
        attn_body::attn_unit128<CfgA, 8>(aa, lds_generic);
    }
    for (int u = rank; u < 1024; u += W) {
        const int b = u >> 8, qh = (u >> 4) & 15, qb = u & 15, kvh = qh >> 3; const size_t qrow = (size_t)b * SEQ + qb * 256, krow = (size_t)b * KVR;
        const int w0 = qb == 0 ? 0 : 256 * qb - 128, w1 = qb == 15 ? SEQ : 256 * qb + 384;
        attn_body::AttnArgs aa; aa.Qw0 = QB + qrow * 1024 + qh * 64; aa.Kh = KB + krow * 128 + kvh * 64; aa.Vh = VB + krow * 128 + kvh * 64; aa.Ow0 = OB + qrow * 1024 + qh * 64;
        aa.NT = 4 + (w1 - w0) / 64; aa.win0 = w0; aa.qpos0 = 256 * qb; aa.sinkl2 = sinks[qh] * 1.4426950408889634f;
        attn_body::attn_unit<CfgB, 8>(aa, lds_generic);
    }
}
__device__ __forceinline__ void p4c_phase(Frame& F, const float* lq1, const float* lk1, const float* lq2, const float* lk2, const float* subw) {
    int tid = threadIdx.x; asm volatile("" : "+v"(tid)); const int lane = tid & 63, wave = __builtin_amdgcn_readfirstlane(tid >> 6);
    const bf16* O4 = (const bf16*)(F.ws + WS_O4); unsigned char* OA = F.ws + WS_OA; float* SOA = (float*)(F.ws + WS_SOA);
    const bf16* OB = (const bf16*)(F.ws + WS_OB); unsigned char* OBQ = F.ws + WS_OBQ; float* SOB = (float*)(F.ws + WS_SOB);
    float lam; { const float a1 = lq1[lane] * lk1[lane], a2 = lq2[lane] * lk2[lane]; lam = __expf(wave_sum(a1)) - __expf(wave_sum(a2)) + LAM_INIT; }
    const int h = lane >> 3, part = lane & 7; float sw[16];
#pragma unroll
    for (int i = 0; i < 16; ++i) sw[i] = subw[part * 16 + i] * (1.0f - LAM_INIT);
    const int gw = F.vcu * NWAVES + wave, NGW = F.G * NWAVES;
    v4u na0, na1, nb0, nb1, nc0, nc1;
#define P4C_LOAD(mm) do { const GAS v4u* o0_ = (const GAS v4u*)(O4 + (size_t)(mm) * 2048 + h * 256 + part * 16); const GAS v4u* o1_ = (const GAS v4u*)(O4 + (size_t)(mm) * 2048 + h * 256 + 128 + part * 16); \
        const GAS v4u* bp_ = (const GAS v4u*)(OB + (size_t)(mm) * 1024 + lane * 16); na0 = o0_[0]; na1 = o0_[1]; nb0 = o1_[0]; nb1 = o1_[1]; nc0 = bp_[0]; nc1 = bp_[1]; } while (0)
    if (gw < MT) P4C_LOAD(gw);
    for (int m = gw; m < MT; m += NGW) {
        const v4u a0 = na0, a1 = na1, b0 = nb0, b1 = nb1, c0 = nc0, c1 = nc1;
        const unsigned aw[8] = {a0.x, a0.y, a0.z, a0.w, a1.x, a1.y, a1.z, a1.w}, bw[8] = {b0.x, b0.y, b0.z, b0.w, b1.x, b1.y, b1.z, b1.w};
        float d[16]; float ss = 0.f;
#pragma unroll
        for (int q = 0; q < 8; ++q) { d[2 * q] = pg8::bf_lo(aw[q]) - lam * pg8::bf_lo(bw[q]); d[2 * q + 1] = pg8::bf_hi(aw[q]) - lam * pg8::bf_hi(bw[q]); ss += d[2 * q] * d[2 * q] + d[2 * q + 1] * d[2 * q + 1]; }
        ss += __shfl_xor(ss, 1); ss += __shfl_xor(ss, 2); ss += __shfl_xor(ss, 4);
        const float rs = 1.0f / sqrtf(ss * (1.0f / 128.0f) + LN_EPS);
        float amax = 0.f;
#pragma unroll
        for (int q = 0; q < 16; ++q) { d[q] = d[q] * rs * sw[q]; amax = fmaxf(amax, fabsf(d[q])); }
        const unsigned cw[8] = {c0.x, c0.y, c0.z, c0.w, c1.x, c1.y, c1.z, c1.w}; float e[16]; float bmax = 0.f;
#pragma unroll
        for (int q = 0; q < 8; ++q) { e[2 * q] = pg8::bf_lo(cw[q]); e[2 * q + 1] = pg8::bf_hi(cw[q]); bmax = fmaxf(bmax, fmaxf(fabsf(e[2 * q]), fabsf(e[2 * q + 1]))); }
#pragma unroll
        for (int o = 1; o < 64; o <<= 1) { amax = fmaxf(amax, __shfl_xor(amax, o)); bmax = fmaxf(bmax, __shfl_xor(bmax, o)); }
        const float ai = amax > 0.f ? 127.0f / amax : 0.f, bi = bmax > 0.f ? 127.0f / bmax : 0.f;
        if (m + NGW < MT) P4C_LOAD(m + NGW);
        if (lane == 0) { SOA[m] = amax * (1.0f / 127.0f); SOB[m] = bmax * (1.0f / 127.0f); }
        *(GAS v4u*)(OA + (size_t)m * 1024 + h * 128 + part * 16) = (v4u){q4_pack(d[0], d[1], d[2], d[3], ai), q4_pack(d[4], d[5], d[6], d[7], ai), q4_pack(d[8], d[9], d[10], d[11], ai), q4_pack(d[12], d[13], d[14], d[15], ai)};
        *(GAS v4u*)(OBQ + (size_t)m * 1024 + lane * 16) = (v4u){q4_pack(e[0], e[1], e[2], e[3], bi), q4_pack(e[4], e[5], e[6], e[7], bi), q4_pack(e[8], e[9], e[10], e[11], bi), q4_pack(e[12], e[13], e[14], e[15], bi)};
    }
}
#undef P4C_LOAD
__device__ __forceinline__ void p7_phase(Frame& F, const float* g1n, const float* b1n, const float* wrt, const float* brt) {
    int tid = threadIdx.x; asm volatile("" : "+v"(tid)); const int lane = tid & 63, wave = __builtin_amdgcn_readfirstlane(tid >> 6); (void)lane; (void)wave;
    typedef float f32x16 __attribute__((ext_vector_type(16)));
    const float* R = (const float*)(F.ws + WS_R); float* STATS = (float*)(F.ws + WS_STATS); unsigned* HMQ = (unsigned*)(F.ws + WS_HM); float* SA = (float*)(F.ws + WS_SA);     const float* MOD = (const float*)(F.ws + WS_MOD);
    int* PSLOT = (int*)(F.ws + WS_PSLOT); float* PGATE = (float*)(F.ws + WS_PGATE);
    LAS float* part = (LAS float*)F.lds;
    LAS float* lg = (LAS float*)(F.lds + 34816);
    LAS int* cntL = (LAS int*)(F.lds + 40960);
    LAS int* baseL = cntL + 32;
    LAS float* stL = (LAS float*)(F.lds + 41472);
    LAS f32x4* vecL = (LAS f32x4*)(F.lds + 49152);
    for (int tile = blockIdx.x; tile < MT / 32; tile += F.G) {
        const int R0 = tile * 32; const float* modb = MOD + (size_t)(R0 >> 12) * MODW;
        if (tid < 32) cntL[tid] = 0;
        for (int i = tid; i < 2048; i += NWAVES * 64) { const int w = i >> 9, d = i & 511; const float* src = w == 0 ? g1n : w == 1 ? b1n : w == 2 ? modb + 4 * DM : modb + 3 * DM; vecL[i] = ((const GAS f32x4*)src)[d]; }
        f32x4 vv[4][8];
#pragma unroll
        for (int i = 0; i < 4; ++i) { const GAS f32x4* r4 = (const GAS f32x4*)(R + (size_t)(R0 + 4 * wave + i) * DM) + lane;
#pragma unroll
            for (int j = 0; j < 8; ++j) vv[i][j] = r4[64 * j]; }
        __syncthreads();
#pragma unroll
        for (int i = 0; i < 4; ++i) {
            const size_t row = R0 + 4 * wave + i;
            f32x4 v[8]; float s = 0.f;
#pragma unroll
            for (int j = 0; j < 8; ++j) { v[j] = vv[i][j]; s += (v[j][0] + v[j][1]) + (v[j][2] + v[j][3]); }
            const float mean = wave_sum(s) * (1.0f / DM); float s2 = 0.f;
#pragma unroll
            for (int j = 0; j < 8; ++j) { v[j] = v[j] - mean; s2 += (v[j][0] * v[j][0] + v[j][1] * v[j][1]) + (v[j][2] * v[j][2] + v[j][3] * v[j][3]); }
            const float rstd = 1.0f / sqrtf(wave_sum(s2) * (1.0f / DM) + LN_EPS);
            if (lane == 0) { STATS[row * 2] = mean; STATS[row * 2 + 1] = rstd; stL[(4 * wave + i) * 2] = mean; stL[(4 * wave + i) * 2 + 1] = rstd; }
            float amax = 0.f;
#pragma unroll
            for (int j = 0; j < 8; ++j) { const int d4 = lane + 64 * j;
                const f32x4 g = vecL[d4], bb = vecL[512 + d4], sc = vecL[1024 + d4], sh = vecL[1536 + d4];
                const f32x4 x1 = v[j] * rstd * g + bb; v[j] = x1 * (sc + 1.0f) + sh;
                amax = fmaxf(amax, fmaxf(fmaxf(fabsf(v[j][0]), fabsf(v[j][1])), fmaxf(fabsf(v[j][2]), fabsf(v[j][3])))); }
#pragma unroll
            for (int o = 1; o < 64; o <<= 1) amax = fmaxf(amax, __shfl_xor(amax, o));
            const float qinv = amax > 0.f ? 127.0f / amax : 0.f;
            if (lane == 0) SA[row] = amax * (1.0f / 127.0f);
            GAS unsigned* ho = (GAS unsigned*)(HMQ + row * (DM / 4)) + lane;
#pragma unroll
            for (int j = 0; j < 8; ++j) ho[64 * j] = q4_pack(v[j][0], v[j][1], v[j][2], v[j][3], qinv);
        }
        VM_WAIT(); __syncthreads();
        {
            const int rw = lane & 31, hf = lane >> 5;
            const float* xr = R + (size_t)(R0 + rw) * DM + 256 * wave + 4 * hf; const float mu = stL[rw * 2], rs = stL[rw * 2 + 1];
            const float* wp = wrt + (size_t)(256 * wave + 4 * hf) * NE + rw;
            const LAS f32x4* vl = vecL + 64 * wave + hf;
            f32x16 acc;
#pragma unroll
            for (int q = 0; q < 16; ++q) acc[q] = 0.f;
#pragma unroll 8
            for (int c = 0; c < 32; ++c) {
                const f32x4 r4 = *(const GAS f32x4*)(xr + 8 * c), g4 = vl[2 * c], b4 = vl[512 + 2 * c], s4 = vl[1024 + 2 * c], h4 = vl[1536 + 2 * c];
                const f32x4 x4 = (r4 - mu) * rs * g4 + b4; const f32x4 hm = x4 * (s4 + 1.0f) + h4;
#pragma unroll
                for (int i = 0; i < 4; ++i) acc = __builtin_amdgcn_mfma_f32_32x32x2f32(hm[i], wp[(size_t)(8 * c + i) * NE], acc, 0, 0, 0);
            }
#pragma unroll
            for (int q = 0; q < 16; ++q) part[(wave * 32 + (q & 3) + 8 * (q >> 2) + 4 * hf) * 33 + rw] = acc[q];
        }
        __syncthreads();
        for (int p = tid; p < 1024; p += NWAVES * 64) { const int rr = p >> 5, e = p & 31; float t = brt[e];
#pragma unroll
            for (int w = 0; w < 8; ++w) t += part[(w * 32 + rr) * 33 + e];
            lg[rr * 33 + e] = t; }
        __syncthreads();
        int sel0 = 0, sel1 = 0, sel2 = 0, sel3 = 0, lr0 = 0, lr1 = 0, lr2 = 0, lr3 = 0; float gt0 = 0.f, gt1 = 0.f, gt2 = 0.f, gt3 = 0.f;
        if (tid < 32) {
            float val[4]; int sel[4];
#pragma unroll
            for (int k = 0; k < 4; ++k) { float best = -INFINITY; int bi = 0;
                for (int e = 0; e < NE; ++e) { const float vv = lg[tid * 33 + e]; if (vv > best) { best = vv; bi = e; } }
                sel[k] = bi; val[k] = best; lg[tid * 33 + bi] = -INFINITY; }
            const float p1 = __expf(val[1] - val[0]), p2 = __expf(val[2] - val[0]), p3 = __expf(val[3] - val[0]); const float inv = 1.0f / (1.0f + p1 + p2 + p3);
            gt0 = inv; gt1 = p1 * inv; gt2 = p2 * inv; gt3 = p3 * inv;
            sel0 = sel[0]; sel1 = sel[1]; sel2 = sel[2]; sel3 = sel[3];
            lr0 = atomicAdd((int*)(cntL + sel0), 1); lr1 = atomicAdd((int*)(cntL + sel1), 1); lr2 = atomicAdd((int*)(cntL + sel2), 1); lr3 = atomicAdd((int*)(cntL + sel3), 1);
        }
        __syncthreads();
        if (tid < 32) { const int cl = cntL[tid]; baseL[tid] = cl ? (int)__hip_atomic_fetch_add((unsigned*)(F.ctl + CW_CNT + tid), (unsigned)cl, __ATOMIC_RELAXED, __HIP_MEMORY_SCOPE_AGENT) : 0; }
        __syncthreads();
        if (tid < 32) { const int a0 = (R0 + tid) * 4;
            const int v0 = sel0 * 16384 + ((baseL[sel0] + lr0) & 16383), v1 = sel1 * 16384 + ((baseL[sel1] + lr1) & 16383), v2 = sel2 * 16384 + ((baseL[sel2] + lr2) & 16383), v3 = sel3 * 16384 + ((baseL[sel3] + lr3) & 16383);
            PSLOT[v0] = a0; PSLOT[v1] = a0 + 1; PSLOT[v2] = a0 + 2; PSLOT[v3] = a0 + 3; *(GAS v4u*)((int*)(F.ws + WS_INV) + a0) = (v4u){(unsigned)v0, (unsigned)v1, (unsigned)v2, (unsigned)v3}; PGATE[v0] = gt0; PGATE[v1] = gt1; PGATE[v2] = gt2; PGATE[v3] = gt3; }
        __syncthreads();
    }
}
__device__ __forceinline__ void p8_phase(Frame& F) {
    int tid = threadIdx.x; asm volatile("" : "+v"(tid)); const int lane = tid & 63, wave = __builtin_amdgcn_readfirstlane(tid >> 6); (void)lane; (void)wave;
    LAS int* cnt = (LAS int*)(F.lds + TBL_OFF); LAS int* pstart = cnt + 32; LAS int* nmt = cnt + 96; LAS int* mt_e = cnt + 128;
    if (tid < 32) cnt[tid] = (int)__hip_atomic_load((unsigned*)(F.ctl + CW_CNT + tid), RLX_AGENT);
    __syncthreads();
    if (tid == 0) { int acc = 0, nt = 0;
        for (int e = 0; e < NE; ++e) { pstart[e] = acc; const int t = (cnt[e] + 255) >> 8; for (int j = 0; j < t && nt < MAXMT; ++j) mt_e[nt++] = e; acc += t * 256; }
        pstart[32] = acc; nmt[0] = nt; }
    __syncthreads();
}
__device__ __forceinline__ unsigned requant4(unsigned w, float ratio) {
    return pg8::q4p((float)(int)(signed char)(w & 255u), (float)(int)(signed char)((w >> 8) & 255u), (float)(int)(signed char)((w >> 16) & 255u), (float)((int)w >> 24), ratio);
}
__device__ __forceinline__ void p9b_phase(Frame& F, int nrows, const float* RMAXP, unsigned char* ACTQ, float* SACT) {
    int tid = threadIdx.x; asm volatile("" : "+v"(tid)); const int lane = tid & 63, wave = __builtin_amdgcn_readfirstlane(tid >> 6);
    const int gw = F.vcu * NWAVES + wave, NGW = F.G * NWAVES;
    float nml = 0.f; v4u nw0 = (v4u){0u, 0u, 0u, 0u}, nw1 = nw0;
#define P9B_LOAD(rr) do { nml = RMAXP[(size_t)(rr) * 64 + lane]; const GAS v4u* p_ = (const GAS v4u*)(ACTQ + (size_t)(rr) * DM) + 2 * lane; nw0 = p_[0]; nw1 = p_[1]; } while (0)
    if (gw < nrows) P9B_LOAD(gw);
    for (int r = gw; r < nrows; r += NGW) {
        float ml = nml; const v4u w0 = nw0, w1 = nw1;
        GAS v4u* p = (GAS v4u*)(ACTQ + (size_t)r * DM) + 2 * lane;
        if (!(ml < 1e30f)) ml = 0.f;
        float mx = ml;
#pragma unroll
        for (int o = 1; o < 64; o <<= 1) mx = fmaxf(mx, __shfl_xor(mx, o));
        const float ratio = mx > 0.f ? ml / mx : 0.f;
        const v4u o0 = (v4u){requant4(w0.x, ratio), requant4(w0.y, ratio), requant4(w0.z, ratio), requant4(w0.w, ratio)}, o1 = (v4u){requant4(w1.x, ratio), requant4(w1.y, ratio), requant4(w1.z, ratio), requant4(w1.w, ratio)};
        if (r + NGW < nrows) P9B_LOAD(r + NGW);
        if (lane == 0) SACT[r] = mx * (1.0f / 127.0f);
        p[0] = o0; p[1] = o1;
    }
#undef P9B_LOAD
}
__device__ __forceinline__ void p11_phase(Frame& F, const float* g1n, const float* b1n, const float* g2n, const float* b2n) {
    int tid = threadIdx.x; asm volatile("" : "+v"(tid)); const int lane0 = tid & 63, wave = __builtin_amdgcn_readfirstlane(tid >> 6); (void)wave;
    const float* R = (const float*)(F.ws + WS_R); const float* STATS = (const float*)(F.ws + WS_STATS); const bf16* YS = (const bf16*)(F.ws + WS_YSG); const float* MOD = (const float*)(F.ws + WS_MOD);
    const int* INV = (const int*)(F.ws + WS_INV); const LAS int* t_ps = (const LAS int*)(F.lds + TBL_OFF) + 32;
    LAS f32x4* vec = (LAS f32x4*)F.lds;
    for (int i = tid; i < 4096; i += NWAVES * 64) { const int w = i >> 9, d = i & 511; const float* src = w == 0 ? g1n : w == 1 ? b1n : w == 2 ? g2n : w == 3 ? b2n : MOD + (size_t)(w - 4) * MODW + 5 * DM; vec[i] = ((const GAS f32x4*)src)[d]; }
    __syncthreads();
    const int gw = F.vcu * NWAVES + wave, NGW = F.G * NWAVES;
    f32x4 nv[8]; u32x2 nyw[4][8]; float nmu = 0.f, nrs = 0.f; int iv[4] = {0, 0, 0, 0};
#define P11_INV(mm) do { _Pragma("unroll") for (int k_ = 0; k_ < 4; ++k_) iv[k_] = INV[4 * (mm) + k_]; } while (0)
#define P11_LOAD(mm) do { int ln_ = lane0; asm volatile("" : "+v"(ln_)); const GAS f32x4* x4_ = (const GAS f32x4*)(R + (size_t)(mm) * DM) + ln_; nmu = STATS[(size_t)(mm) * 2]; nrs = STATS[(size_t)(mm) * 2 + 1]; \
        const GAS u32x2* y8_[4]; _Pragma("unroll") for (int k_ = 0; k_ < 4; ++k_) { const int v_ = __builtin_amdgcn_readfirstlane(iv[k_]); y8_[k_] = (const GAS u32x2*)(YS + (size_t)(t_ps[v_ >> 14] + (v_ & 16383)) * DM) + ln_; } \
        _Pragma("unroll") for (int j_ = 0; j_ < 8; ++j_) { nv[j_] = x4_[64 * j_]; _Pragma("unroll") for (int k_ = 0; k_ < 4; ++k_) nyw[k_][j_] = y8_[k_][64 * j_]; } } while (0)
    if (gw < MT) { P11_INV(gw); P11_LOAD(gw); if (gw + NGW < MT) P11_INV(gw + NGW); }
    for (int m = gw; m < MT; m += NGW) {
        int lane = lane0; asm volatile("" : "+v"(lane));
        const float mu = nmu, rs = nrs; const LAS f32x4* g2v = vec + 2048 + (m >> 12) * 512;
        f32x4 v[8]; float s = 0.f;
#pragma unroll
        for (int j = 0; j < 8; ++j) { f32x4 mo = (f32x4){0.f, 0.f, 0.f, 0.f};
#pragma unroll
            for (int k = 0; k < 4; ++k) { const u32x2 w = nyw[k][j]; mo += (f32x4){pg8::bf_lo(w.x), pg8::bf_hi(w.x), pg8::bf_lo(w.y), pg8::bf_hi(w.y)}; }
            const f32x4 x1 = (nv[j] - mu) * rs * vec[lane + 64 * j] + vec[512 + lane + 64 * j];
            v[j] = x1 * DN_ALPHA + g2v[lane + 64 * j] * mo; s += (v[j][0] + v[j][1]) + (v[j][2] + v[j][3]);
            if (j & 1) __builtin_amdgcn_sched_barrier(0); }
        const float mean = wave_sum(s) * (1.0f / DM); float s2 = 0.f;
#pragma unroll
        for (int j = 0; j < 8; ++j) { v[j] = v[j] - mean; s2 += (v[j][0] * v[j][0] + v[j][1] * v[j][1]) + (v[j][2] * v[j][2] + v[j][3] * v[j][3]); }
        const float rstd = 1.0f / sqrtf(wave_sum(s2) * (1.0f / DM) + LN_EPS);
        if (m + NGW < MT) { P11_LOAD(m + NGW); if (m + 2 * NGW < MT) P11_INV(m + 2 * NGW); }
        __builtin_amdgcn_sched_barrier(0);
        GAS f32x4* o4 = (GAS f32x4*)(F.out + (size_t)m * DM) + lane;
#pragma unroll
        for (int j = 0; j < 8; ++j) o4[64 * j] = v[j] * rstd * vec[1024 + lane + 64 * j] + vec[1536 + lane + 64 * j];
    }
#undef P11_INV
#undef P11_LOAD
}

#ifndef PROBE
#define PROBE 0
#endif
struct Args { const float* in[26]; float* out; unsigned char* ws; };
__global__ void __launch_bounds__(NWAVES * 64, 2) mega_fwd(Args args) {
    extern __shared__ __attribute__((aligned(16))) unsigned char lds[];
    Frame F;
    F.lds = (LAS unsigned char*)lds;
    F.MISC = (volatile LAS unsigned*)(F.lds + MISC_OFF);
    F.tid = threadIdx.x; F.lane = F.tid & 63; F.wave = __builtin_amdgcn_readfirstlane(F.tid >> 6);
    F.G = gridDim.x; { const int bx = blockIdx.x; F.vcu = (F.G % 8 == 0) ? (bx % 8) * (F.G / 8) + bx / 8 : bx; }
    F.ws = args.ws; F.ctl = (gu32*)(args.ws + WS_CTL); F.out = args.out;
    for (int u = F.tid; u < (LDS_BYTES - LDSCTL_OFF) / 4; u += NWAVES * 64) ((LAS unsigned*)(F.lds + LDSCTL_OFF))[u] = 0u;
    __syncthreads();
    XcdBarrier bar = xcd_barrier_post((unsigned*)(F.ctl + CW_BAR), F.MISC + 8);
#define GRID_BAR() xcd_barrier(bar)
    unsigned char* ws = args.ws;
    pg8::bf16_t* WIN = (pg8::bf16_t*)(ws + WS_WIN);

    p0_phase(F, args.in[1], args.in[3], args.in[4], args.in[6], args.in[13], args.in[14], args.in[15]); GRID_BAR();
    p2_phase(F, args.in[0], args.in[2], args.in[5]); GRID_BAR();
    const bool split = (F.G == 256); const int NWRK = split ? NWORK : F.G; const bool conv_role = split && (int)blockIdx.x >= NWORK;
    if (conv_role) (void)xcd_barrier_arrive(bar);
    else {
        pg8::Gemm g{(const pg8::bf16_t*)(ws + WS_H), WIN, MH, PROJ, DM / 2}; pg8::InProjOrder S{NWRK, (int)blockIdx.x};
        pg8::EpiInProj E{(const float*)(ws + WS_SH), (const float*)(ws + WS_SBIN), (pg8::bf16_t*)(ws + WS_QA), (pg8::bf16_t*)(ws + WS_KA), (pg8::bf16_t*)(ws + WS_VA), (pg8::bf16_t*)(ws + WS_QB), (pg8::bf16_t*)(ws + WS_KB), (pg8::bf16_t*)(ws + WS_VB),
                          (pg8::bf16_t*)(ws + WS_GA), (pg8::bf16_t*)(ws + WS_GB), attn_body::C2, (LAS float*)(F.lds + TOK_OFF)};
        pg8::gemm_phase<pg8::EpiInProj, pg8::InProjOrder, PG8_ALIGN, PG8_SP2>(F.lds + RING_OFF, g, S, E);
    }
    if (conv_role) { conv_mixer_out(F, args.in[13], args.in[14], args.in[15], (int)blockIdx.x - NWORK, F.G - NWORK);
        conv_up_int8_queue(F, args.in[20]); conv_int8_queue<0, 2048>(F, args.in[22], F.ws + WS_WDN, (float*)(F.ws + WS_SBD), CW_QDNQ); xcd_barrier_wait(bar); }
    else if (split) {
        (void)xcd_barrier_arrive(bar);
        for (;;) {
            if (xcd_barrier_test(bar)) break;
            int done = conv_up_int8_queue(F, args.in[20], CW_QUPQ, 1);
            if (!done) done = conv_int8_queue<0, 2048>(F, args.in[22], F.ws + WS_WDN, (float*)(F.ws + WS_SBD), CW_QDNQ, 1);
            if (!done) { xcd_barrier_wait(bar); break; }
        }
    } else GRID_BAR();
    if (!conv_role) p4_phase(F, (char*)lds + RING_OFF, args.in[12], split ? (int)((blockIdx.x & 7) * (NWORK / 8) + (blockIdx.x >> 3)) : F.vcu, NWRK);
    if (!split) conv_mixer_out(F, args.in[13], args.in[14], args.in[15], (int)blockIdx.x, F.G);
    conv_up_int8_queue(F, args.in[20]);
    conv_int8_queue<0, 2048>(F, args.in[22], F.ws + WS_WDN, (float*)(F.ws + WS_SBD), CW_QDNQ);
    GRID_BAR();
    p4c_phase(F, args.in[7], args.in[8], args.in[9], args.in[10], args.in[11]);
    GRID_BAR();
    {
        pg8::Gemm g{(const pg8::bf16_t*)(ws + WS_OA), (const pg8::bf16_t*)(ws + WS_WOA), MT, DM, 512}; pg8::StaticOrder S; S.init(MT, DM, F.G, (int)blockIdx.x);
        pg8::EpiGate1Q E{(const pg8::bf16_t*)(ws + WS_GA), (float*)(ws + WS_Y1), (const float*)(ws + WS_SOA), (const float*)(ws + WS_SBOA), (LAS float*)(F.lds + TOK_OFF)};
        pg8::gemm_phase<pg8::EpiGate1Q, pg8::StaticOrder, PG8_ALIGN, PG8_SP2>(F.lds + RING_OFF, g, S, E);
    }
    VM_WAIT(); __syncthreads();
    {
        pg8::Gemm g{(const pg8::bf16_t*)(ws + WS_OBQ), (const pg8::bf16_t*)(ws + WS_WOB), MT, DM, 512}; pg8::StaticOrder S; S.init(MT, DM, F.G, (int)blockIdx.x);
        pg8::EpiGate2Q E{(const pg8::bf16_t*)(ws + WS_GB), (const float*)(ws + WS_Y1), ws + WS_Y, (float*)(ws + WS_RMAXY), (const float*)(ws + WS_SOB), (const float*)(ws + WS_SBOB), (LAS float*)(F.lds + TOK_OFF)};
        pg8::gemm_phase<pg8::EpiGate2Q, pg8::StaticOrder, PG8_ALIGN, PG8_SP2>(F.lds + RING_OFF, g, S, E);
    }
    GRID_BAR();
    {
        p9b_phase(F, MT, (const float*)(ws + WS_RMAXY), ws + WS_Y, (float*)(ws + WS_SY)); GRID_BAR();
        pg8::Gemm g{(const pg8::bf16_t*)(ws + WS_Y), (const pg8::bf16_t*)(ws + WS_WOUT), MT, DM, DM / 2}; pg8::StaticOrder S; S.init(MT, DM, F.G, (int)blockIdx.x);
        pg8::EpiOutQ E{args.in[0], (const float*)(ws + WS_MOD), (float*)(ws + WS_R), DN_ALPHA, (const float*)(ws + WS_SY), (const float*)(ws + WS_SBOUT), (LAS float*)(F.lds + TOK_OFF)};
        pg8::gemm_phase<pg8::EpiOutQ, pg8::StaticOrder, PG8_ALIGN, PG8_SP2>(F.lds + RING_OFF, g, S, E);
    }
    GRID_BAR();
    p7_phase(F, args.in[16], args.in[17], args.in[18], args.in[19]); GRID_BAR();
    p8_phase(F);
    const LAS int* t_cnt = (const LAS int*)(F.lds + TBL_OFF); const LAS int* t_pstart = t_cnt + 32; const LAS int* t_mte = t_cnt + 128; const int nMt = t_cnt[96];
    {
        pg8::Gemm g{(const pg8::bf16_t*)(ws + WS_HM), (const pg8::bf16_t*)(ws + WS_WUP), MT, NE * 4096, DM / 2}; pg8::MoeOrder S;     S.init(nMt, 16, F.G, (int)blockIdx.x, t_mte, t_cnt, t_pstart); S.mode = 1; pg8::MoeOrder S2 = S; S2.mode = 2;
        LAS unsigned short* tokl = (LAS unsigned short*)(F.lds + TOK_OFF); LAS float* sclL = (LAS float*)(F.lds + TOK_OFF + 9216);
        if (F.wave < 4) {
            const int* PSL = (const int*)(ws + WS_PSLOT); const float* SAp = (const float*)(ws + WS_SA); int tl_ = threadIdx.x; asm volatile("" : "+v"(tl_));
            int tkv[18]; bool okv[18];
#pragma unroll
            for (int i = 0; i < 18; ++i) { pg8::Unit u; u.pm = 0; bool has = S.next(i, u); if (!has && i == S.nwg / S.G) has = S2.next(0, u); const int pm = has ? u.pm : 0, e = t_mte[pm], q = pm * 256 + tl_ - t_pstart[e];
                okv[i] = has && q < t_cnt[e]; tkv[i] = PSL[okv[i] ? e * 16384 + q : 0]; }
            float sav[18];
#pragma unroll
            for (int i = 0; i < 18; ++i) { tkv[i] = okv[i] ? ((tkv[i] >> 2) & 16383) : 0; sav[i] = SAp[tkv[i]]; }
#pragma unroll
            for (int i = 0; i < 18; ++i) { tokl[i * 256 + tl_] = (unsigned short)tkv[i]; sclL[i * 256 + tl_] = okv[i] ? sav[i] : 0.f; }
        }
        __syncthreads();
        pg8::EpiUpQ E{args.in[21], ws + WS_ACTQ, (const float*)(ws + WS_SA), (const float*)(ws + WS_SB), (const int*)(ws + WS_PSLOT), t_cnt, t_pstart, (float*)(ws + WS_RMAXP), sclL, (LAS float*)(F.lds + EPL_OFF)};
        pg8::gemm_phase<pg8::EpiUpQ, pg8::MoeOrder, PG8_ALIGN, PG8_SP2, true, false>(F.lds + RING_OFF, g, S, E, tokl);
        pg8::gemm_phase<pg8::EpiUpQ, pg8::MoeOrder, PG8_ALIGN, PG8_SP2, true, true>(F.lds + RING_OFF, g, S2, E, tokl);
    }
    GRID_BAR();
    {
        p9b_phase(F, nMt * 256, (const float*)(ws + WS_RMAXP), ws + WS_ACTQ, (float*)(ws + WS_SACT)); GRID_BAR();
        pg8::Gemm g{(const pg8::bf16_t*)(ws + WS_ACTQ), (const pg8::bf16_t*)(ws + WS_WDN), MAXMT * 256, NE * DM, DM / 2}; pg8::MoeOrder S; S.init(nMt, 8, F.G, (int)blockIdx.x, t_mte, t_cnt, t_pstart); S.mode = 1; pg8::MoeOrder S2 = S; S2.mode = 2;
        pg8::EpiDownQ E{args.in[23], (pg8::bf16_t*)(ws + WS_YSG), (const int*)(ws + WS_PSLOT), (const float*)(ws + WS_PGATE), t_cnt, t_pstart, (const float*)(ws + WS_SACT), (const float*)(ws + WS_SBD), (LAS float*)(F.lds + TOK_OFF)};
        pg8::gemm_phase<pg8::EpiDownQ, pg8::MoeOrder, PG8_ALIGN, PG8_SP2, false, false>(F.lds + RING_OFF, g, S, E);
        pg8::gemm_phase<pg8::EpiDownQ, pg8::MoeOrder, PG8_ALIGN, PG8_SP2, false, true>(F.lds + RING_OFF, g, S2, E);
    }
    GRID_BAR();
#if PROBE == 3 || PROBE == 4
    {
        pg8::Gemm g{(const pg8::bf16_t*)(ws + WS_HM), (const pg8::bf16_t*)(ws + WS_WUP), MT, NE * 4096, DM / 2}; pg8::MoeOrder S;     S.init(nMt, 16, F.G, (int)blockIdx.x, t_mte, t_cnt, t_pstart);
        LAS unsigned short* tokl = (LAS unsigned short*)(F.lds + TOK_OFF); LAS float* sclL = (LAS float*)(F.lds + TOK_OFF + 9216);
        { const int* PSL = (const int*)(ws + WS_PSLOT); pg8::Unit u;
          for (int i = 0; i < 18 && S.next(i, u); ++i) if (F.tid < 256) { const int e = t_mte[u.pm], q = u.pm * 256 + F.tid - t_pstart[e];
              const int tk = q < t_cnt[e] ? ((PSL[e * 16384 + q] >> 2) & 16383) : 0; tokl[i * 256 + F.tid] = (unsigned short)tk; sclL[i * 256 + F.tid] = q < t_cnt[e] ? ((const float*)(ws + WS_SA))[tk] : 0.f; } }
        __syncthreads();
        pg8::EpiUpQ E{args.in[21], ws + WS_ACTQ, (const float*)(ws + WS_SA), (const float*)(ws + WS_SB), (const int*)(ws + WS_PSLOT), t_cnt, t_pstart, (float*)(ws + WS_RMAXP), sclL, (LAS float*)(F.lds + EPL_OFF)};
        pg8::gemm_phase<pg8::EpiUpQ, pg8::MoeOrder, PG8_ALIGN, PG8_SP2, true, false>(F.lds + RING_OFF, g, S, E, tokl);
    }
    GRID_BAR();
#endif
#if PROBE == 3 || PROBE == 5 || PROBE == 6
    {
#if PROBE != 5
        p9b_phase(F, nMt * 256, (const float*)(ws + WS_RMAXP), ws + WS_ACTQ, (float*)(ws + WS_SACT)); GRID_BAR();
#endif
#if PROBE != 6
        pg8::Gemm g{(const pg8::bf16_t*)(ws + WS_ACTQ), (const pg8::bf16_t*)(ws + WS_WDN), MAXMT * 256, NE * DM, DM / 2}; pg8::MoeOrder S; S.init(nMt, 8, F.G, (int)blockIdx.x, t_mte, t_cnt, t_pstart);
        pg8::EpiDownQ E{args.in[23], (pg8::bf16_t*)(ws + WS_YSG), (const int*)(ws + WS_PSLOT), (const float*)(ws + WS_PGATE), t_cnt, t_pstart, (const float*)(ws + WS_SACT), (const float*)(ws + WS_SBD), (LAS float*)(F.lds + TOK_OFF)};
        pg8::gemm_phase<pg8::EpiDownQ, pg8::MoeOrder, PG8_ALIGN, PG8_SP2, false, false>(F.lds + RING_OFF, g, S, E);
#endif
    }
    GRID_BAR();
#endif
    p11_phase(F, args.in[16], args.in[17], args.in[24], args.in[25]);
#if PROBE == 8
    GRID_BAR(); p11_phase(F, args.in[16], args.in[17], args.in[24], args.in[25]);
#endif
#undef GRID_BAR
}

extern "C" void kernel_launch(void* const* d_in, const int* in_sizes, int n_in, void* d_out, int out_size, void* d_ws, size_t ws_size, hipStream_t stream) {
    static int grid = 0;
    if (grid == 0) {
        if (n_in != 26 || out_size != MT * DM || ws_size < WS_END) { fprintf(stderr, "kernel_launch: unexpected shapes (n_in %d, out %d, ws %zu); nothing launched\n", n_in, out_size, ws_size); grid = -1; return; }
        int dev = 0, cus = 0, per_cu = 0;
        if (hipGetDevice(&dev) != hipSuccess || hipDeviceGetAttribute(&cus, hipDeviceAttributeMultiprocessorCount, dev) != hipSuccess) { grid = -1; return; }
        if (hipFuncSetAttribute((const void*)mega_fwd, hipFuncAttributeMaxDynamicSharedMemorySize, LDS_BYTES) != hipSuccess) { fprintf(stderr, "kernel_launch: hipFuncSetAttribute failed\n"); grid = -1; return; }
        if (hipOccupancyMaxActiveBlocksPerMultiprocessor(&per_cu, (const void*)mega_fwd, NWAVES * 64, LDS_BYTES) != hipSuccess || per_cu < 1) fprintf(stderr, "kernel_launch: occupancy query reports %d\n", per_cu);
        (void)hipGetLastError();
        grid = cus;
    }
    if (grid < 0) return;
    if (hipMemsetAsync((char*)d_ws + WS_CTL, 0, CTL_ZERO_BYTES, stream) != hipSuccess) return;
    Args a{};
    for (int i = 0; i < 26; ++i) a.in[i] = (const float*)d_in[i];
    a.out = (float*)d_out; a.ws = (unsigned char*)d_ws;
    hipLaunchKernelGGL(mega_fwd, dim3(grid), dim3(NWAVES * 64), LDS_BYTES, stream, a);
}
```

```cpp
#include <hip/hip_runtime.h>
#include <cstdio>
#include <cstdint>
namespace pg8 {
#define PG8_LAS __attribute__((address_space(3)))
typedef unsigned short bf16_t;
typedef short bf16x8 __attribute__((ext_vector_type(8)));
typedef float f32x4 __attribute__((ext_vector_type(4)));
typedef unsigned u32x4 __attribute__((ext_vector_type(4)));
typedef int i32x4 __attribute__((ext_vector_type(4)));
template <class AccT> __device__ __forceinline__ AccT pg8_mma(bf16x8 b, bf16x8 a, AccT c);
template <> __device__ __forceinline__ f32x4 pg8_mma<f32x4>(bf16x8 b, bf16x8 a, f32x4 c) { return __builtin_amdgcn_mfma_f32_16x16x32_bf16(b, a, c, 0, 0, 0); }
template <> __device__ __forceinline__ i32x4 pg8_mma<i32x4>(bf16x8 b, bf16x8 a, i32x4 c) { return __builtin_amdgcn_mfma_i32_16x16x64_i8(__builtin_bit_cast(i32x4, b), __builtin_bit_cast(i32x4, a), c, 0, 0, 0); }
constexpr int BM = 256, BK = 64, HALF = 128, HTB = HALF * BK * 2  , STAGE_BYTES = 8 * HTB, NXCD = 8, WGM = 8;

__host__ __device__ __forceinline__ int lds_byte(int r, int c) { const int st = (r >> 4) * 2 + (c >> 5), rr = r & 15, cc = c & 31, ob = rr * 64 + cc * 2; return st * 1024 + (ob ^ (((ob >> 9) & 1) << 5)); }
__host__ __device__ __forceinline__ void stage_rc(int b, int& R, int& C) { const int st = b / 1024, sb = b % 1024, swz = sb ^ (((sb >> 9) & 1) << 5); R = (st >> 1) * 16 + swz / 64; C = (st & 1) * 32 + (swz % 64) / 2; }
__host__ __device__ __forceinline__ int perm32(int rho) { const int n = rho >> 4, i = rho & 15; return 8 * (i >> 2) + 4 * n + (i & 3); }

struct Unit { int pm, pn, pb, half, ord; };
struct Gemm { const bf16_t* A; const bf16_t* Bt; int M, N, K; };

struct StaticOrder {
    int nM, nN, nwg, G, c;
    __host__ __device__ __forceinline__ void init(int M, int N, int G_, int c_) { nM = M / BM; nN = N / BM; nwg = nM * nN; G = G_; c = c_; }
    __host__ __device__ __forceinline__ bool next(int i, Unit& u) const {
        const long L = (long)i * G + c; if (L >= nwg) return false;
        int wgid = (int)L; { const int q = nwg / NXCD, r = nwg % NXCD, xcd = wgid % NXCD, off = wgid / NXCD; wgid = (xcd < r ? xcd * (q + 1) : r * (q + 1) + (xcd - r) * q) + off; }
        constexpr int WS_ = 4;
        const int nig = WS_ * nN, gid = wgid / nig, fm = gid * WS_, gsz = (nM - fm) < WS_ ? (nM - fm) : WS_;
        u.pm = fm + ((wgid % nig) % gsz); u.pn = (wgid % nig) / gsz; u.pb = u.pn; u.half = 0; u.ord = i; return true;
    }
    __device__ __forceinline__ void a_ready(const Unit&) const {}
    __device__ __forceinline__ void done(const Unit&) const {}
};

__device__ __forceinline__ unsigned cvt_pk_bf16(float lo, float hi) { unsigned r; asm volatile("v_cvt_pk_bf16_f32 %0, %1, %2" : "=v"(r) : "v"(lo), "v"(hi)); return r; }
typedef float f32x2 __attribute__((ext_vector_type(2)));
__device__ __forceinline__ f32x2 gelu_pk(f32x2 v) {
    const f32x2 av = __builtin_elementwise_abs(v), d = av * 0.2316418882f + 1.0f;
    f32x2 t; t.x = __builtin_amdgcn_rcpf(d.x); t.y = __builtin_amdgcn_rcpf(d.y);
    f32x2 q = t * 0.5307027145f + (-0.7265760135f); q = q * t + 0.7107068705f; q = q * t + (-0.142248368f); q = q * t + 0.127414796f; q = q * t;
    const f32x2 s = (v * v) * (-0.72134752044f);
    f32x2 e; e.x = __builtin_amdgcn_exp2f(s.x); e.y = __builtin_amdgcn_exp2f(s.y);
    const f32x2 m = v * (q * e), r = v - m;
    f32x2 o; o.x = v.x < 0.f ? m.x : r.x; o.y = v.y < 0.f ? m.y : r.y; return o;
}

template <int ACT  > struct EpiBf16 {
    typedef f32x4 AccT; static constexpr bool PERM = true, AFTER_DRAIN = false; static_assert(ACT == 0 || ACT == 1, "EpiBf16: ACT is 0 (none) or 1 (gelu_pk)");
    bf16_t* O; int ldc; const float* bias; int split_cols; size_t split_stride; float scale0;
    __device__ __forceinline__ void operator()(const f32x4 (&acc)[2][2][4][2], const Unit& u, int wr, int wc, int fr, int fq) const {
        const int row0 = u.pm * BM + wr * 64 + fr; int colt = u.pn * BM; bf16_t* base = O;
        float sc = 1.f; if (split_cols) { const int t = colt / split_cols; base += (size_t)t * split_stride; colt -= t * split_cols; if (t == 0) sc = scale0; }
        const int col0 = colt + wc * 32 + 8 * fq, bcol0 = u.pn * BM + wc * 32 + 8 * fq;
        f32x4 bv[2][2];
#pragma unroll
        for (int bj = 0; bj < 2; ++bj)
#pragma unroll
            for (int n = 0; n < 2; ++n) bv[bj][n] = bias ? *(const f32x4*)(bias + bcol0 + bj * HALF + 4 * n) : (f32x4){0.f, 0.f, 0.f, 0.f};
#pragma unroll
        for (int ai = 0; ai < 2; ++ai)
#pragma unroll
            for (int m = 0; m < 4; ++m) { bf16_t* rowp = base + (size_t)(row0 + ai * HALF + m * 16) * ldc + col0;
#pragma unroll
                for (int bj = 0; bj < 2; ++bj) { f32x4 v0 = acc[ai][bj][m][0] + bv[bj][0], v1 = acc[ai][bj][m][1] + bv[bj][1];
                    if (ACT == 1) { f32x2 a = gelu_pk((f32x2){v0[0], v0[1]}), b = gelu_pk((f32x2){v0[2], v0[3]}), c = gelu_pk((f32x2){v1[0], v1[1]}), d = gelu_pk((f32x2){v1[2], v1[3]});
                        v0 = (f32x4){a.x, a.y, b.x, b.y}; v1 = (f32x4){c.x, c.y, d.x, d.y}; }
                    v0 = v0 * sc; v1 = v1 * sc; u32x4 w; w.x = cvt_pk_bf16(v0[0], v0[1]); w.y = cvt_pk_bf16(v0[2], v0[3]); w.z = cvt_pk_bf16(v1[0], v1[1]); w.w = cvt_pk_bf16(v1[2], v1[3]);
                    *(u32x4*)(rowp + bj * HALF) = w; } }
    }
};

template <class Epi, class Sched, bool ALIGN_EPI = false, bool SP2 = false, bool GATHER = false, bool HALFU = false>
__device__ __forceinline__ void gemm_phase(PG8_LAS unsigned char* lds, const Gemm g, const Sched& S, const Epi& E, const PG8_LAS unsigned short* tokl = nullptr) {
    int tid_ = threadIdx.x; asm volatile("" : "+v"(tid_));
    const int tid = tid_, wid = __builtin_amdgcn_readfirstlane(tid >> 6), lane = tid & 63, wr = wid >> 2, wc = wid & 3, fr = lane & 15, fq = lane >> 4;
    const int K = g.K, nt = K / BK;
    unsigned voffA[2], voffB[2]; int rA_[2]; unsigned cA2_[2];
#pragma unroll
    for (int i = 0; i < 2; ++i) { int R, C; stage_rc(tid * 16 + i * 8192, R, C); const int Rb = Epi::PERM ? ((R & ~31) + perm32(R & 31)) : R;
        voffA[i] = (unsigned)(R * K + C) * 2u; voffB[i] = (unsigned)(Rb * K + C) * 2u; rA_[i] = R; cA2_[i] = (unsigned)C * 2u; }
    unsigned gc[2][2], gn[2][2];
#define PG8_GOFF(dst, ord) do { _Pragma("unroll") for (int h_ = 0; h_ < 2; ++h_) _Pragma("unroll") for (int i_ = 0; i_ < 2; ++i_) dst[h_][i_] = (unsigned)tokl[(ord) * 256 + h_ * 128 + rA_[i_]] * (unsigned)(K * 2) + cA2_[i_]; } while (0)
#define PG8_GCOPY(dst, src) do { dst[0][0] = src[0][0]; dst[0][1] = src[0][1]; dst[1][0] = src[1][0]; dst[1][1] = src[1][1]; } while (0)
    const size_t kstep = (size_t)(BK * 2);
    const size_t hstep = (size_t)HALF * K * 2;
    const size_t tstep = 2 * hstep;
    const unsigned ldsw = (unsigned)wid * 1024u;
    const int aoff = lds_byte(wr * 64 + fr, fq * 8), boff = lds_byte(wc * 32 + fr, fq * 8);
#define PG8_SA(b, h) (((b) * 2 + (h)) * HTB)
#define PG8_SB(b, h) ((4 + (b) * 2 + (h)) * HTB)
#define PG8_STAGE(bufoff, gbase, voff) do { _Pragma("unroll") for (int _i = 0; _i < 2; ++_i) \
        __builtin_amdgcn_global_load_lds((const unsigned*)((const char*)(gbase) + (voff)[_i]), (PG8_LAS unsigned*)(lds + (bufoff) + ldsw + _i * 8192), 16, 0, 0); } while (0)
#define PG8_STAGE_A(bufoff, gbase, h, nx) do { _Pragma("unroll") for (int _i = 0; _i < 2; ++_i) { const unsigned vo_ = GATHER ? ((nx) ? gn[h][_i] : gc[h][_i]) : voffA[_i]; \
        __builtin_amdgcn_global_load_lds((const unsigned*)((const char*)(gbase) + (GATHER ? (size_t)0 : (size_t)(h) * hstep) + vo_), (PG8_LAS unsigned*)(lds + (bufoff) + ldsw + _i * 8192), 16, 0, 0); } } while (0)
#define PG8_LDA(dst, b, h) do { _Pragma("unroll") for (int m = 0; m < 4; ++m) _Pragma("unroll") for (int k = 0; k < 2; ++k) dst[m][k] = *(const PG8_LAS bf16x8*)(lds + PG8_SA(b, h) + aoff + m * 2048 + k * 1024); } while (0)
#define PG8_LDB(dst, b, h) do { _Pragma("unroll") for (int n = 0; n < 2; ++n) _Pragma("unroll") for (int k = 0; k < 2; ++k) dst[n][k] = *(const PG8_LAS bf16x8*)(lds + PG8_SB(b, h) + boff + n * 2048 + k * 1024); } while (0)
#define PG8_MMA(ai, bj, At, Bt) do { __builtin_amdgcn_s_setprio(1); _Pragma("unroll") for (int m = 0; m < 4; ++m) _Pragma("unroll") for (int n = 0; n < 2; ++n) _Pragma("unroll") for (int k = 0; k < 2; ++k) \
        acc[ai][bj][m][n] = pg8_mma<typename Epi::AccT>(Bt[n][k], At[m][k], acc[ai][bj][m][n]); __builtin_amdgcn_s_setprio(0); } while (0)
#define PG8_WAIT_V(n) asm volatile("s_waitcnt vmcnt(" #n ")" ::: "memory")
#define PG8_WAIT_L(n) asm volatile("s_waitcnt lgkmcnt(" #n ")" ::: "memory")
#define PG8_BAR __builtin_amdgcn_s_barrier()
#define PG8_SCHED __builtin_amdgcn_sched_barrier(0)
    Unit cur, nxt; int ui = 0;
    if (!S.next(0, cur)) return;
    typedef typename Epi::AccT acc_t; acc_t acc[2][2][4][2];
#pragma unroll
    for (int a = 0; a < 2; ++a)
#pragma unroll
        for (int b = 0; b < 2; ++b)
#pragma unroll
            for (int m = 0; m < 4; ++m)
#pragma unroll
                for (int n = 0; n < 2; ++n) acc[a][b][m][n] = acc_t{};
    bf16x8 At[4][2], B0[2][2], B1[2][2];
    const char* cA = (const char*)g.A + (GATHER ? (size_t)0 : (size_t)cur.pm * tstep); const char* cB = (const char*)g.Bt + (size_t)cur.pb * tstep;
    if (GATHER) { PG8_GOFF(gc, cur.ord); PG8_GCOPY(gn, gc); }
    S.a_ready(cur);
    if constexpr (SP2) {
        PG8_STAGE(PG8_SB(0, 0), cB, voffB); PG8_STAGE(PG8_SB(0, 1), cB + hstep, voffB); PG8_STAGE_A(PG8_SA(0, 0), cA, 0, false); PG8_STAGE_A(PG8_SA(0, 1), cA, 1, false);
        if (wr == 1) PG8_BAR;
        PG8_WAIT_V(2); PG8_BAR;
        PG8_STAGE(PG8_SB(1, 0), cB + kstep, voffB); PG8_STAGE_A(PG8_SA(1, 0), cA + kstep, 0, false); PG8_STAGE(PG8_SB(1, 1), cB + hstep + kstep, voffB);
        PG8_WAIT_V(6); PG8_BAR;
    } else {
        PG8_STAGE(PG8_SB(0, 0), cB, voffB); PG8_STAGE_A(PG8_SA(0, 0), cA, 0, false); PG8_STAGE(PG8_SB(0, 1), cB + hstep, voffB); PG8_STAGE_A(PG8_SA(0, 1), cA, 1, false);
        if (wr == 1) PG8_BAR;
        PG8_WAIT_V(4); PG8_BAR;
        PG8_STAGE(PG8_SB(1, 0), cB + kstep, voffB); PG8_STAGE_A(PG8_SA(1, 0), cA + kstep, 0, false); PG8_STAGE(PG8_SB(1, 1), cB + hstep + kstep, voffB);
        PG8_WAIT_V(6); PG8_BAR;
    }
    for (;;) {
        const bool has_next = S.next(ui + 1, nxt);
        if (GATHER) { if (has_next) PG8_GOFF(gn, nxt.ord); else PG8_GCOPY(gn, gc); }
        const char* nA = (has_next && !GATHER) ? (const char*)g.A + (size_t)nxt.pm * tstep : cA; const char* nB = has_next ? (const char*)g.Bt + (size_t)nxt.pb * tstep : cB;
        for (int t = 0; t < nt; t += 2) {
            const bool last = (t == nt - 2);
            const char* a1 = cA + (size_t)(t + 1) * kstep;
            const char* a2 = last ? nA : cA + (size_t)(t + 2) * kstep; const char* b2 = last ? nB : cB + (size_t)(t + 2) * kstep;
            const char* a3 = a2 + kstep; const char* b3 = b2 + kstep;
            if (last && has_next) S.a_ready(nxt);
            if (last) { int ln_ = fq * 16 + fr; asm volatile("" : "+v"(ln_)); E.stage(cur, wid, ln_); }
            if constexpr (SP2) {
            PG8_LDB(B0, 0, 0); PG8_LDB(B1, 0, 1); PG8_SCHED; PG8_LDA(At, 0, 0); PG8_STAGE_A(PG8_SA(1, 1), a1, 1, false);
            PG8_WAIT_V(8); PG8_WAIT_L(0); PG8_BAR; if (!(HALFU && cur.half == 2)) { PG8_MMA(0, 0, At, B0); PG8_MMA(0, 1, At, B1); } PG8_BAR; PG8_SCHED;
            PG8_LDA(At, 0, 1); PG8_STAGE(PG8_SB(0, 0), b2, voffB); PG8_STAGE(PG8_SB(0, 1), b2 + hstep, voffB); PG8_STAGE_A(PG8_SA(0, 0), a2, 0, last);
            PG8_WAIT_V(8); PG8_WAIT_L(0); PG8_BAR; if (!(HALFU && cur.half == 1)) { PG8_MMA(1, 0, At, B0); PG8_MMA(1, 1, At, B1); } PG8_BAR; PG8_SCHED;
            PG8_LDB(B0, 1, 0); PG8_LDB(B1, 1, 1); PG8_SCHED; PG8_LDA(At, 1, 0); PG8_STAGE_A(PG8_SA(0, 1), a2, 1, last);
            PG8_WAIT_V(8); PG8_WAIT_L(0); PG8_BAR; if (!(HALFU && cur.half == 2)) { PG8_MMA(0, 0, At, B0); PG8_MMA(0, 1, At, B1); } PG8_BAR; PG8_SCHED;
            PG8_LDA(At, 1, 1); PG8_STAGE(PG8_SB(1, 0), b3, voffB); PG8_STAGE(PG8_SB(1, 1), b3 + hstep, voffB); PG8_STAGE_A(PG8_SA(1, 0), a3, 0, last);
            PG8_WAIT_V(8); PG8_WAIT_L(0); PG8_BAR; if (!(HALFU && cur.half == 1)) { PG8_MMA(1, 0, At, B0); PG8_MMA(1, 1, At, B1); } PG8_BAR; PG8_SCHED;
            } else {
            PG8_LDB(B0, 0, 0); PG8_SCHED; PG8_LDA(At, 0, 0); PG8_STAGE_A(PG8_SA(1, 1), a1, 1, false);
            PG8_WAIT_L(8); PG8_BAR; PG8_WAIT_L(0); PG8_MMA(0, 0, At, B0); PG8_BAR; PG8_SCHED;
            PG8_LDB(B1, 0, 1); PG8_STAGE(PG8_SB(0, 0), b2, voffB);
            PG8_BAR; PG8_WAIT_L(0); PG8_MMA(0, 1, At, B1); PG8_BAR;
            PG8_LDA(At, 0, 1); PG8_STAGE_A(PG8_SA(0, 0), a2, 0, last);
            PG8_BAR; PG8_WAIT_L(0); PG8_MMA(1, 0, At, B0); PG8_BAR; PG8_SCHED;
            PG8_STAGE(PG8_SB(0, 1), b2 + hstep, voffB);
            PG8_WAIT_V(6); PG8_BAR; PG8_MMA(1, 1, At, B1); PG8_BAR;
            PG8_LDB(B0, 1, 0); PG8_SCHED; PG8_LDA(At, 1, 0); PG8_STAGE_A(PG8_SA(0, 1), a2, 1, last);
            PG8_WAIT_L(8); PG8_BAR; PG8_WAIT_L(0); PG8_MMA(0, 0, At, B0); PG8_BAR; PG8_SCHED;
            PG8_LDB(B1, 1, 1); PG8_STAGE(PG8_SB(1, 0), b3, voffB);
            PG8_BAR; PG8_WAIT_L(0); PG8_MMA(0, 1, At, B1); PG8_BAR;
            PG8_LDA(At, 1, 1); PG8_STAGE_A(PG8_SA(1, 0), a3, 0, last);
            PG8_BAR; PG8_WAIT_L(0); PG8_MMA(1, 0, At, B0); PG8_BAR; PG8_SCHED;
            PG8_STAGE(PG8_SB(1, 1), b3 + hstep, voffB);
            PG8_WAIT_V(6); PG8_BAR; PG8_MMA(1, 1, At, B1); PG8_BAR;
            }
        }
        if constexpr (ALIGN_EPI) { if (wr == 0) PG8_BAR; }
        if constexpr (!Epi::AFTER_DRAIN) { E(acc, cur, wr, wc, fr, fq); S.done(cur); }
        if (!has_next) break;
#pragma unroll
        for (int a = 0; a < 2; ++a)
#pragma unroll
            for (int b = 0; b < 2; ++b)
#pragma unroll
                for (int m = 0; m < 4; ++m)
#pragma unroll
                    for (int n = 0; n < 2; ++n) acc[a][b][m][n] = acc_t{};
        cur = nxt; cA = nA; cB = nB; ++ui; if (GATHER) PG8_GCOPY(gc, gn);
        if constexpr (ALIGN_EPI) { if (wr == 1) PG8_BAR; }
    }
    PG8_WAIT_V(0);
    if constexpr (!ALIGN_EPI) { if (wr == 0) PG8_BAR; }
    PG8_BAR;
    if constexpr (Epi::AFTER_DRAIN) { E.fused(acc, cur, wr, wc, fr, fq, lds, wid, lane); S.done(cur); }
#undef PG8_SA
#undef PG8_SB
#undef PG8_STAGE
#undef PG8_STAGE_A
#undef PG8_GOFF
#undef PG8_GCOPY
#undef PG8_LDA
#undef PG8_LDB
#undef PG8_MMA
#undef PG8_WAIT_V
#undef PG8_WAIT_L
#undef PG8_BAR
#undef PG8_SCHED
}
}

#ifndef PG8_SP2
#define PG8_SP2 true
#endif
#ifndef PG8_ALIGN
#define PG8_ALIGN true
#endif
#include <hip/hip_bf16.h>
#include <cmath>
namespace pg8 {
__device__ __forceinline__ float bf_lo(unsigned w) { return __uint_as_float(w << 16); }
__device__ __forceinline__ float bf_hi(unsigned w) { return __uint_as_float(w & 0xffff0000u); }
__device__ __forceinline__ u32x4 pack8(const f32x4 v0, const f32x4 v1) { u32x4 w; w.x = cvt_pk_bf16(v0[0], v0[1]); w.y = cvt_pk_bf16(v0[2], v0[3]); w.z = cvt_pk_bf16(v1[0], v1[1]); w.w = cvt_pk_bf16(v1[2], v1[3]); return w; }
__device__ __forceinline__ unsigned q4p(float a, float b, float c, float d, float inv) {
    const float M = 12582912.0f;
    const unsigned b0 = __float_as_uint(fmaf(a, inv, M)), b1 = __float_as_uint(fmaf(b, inv, M)), b2 = __float_as_uint(fmaf(c, inv, M)), b3 = __float_as_uint(fmaf(d, inv, M));
    return __builtin_amdgcn_perm(__builtin_amdgcn_perm(b3, b2, 0x0c0c0400u), __builtin_amdgcn_perm(b1, b0, 0x0c0c0400u), 0x05040100u);
}
__device__ __forceinline__ float lane_max_16_32(float v) {
    { auto r = __builtin_amdgcn_permlane16_swap(__float_as_uint(v), __float_as_uint(v), false, false); v = fmaxf(__uint_as_float(r[0]), __uint_as_float(r[1])); }
    { auto r = __builtin_amdgcn_permlane32_swap(__float_as_uint(v), __float_as_uint(v), false, false); v = fmaxf(__uint_as_float(r[0]), __uint_as_float(r[1])); }
    return v;
}
__device__ __forceinline__ float sigmoidf_fast(float x) { return __builtin_amdgcn_rcpf(1.0f + __builtin_amdgcn_exp2f(-1.4426950408889634f * x)); }

struct InProjOrder {
    int G, c;
    __device__ __forceinline__ bool next(int i, Unit& u) const {
        constexpr int NMAIN = 64 * 33, NWG = NMAIN + 36;
        const int L = i * G + c; if (L >= NWG) return false;
        int wgid = L; { const int q = NWG / NXCD, r = NWG % NXCD, xcd = wgid % NXCD, off = wgid / NXCD; wgid = (xcd < r ? xcd * (q + 1) : r * (q + 1) + (xcd - r) * q) + off; }
        if (wgid < NMAIN) { const int nig = WGM * 33, gid = wgid / nig, fm = gid * WGM; u.pm = fm + ((wgid % nig) % WGM); u.pn = (wgid % nig) / WGM; }
        else { const int idx = wgid - NMAIN, j = idx >> 2; u.pm = 64 + (idx & 3); u.pn = j < 8 ? 4 + j : 16; }
        u.pb = u.pn; u.half = 0; u.ord = i; return true;
    }
    __device__ __forceinline__ void a_ready(const Unit&) const {}
    __device__ __forceinline__ void done(const Unit&) const {}
};
struct MoeOrder {
    int nM, nN, nwg, G, c; const PG8_LAS int* mt_e; const PG8_LAS int* cnt; const PG8_LAS int* pstart;
    int mode = 0;
    __device__ __forceinline__ void init(int nM_, int nN_, int G_, int c_, const PG8_LAS int* t, const PG8_LAS int* cn, const PG8_LAS int* ps) { nM = nM_; nN = nN_; nwg = nM * nN; G = G_; c = c_; mt_e = t; cnt = cn; pstart = ps; }
    __device__ __forceinline__ bool next(int i, Unit& u) const {
        const int full = (nwg / G) * G, tail = nwg - full; const bool sp = tail > 0 && 2 * tail <= G; long L; int hf = 0;
        if (mode == 2) { if (!sp || i != 0 || c >= 2 * tail) return false; L = full + (c >> 1); hf = 1 + (c & 1); }
        else { L = (long)i * G + c; if (L >= ((mode == 1 && sp) ? full : nwg)) return false; }
        int wgid = (int)L; { const int q = nwg / NXCD, r = nwg % NXCD, xcd = wgid % NXCD, off = wgid / NXCD; wgid = (xcd < r ? xcd * (q + 1) : r * (q + 1) + (xcd - r) * q) + off; }
        constexpr int WG_ = 4;     const int nig = WG_ * nN, gid = wgid / nig, fm = gid * WG_, gsz = (nM - fm) < WG_ ? (nM - fm) : WG_;
        u.pm = fm + ((wgid % nig) % gsz); u.pn = (wgid % nig) / gsz;
        const int e = __builtin_amdgcn_readfirstlane(mt_e[u.pm]); u.pb = e * nN + u.pn;
        u.half = hf; u.ord = (mode == 2) ? nwg / G : i; return true;
    }
    __device__ __forceinline__ void a_ready(const Unit&) const {}
    __device__ __forceinline__ void done(const Unit&) const {}
};

struct EpiInProj {
    typedef i32x4 AccT; static constexpr bool PERM = true, AFTER_DRAIN = false;
    const float* SH; const float* SBc; bf16_t *QA, *KA, *VA, *QB, *KB, *VB, *GA, *GB; float c2; PG8_LAS float* epl;
    __device__ __forceinline__ void stage(const Unit& u, int wid, int lane) const { const float* p = wid < 4 ? SH + u.pm * 256 + wid * 64 : SBc + u.pn * 256 + (wid - 4) * 64;
        __builtin_amdgcn_global_load_lds((const unsigned*)(p + (unsigned)lane), (PG8_LAS unsigned*)(epl + wid * 64), 4, 0, 0); }
    __device__ __forceinline__ void operator()(const i32x4 (&acc)[2][2][4][2], const Unit& u, int wr, int wc, int fr, int fq) const {
        const int pm = u.pm, pn = u.pn; const bool ctx = pm >= 64;
        const int b = ctx ? pm - 64 : (pm >> 4);
        const int krow0 = ctx ? b * 4352 + 4096 : b * 4352 + (pm & 15) * 256, qrow0 = pm * 256;
        float sa8[2][4];
#pragma unroll
        for (int ai = 0; ai < 2; ++ai)
#pragma unroll
            for (int m = 0; m < 4; ++m) sa8[ai][m] = epl[ai * HALF + wr * 64 + m * 16 + fr];
        float invf[4];
#pragma unroll
        for (int i = 0; i < 4; ++i) invf[i] = __builtin_amdgcn_exp2f(-(float)(4 * fq + i) * (13.287712379549449f / 16.0f)) * 0.15915494309189535f;
#pragma unroll
        for (int bj = 0; bj < 2; ++bj) {
            const int colt = 128 * bj + 32 * wc + 8 * fq;
            const f32x4 sb0 = *(const PG8_LAS f32x4*)(epl + 256 + colt), sb1 = *(const PG8_LAS f32x4*)(epl + 256 + colt + 4);
            bf16_t* base; int pitch, row0, mode; float scl = 1.f;
            if (pn < 4)        { base = QA + (pn * 256 + colt);        pitch = 1024; row0 = qrow0; mode = 1; scl = c2; }
            else if (pn < 8)   { base = KA + ((pn - 4) * 256 + colt);  pitch = 1024; row0 = krow0; mode = ctx ? 0 : 1; }
            else if (pn < 12)  { base = VA + ((pn - 8) * 256 + colt);  pitch = 1024; row0 = krow0; mode = 0; }
            else if (pn < 16)  { base = QB + ((pn - 12) * 256 + colt); pitch = 1024; row0 = qrow0; mode = 1; scl = c2; }
            else if (pn == 16) { if (bj == 0) { base = KB + (32 * wc + 8 * fq); mode = ctx ? 0 : 1; } else { base = VB + (32 * wc + 8 * fq); mode = 0; } pitch = 128; row0 = krow0; }
            else if (pn < 25)  { base = GA + ((pn - 17) * 256 + colt); pitch = 2048; row0 = qrow0; mode = 2; }
            else               { base = GB + ((pn - 25) * 256 + colt); pitch = 2048; row0 = qrow0; mode = 2; }
#pragma unroll
            for (int ai = 0; ai < 2; ++ai)
#pragma unroll
                for (int m = 0; m < 4; ++m) {
                    const int row = ai * HALF + wr * 64 + m * 16 + fr;
                    const float sa = sa8[ai][m];
                    f32x4 v0 = __builtin_convertvector(acc[ai][bj][m][0], f32x4) * (sb0 * sa), v1 = __builtin_convertvector(acc[ai][bj][m][1], f32x4) * (sb1 * sa);
                    if (mode == 1) {
                        const float pos = (wc & 1) ? (float)(16 * m + fr) : (float)((pm & 15) * 4 + 2 * ai + wr);
#pragma unroll
                        for (int i = 0; i < 4; ++i) { float rev = pos * invf[i]; rev -= floorf(rev); const float cs = __builtin_amdgcn_cosf(rev), sn = __builtin_amdgcn_sinf(rev);
                            const float x1 = v0[i], x2 = v1[i]; v0[i] = x1 * cs - x2 * sn; v1[i] = x2 * cs + x1 * sn; }
                    } else if (mode == 2) {
#pragma unroll
                        for (int i = 0; i < 4; ++i) { v0[i] = sigmoidf_fast(v0[i]); v1[i] = sigmoidf_fast(v1[i]); }
                    }
                    v0 = v0 * scl; v1 = v1 * scl;
                    *(u32x4*)(base + (size_t)(row0 + row) * pitch) = pack8(v0, v1);
                }
        }
    }
};
struct EpiGate1 {
    typedef f32x4 AccT; static constexpr bool PERM = true, AFTER_DRAIN = false;
    __device__ __forceinline__ void stage(const Unit&, int, int) const {}
    const bf16_t* G; float* Y1;
    __device__ __forceinline__ void operator()(const f32x4 (&acc)[2][2][4][2], const Unit& u, int wr, int wc, int fr, int fq) const {
        u32x4 g[2][4][2];
#pragma unroll
        for (int ai = 0; ai < 2; ++ai)
#pragma unroll
            for (int m = 0; m < 4; ++m)
#pragma unroll
                for (int bj = 0; bj < 2; ++bj) g[ai][m][bj] = *(const u32x4*)(G + (size_t)(u.pm * BM + ai * HALF + wr * 64 + m * 16 + fr) * 2048 + (u.pn * BM + bj * HALF + wc * 32 + 8 * fq));
#pragma unroll
        for (int ai = 0; ai < 2; ++ai)
#pragma unroll
            for (int m = 0; m < 4; ++m)
#pragma unroll
                for (int bj = 0; bj < 2; ++bj) {
                    const size_t off = (size_t)(u.pm * BM + ai * HALF + wr * 64 + m * 16 + fr) * 2048 + (u.pn * BM + bj * HALF + wc * 32 + 8 * fq);
                    const u32x4 gg = g[ai][m][bj];
                    const f32x4 a0 = acc[ai][bj][m][0], a1 = acc[ai][bj][m][1];
                    f32x4 o0, o1; o0[0] = a0[0] * bf_lo(gg.x); o0[1] = a0[1] * bf_hi(gg.x); o0[2] = a0[2] * bf_lo(gg.y); o0[3] = a0[3] * bf_hi(gg.y);
                    o1[0] = a1[0] * bf_lo(gg.z); o1[1] = a1[1] * bf_hi(gg.z); o1[2] = a1[2] * bf_lo(gg.w); o1[3] = a1[3] * bf_hi(gg.w);
                    *(f32x4*)(Y1 + off) = o0; *(f32x4*)(Y1 + off + 4) = o1;
                }
    }
};
struct EpiGate2 {
    typedef f32x4 AccT; static constexpr bool PERM = true, AFTER_DRAIN = false;
    __device__ __forceinline__ void stage(const Unit&, int, int) const {}
    const bf16_t* G; const float* Y1; bf16_t* Y;
    __device__ __forceinline__ void operator()(const f32x4 (&acc)[2][2][4][2], const Unit& u, int wr, int wc, int fr, int fq) const {
#pragma unroll
        for (int ai = 0; ai < 2; ++ai)
#pragma unroll
            for (int mh = 0; mh < 2; ++mh) {
                u32x4 g[2][2]; f32x4 ya[2][2], yb[2][2];
#pragma unroll
                for (int mm = 0; mm < 2; ++mm)
#pragma unroll
                    for (int bj = 0; bj < 2; ++bj) { const size_t off = (size_t)(u.pm * BM + ai * HALF + wr * 64 + (2 * mh + mm) * 16 + fr) * 2048 + (u.pn * BM + bj * HALF + wc * 32 + 8 * fq);
                        g[mm][bj] = *(const u32x4*)(G + off); ya[mm][bj] = *(const f32x4*)(Y1 + off); yb[mm][bj] = *(const f32x4*)(Y1 + off + 4); }
#pragma unroll
                for (int mm = 0; mm < 2; ++mm)
#pragma unroll
                    for (int bj = 0; bj < 2; ++bj) { const int m = 2 * mh + mm; const size_t off = (size_t)(u.pm * BM + ai * HALF + wr * 64 + m * 16 + fr) * 2048 + (u.pn * BM + bj * HALF + wc * 32 + 8 * fq);
                        const u32x4 gg = g[mm][bj]; const f32x4 y0 = ya[mm][bj], y1 = yb[mm][bj], a0 = acc[ai][bj][m][0], a1 = acc[ai][bj][m][1];
                        f32x4 o0, o1; o0[0] = y0[0] + a0[0] * bf_lo(gg.x); o0[1] = y0[1] + a0[1] * bf_hi(gg.x); o0[2] = y0[2] + a0[2] * bf_lo(gg.y); o0[3] = y0[3] + a0[3] * bf_hi(gg.y);
                        o1[0] = y1[0] + a1[0] * bf_lo(gg.z); o1[1] = y1[1] + a1[1] * bf_hi(gg.z); o1[2] = y1[2] + a1[2] * bf_lo(gg.w); o1[3] = y1[3] + a1[3] * bf_hi(gg.w);
                        *(u32x4*)(Y + off) = pack8(o0, o1); }
            }
    }
};
struct EpiGate1Q {
    typedef i32x4 AccT; static constexpr bool PERM = true, AFTER_DRAIN = false;
    const bf16_t* G; float* Y1;
    const float* SR; const float* SC; PG8_LAS float* epl;
    __device__ __forceinline__ void stage(const Unit& u, int wid, int lane) const { const float* p = wid < 4 ? SR + u.pm * 256 + wid * 64 : SC + u.pn * 256 + (wid - 4) * 64;
        __builtin_amdgcn_global_load_lds((const unsigned*)(p + (unsigned)lane), (PG8_LAS unsigned*)(epl + wid * 64), 4, 0, 0); }
    __device__ __forceinline__ void operator()(const i32x4 (&acc)[2][2][4][2], const Unit& u, int wr, int wc, int fr, int fq) const {
#pragma unroll
        for (int ai = 0; ai < 2; ++ai) {
            u32x4 g[4][2];
#pragma unroll
            for (int m = 0; m < 4; ++m)
#pragma unroll
                for (int bj = 0; bj < 2; ++bj) g[m][bj] = *(const u32x4*)(G + (size_t)(u.pm * BM + ai * HALF + wr * 64 + m * 16 + fr) * 2048 + (u.pn * BM + bj * HALF + wc * 32 + 8 * fq));
#pragma unroll
            for (int m = 0; m < 4; ++m) {
                const float sa = epl[ai * HALF + wr * 64 + m * 16 + fr];
#pragma unroll
                for (int bj = 0; bj < 2; ++bj) {
                    const size_t off = (size_t)(u.pm * BM + ai * HALF + wr * 64 + m * 16 + fr) * 2048 + (u.pn * BM + bj * HALF + wc * 32 + 8 * fq);
                    const u32x4 gg = g[m][bj]; const PG8_LAS float* ec = epl + 256 + bj * HALF + wc * 32 + 8 * fq;
                    const f32x4 a0 = __builtin_convertvector(acc[ai][bj][m][0], f32x4) * (*(const PG8_LAS f32x4*)ec * sa), a1 = __builtin_convertvector(acc[ai][bj][m][1], f32x4) * (*(const PG8_LAS f32x4*)(ec + 4) * sa);
                    f32x4 o0, o1; o0[0] = a0[0] * bf_lo(gg.x); o0[1] = a0[1] * bf_hi(gg.x); o0[2] = a0[2] * bf_lo(gg.y); o0[3] = a0[3] * bf_hi(gg.y);
                    o1[0] = a1[0] * bf_lo(gg.z); o1[1] = a1[1] * bf_hi(gg.z); o1[2] = a1[2] * bf_lo(gg.w); o1[3] = a1[3] * bf_hi(gg.w);
                    *(f32x4*)(Y1 + off) = o0; *(f32x4*)(Y1 + off + 4) = o1;
                }
            }
        }
    }
};
struct EpiGate2Q {
    typedef i32x4 AccT; static constexpr bool PERM = true, AFTER_DRAIN = false;
    const bf16_t* G; const float* Y1; unsigned char* YQ; float* RMAXY;
    const float* SR; const float* SC; PG8_LAS float* epl;
    __device__ __forceinline__ void stage(const Unit& u, int wid, int lane) const { const float* p = wid < 4 ? SR + u.pm * 256 + wid * 64 : SC + u.pn * 256 + (wid - 4) * 64;
        __builtin_amdgcn_global_load_lds((const unsigned*)(p + (unsigned)lane), (PG8_LAS unsigned*)(epl + wid * 64), 4, 0, 0); }
    __device__ __forceinline__ void operator()(const i32x4 (&acc)[2][2][4][2], const Unit& u, int wr, int wc, int fr, int fq) const {
#pragma unroll
        for (int ai = 0; ai < 2; ++ai)
#pragma unroll
            for (int mh = 0; mh < 2; ++mh) {
                u32x4 g[2][2]; f32x4 ya[2][2], yb[2][2];
#pragma unroll
                for (int mm = 0; mm < 2; ++mm)
#pragma unroll
                    for (int bj = 0; bj < 2; ++bj) { const size_t off = (size_t)(u.pm * BM + ai * HALF + wr * 64 + (2 * mh + mm) * 16 + fr) * 2048 + (u.pn * BM + bj * HALF + wc * 32 + 8 * fq);
                        g[mm][bj] = *(const u32x4*)(G + off); ya[mm][bj] = *(const f32x4*)(Y1 + off); yb[mm][bj] = *(const f32x4*)(Y1 + off + 4); }
#pragma unroll
                for (int mm = 0; mm < 2; ++mm)
#pragma unroll
                    for (int bj = 0; bj < 2; ++bj) { const int m = 2 * mh + mm; const size_t off = (size_t)(u.pm * BM + ai * HALF + wr * 64 + m * 16 + fr) * 2048 + (u.pn * BM + bj * HALF + wc * 32 + 8 * fq);
                        const u32x4 gg = g[mm][bj]; const float sa = epl[ai * HALF + wr * 64 + m * 16 + fr]; const PG8_LAS float* ec = epl + 256 + bj * HALF + wc * 32 + 8 * fq;
                        const f32x4 y0 = ya[mm][bj], y1 = yb[mm][bj], a0 = __builtin_convertvector(acc[ai][bj][m][0], f32x4) * (*(const PG8_LAS f32x4*)ec * sa), a1 = __builtin_convertvector(acc[ai][bj][m][1], f32x4) * (*(const PG8_LAS f32x4*)(ec + 4) * sa);
                        f32x4 o0, o1; o0[0] = y0[0] + a0[0] * bf_lo(gg.x); o0[1] = y0[1] + a0[1] * bf_hi(gg.x); o0[2] = y0[2] + a0[2] * bf_lo(gg.y); o0[3] = y0[3] + a0[3] * bf_hi(gg.y);
                        o1[0] = y1[0] + a1[0] * bf_lo(gg.z); o1[1] = y1[1] + a1[1] * bf_hi(gg.z); o1[2] = y1[2] + a1[2] * bf_lo(gg.w); o1[3] = y1[3] + a1[3] * bf_hi(gg.w);
                        float mx = fmaxf(fmaxf(fmaxf(fabsf(o0[0]), fabsf(o0[1])), fmaxf(fabsf(o0[2]), fabsf(o0[3]))), fmaxf(fmaxf(fabsf(o1[0]), fabsf(o1[1])), fmaxf(fabsf(o1[2]), fabsf(o1[3]))));
                        mx = lane_max_16_32(mx);
                        const float qi = mx > 0.f ? 127.0f * __builtin_amdgcn_rcpf(mx) : 0.f;
                        typedef unsigned u2_t __attribute__((ext_vector_type(2))); u2_t w; w.x = q4p(o0[0], o0[1], o0[2], o0[3], qi); w.y = q4p(o1[0], o1[1], o1[2], o1[3], qi);
                        *(u2_t*)(YQ + off) = w;
                        if (fq == 0) RMAXY[(size_t)(u.pm * BM + ai * HALF + wr * 64 + m * 16 + fr) * 64 + u.pn * 8 + bj * 4 + wc] = mx; }
            }
    }
};
struct EpiOut {
    typedef f32x4 AccT; static constexpr bool PERM = true, AFTER_DRAIN = false;
    __device__ __forceinline__ void stage(const Unit&, int, int) const {}
    const float* X; const float* mod; float* R; float alpha;
    __device__ __forceinline__ void operator()(const f32x4 (&acc)[2][2][4][2], const Unit& u, int wr, int wc, int fr, int fq) const {
        const float* g1 = mod + (size_t)(u.pm >> 4) * 12288 + 4096;
#pragma unroll
        for (int bj = 0; bj < 2; ++bj) {
            const int col = u.pn * BM + bj * HALF + wc * 32 + 8 * fq;
            const f32x4 ga = *(const f32x4*)(g1 + col), gb = *(const f32x4*)(g1 + col + 4);
#pragma unroll
            for (int ai = 0; ai < 2; ++ai) {
                f32x4 xa[4], xb[4];
#pragma unroll
                for (int m = 0; m < 4; ++m) { const size_t off = (size_t)(u.pm * BM + ai * HALF + wr * 64 + m * 16 + fr) * 2048 + col; xa[m] = *(const f32x4*)(X + off); xb[m] = *(const f32x4*)(X + off + 4); }
#pragma unroll
                for (int m = 0; m < 4; ++m) {
                    const size_t off = (size_t)(u.pm * BM + ai * HALF + wr * 64 + m * 16 + fr) * 2048 + col;
                    *(f32x4*)(R + off) = xa[m] * alpha + ga * acc[ai][bj][m][0]; *(f32x4*)(R + off + 4) = xb[m] * alpha + gb * acc[ai][bj][m][1];
                }
            }
        }
    }
};
struct EpiOutQ {
    typedef i32x4 AccT; static constexpr bool PERM = true, AFTER_DRAIN = false;
    const float* X; const float* mod; float* R; float alpha;
    const float* SR; const float* SC; PG8_LAS float* epl;
    __device__ __forceinline__ void stage(const Unit& u, int wid, int lane) const { const float* p = wid < 4 ? SR + u.pm * 256 + wid * 64 : SC + u.pn * 256 + (wid - 4) * 64;
        __builtin_amdgcn_global_load_lds((const unsigned*)(p + (unsigned)lane), (PG8_LAS unsigned*)(epl + wid * 64), 4, 0, 0); }
    __device__ __forceinline__ void operator()(const i32x4 (&acc)[2][2][4][2], const Unit& u, int wr, int wc, int fr, int fq) const {
        const float* g1 = mod + (size_t)(u.pm >> 4) * 12288 + 4096;
#pragma unroll
        for (int bj = 0; bj < 2; ++bj) {
            const int col = u.pn * BM + bj * HALF + wc * 32 + 8 * fq;
            const PG8_LAS float* ec = epl + 256 + bj * HALF + wc * 32 + 8 * fq;
            const f32x4 ga = *(const f32x4*)(g1 + col) * *(const PG8_LAS f32x4*)ec, gb = *(const f32x4*)(g1 + col + 4) * *(const PG8_LAS f32x4*)(ec + 4);
#pragma unroll
            for (int ai = 0; ai < 2; ++ai) {
                f32x4 xa[4], xb[4];
#pragma unroll
                for (int m = 0; m < 4; ++m) { const size_t off = (size_t)(u.pm * BM + ai * HALF + wr * 64 + m * 16 + fr) * 2048 + col; xa[m] = *(const f32x4*)(X + off); xb[m] = *(const f32x4*)(X + off + 4); }
#pragma unroll
                for (int m = 0; m < 4; ++m) {
                    const size_t off = (size_t)(u.pm * BM + ai * HALF + wr * 64 + m * 16 + fr) * 2048 + col;
                    const float sa = epl[ai * HALF + wr * 64 + m * 16 + fr];
                    *(f32x4*)(R + off) = xa[m] * alpha + (ga * sa) * __builtin_convertvector(acc[ai][bj][m][0], f32x4); *(f32x4*)(R + off + 4) = xb[m] * alpha + (gb * sa) * __builtin_convertvector(acc[ai][bj][m][1], f32x4);
                }
            }
        }
    }
};
struct EpiUp {
    typedef f32x4 AccT; static constexpr bool PERM = true, AFTER_DRAIN = false;
    __device__ __forceinline__ void stage(const Unit&, int, int) const {}
    const float* bup; bf16_t* ACT;
    __device__ __forceinline__ void operator()(const f32x4 (&acc)[2][2][4][2], const Unit& u, int wr, int wc, int fr, int fq) const {
        const int e = u.pb >> 4, col = u.pn * 128 + wc * 32 + 8 * fq;
        const float* bg = bup + (size_t)e * 4096 + col; const float* bl = bg + 2048;
        const f32x4 bg0 = *(const f32x4*)bg, bg1 = *(const f32x4*)(bg + 4), bl0 = *(const f32x4*)bl, bl1 = *(const f32x4*)(bl + 4);
#pragma unroll
        for (int ai = 0; ai < 2; ++ai)
#pragma unroll
            for (int m = 0; m < 4; ++m) {
                const size_t off = (size_t)(u.pm * BM + ai * HALF + wr * 64 + m * 16 + fr) * 2048 + col;
                f32x4 g0 = acc[ai][0][m][0] + bg0, g1 = acc[ai][0][m][1] + bg1, l0 = acc[ai][1][m][0] + bl0, l1 = acc[ai][1][m][1] + bl1, o0, o1;
#pragma unroll
                for (int i = 0; i < 4; ++i) {
                    const float xg0 = fminf(g0[i], 7.0f), xl0 = fminf(fmaxf(l0[i], -7.0f), 7.0f); o0[i] = xg0 * sigmoidf_fast(1.702f * xg0) * (xl0 + 1.0f);
                    const float xg1 = fminf(g1[i], 7.0f), xl1 = fminf(fmaxf(l1[i], -7.0f), 7.0f); o1[i] = xg1 * sigmoidf_fast(1.702f * xg1) * (xl1 + 1.0f);
                }
                *(u32x4*)(ACT + off) = pack8(o0, o1);
            }
    }
};
struct EpiUpQ {
    typedef i32x4 AccT; static constexpr bool PERM = true, AFTER_DRAIN = false;
    const float* bup; unsigned char* ACTP; const float* SA; const float* SB; const int* pos_slot; const PG8_LAS int* cnt; const PG8_LAS int* pstart; float* RMAXP; const PG8_LAS float* sclL; PG8_LAS float* epl;
    __device__ __forceinline__ void stage(const Unit& u, int wid, int lane) const { const int e = u.pb >> 4;
        const float* p = wid < 2 ? bup + (size_t)e * 4096 + u.pn * 128 + wid * 64 : wid < 4 ? bup + (size_t)e * 4096 + 2048 + u.pn * 128 + (wid - 2) * 64 : SB + (size_t)e * 4096 + u.pn * 256 + (wid - 4) * 64;
        __builtin_amdgcn_global_load_lds((const unsigned*)(p + (unsigned)lane), (PG8_LAS unsigned*)(epl + wid * 64), 4, 0, 0); }
    __device__ __forceinline__ void operator()(const i32x4 (&acc)[2][2][4][2], const Unit& u, int wr, int wc, int fr, int fq) const {
        const int e = u.pb >> 4, col = u.pn * 128 + wc * 32 + 8 * fq, lim = pstart[e] + cnt[e], vb = e * 16384 - pstart[e]; (void)e;
        const PG8_LAS float* ec = epl + wc * 32 + 8 * fq;
        const f32x4 bg0 = *(const PG8_LAS f32x4*)ec, bg1 = *(const PG8_LAS f32x4*)(ec + 4), bl0 = *(const PG8_LAS f32x4*)(ec + 128), bl1 = *(const PG8_LAS f32x4*)(ec + 132);
        const f32x4 sg0 = *(const PG8_LAS f32x4*)(ec + 256), sg1 = *(const PG8_LAS f32x4*)(ec + 260), sl0 = *(const PG8_LAS f32x4*)(ec + 384), sl1 = *(const PG8_LAS f32x4*)(ec + 388);
#pragma unroll
        for (int ai = 0; ai < 2; ++ai) if (!(u.half && ai != u.half - 1))
#pragma unroll
            for (int m = 0; m < 4; ++m) {
                const int pos = u.pm * BM + ai * HALF + wr * 64 + m * 16 + fr; const size_t off = (size_t)pos * 2048 + col;
                const float sa = sclL[u.ord * 256 + ai * HALF + wr * 64 + m * 16 + fr]; (void)lim; (void)vb;
                const f32x4 g0 = __builtin_convertvector(acc[ai][0][m][0], f32x4) * (sg0 * sa) + bg0, g1 = __builtin_convertvector(acc[ai][0][m][1], f32x4) * (sg1 * sa) + bg1;
                const f32x4 l0 = __builtin_convertvector(acc[ai][1][m][0], f32x4) * (sl0 * sa) + bl0, l1 = __builtin_convertvector(acc[ai][1][m][1], f32x4) * (sl1 * sa) + bl1;
                f32x4 xg0, xg1, xl0, xl1;
#pragma unroll
                for (int i = 0; i < 4; ++i) { xg0[i] = fminf(g0[i], 7.0f); xg1[i] = fminf(g1[i], 7.0f); xl0[i] = __builtin_amdgcn_fmed3f(l0[i], -7.0f, 7.0f); xl1[i] = __builtin_amdgcn_fmed3f(l1[i], -7.0f, 7.0f); }
                const f32x4 t0 = xg0 * -2.4554669595930157f, t1 = xg1 * -2.4554669595930157f;
                f32x4 e0, e1;
#pragma unroll
                for (int i = 0; i < 4; ++i) { e0[i] = __builtin_amdgcn_exp2f(t0[i]); e1[i] = __builtin_amdgcn_exp2f(t1[i]); }
                const f32x4 d0 = e0 + 1.0f, d1 = e1 + 1.0f;
                f32x4 r0, r1;
#pragma unroll
                for (int i = 0; i < 4; ++i) { r0[i] = __builtin_amdgcn_rcpf(d0[i]); r1[i] = __builtin_amdgcn_rcpf(d1[i]); }
                const f32x4 o0 = (xg0 * r0) * (xl0 + 1.0f), o1 = (xg1 * r1) * (xl1 + 1.0f);
                float mx = fmaxf(fmaxf(fmaxf(fabsf(o0[0]), fabsf(o0[1])), fmaxf(fabsf(o0[2]), fabsf(o0[3]))), fmaxf(fmaxf(fabsf(o1[0]), fabsf(o1[1])), fmaxf(fabsf(o1[2]), fabsf(o1[3]))));
                mx = lane_max_16_32(mx);
                const float qi = mx > 0.f ? 127.0f * __builtin_amdgcn_rcpf(mx) : 0.f;
                const f32x4 q0 = o0 * qi + 12582912.0f, q1 = o1 * qi + 12582912.0f;
                typedef unsigned u2_t __attribute__((ext_vector_type(2))); u2_t w;
                w.x = __builtin_amdgcn_perm(__builtin_amdgcn_perm(__float_as_uint(q0[3]), __float_as_uint(q0[2]), 0x0c0c0400u), __builtin_amdgcn_perm(__float_as_uint(q0[1]), __float_as_uint(q0[0]), 0x0c0c0400u), 0x05040100u);
                w.y = __builtin_amdgcn_perm(__builtin_amdgcn_perm(__float_as_uint(q1[3]), __float_as_uint(q1[2]), 0x0c0c0400u), __builtin_amdgcn_perm(__float_as_uint(q1[1]), __float_as_uint(q1[0]), 0x0c0c0400u), 0x05040100u);
                *(u2_t*)(ACTP + off) = w;
                if (fq == 0) RMAXP[((size_t)pos * 16 + u.pn) * 4 + wc] = mx;
            }
    }
};
struct EpiDown {
    typedef f32x4 AccT; static constexpr bool PERM = true, AFTER_DRAIN = false;
    __device__ __forceinline__ void stage(const Unit&, int, int) const {}
    const float* bdn; bf16_t* YS; const int* pos_slot; const float* pos_gate; const PG8_LAS int* cnt; const PG8_LAS int* pstart;
    __device__ __forceinline__ void operator()(const f32x4 (&acc)[2][2][4][2], const Unit& u, int wr, int wc, int fr, int fq) const {
        const int e = u.pb >> 3; const int lim = pstart[e] + cnt[e], vb = e * 16384 - pstart[e];
        f32x4 bv[2][2];
#pragma unroll
        for (int bj = 0; bj < 2; ++bj) { const float* bp = bdn + (size_t)e * 2048 + u.pn * BM + bj * HALF + wc * 32 + 8 * fq; bv[bj][0] = *(const f32x4*)bp; bv[bj][1] = *(const f32x4*)(bp + 4); }
#pragma unroll
        for (int ai = 0; ai < 2; ++ai)
#pragma unroll
            for (int m = 0; m < 4; ++m) {
                const int pos = u.pm * BM + ai * HALF + wr * 64 + m * 16 + fr;
                if (pos < lim) {
                    const int slot = pos_slot[vb + pos]; const float gt = pos_gate[vb + pos];
#pragma unroll
                    for (int bj = 0; bj < 2; ++bj) {
                        const f32x4 o0 = (acc[ai][bj][m][0] + bv[bj][0]) * gt, o1 = (acc[ai][bj][m][1] + bv[bj][1]) * gt;
                        *(u32x4*)(YS + (size_t)slot * 2048 + u.pn * BM + bj * HALF + wc * 32 + 8 * fq) = pack8(o0, o1);
                    }
                }
            }
    }
};
struct EpiDownQ {
    typedef i32x4 AccT; static constexpr bool PERM = true, AFTER_DRAIN = false;
    const float* bdn; bf16_t* YS; const int* pos_slot; const float* pos_gate; const PG8_LAS int* cnt; const PG8_LAS int* pstart; const float* SACT; const float* SBD; PG8_LAS float* epl; int probe_skip = 0;
    __device__ __forceinline__ void stage(const Unit& u, int wid, int lane) const { const int e = u.pb >> 3;
        if (wid < 4) { const int lim = pstart[e] + cnt[e], r0 = u.pm * BM + wid * 64; const int row = min(r0 + lane, lim - 1); const size_t vb = (size_t)(e * 16384 - pstart[e]);
            __builtin_amdgcn_global_load_lds((const unsigned*)(pos_gate + vb) + (unsigned)row, (PG8_LAS unsigned*)(epl + wid * 64), 4, 0, 0);
            __builtin_amdgcn_global_load_lds((const unsigned*)SACT + (unsigned)row, (PG8_LAS unsigned*)(epl + 256 + wid * 64), 4, 0, 0); }
        else { const size_t ci = (size_t)e * 2048 + u.pn * BM + (wid - 4) * 64;
            __builtin_amdgcn_global_load_lds((const unsigned*)(bdn + ci) + (unsigned)lane, (PG8_LAS unsigned*)(epl + 512 + (wid - 4) * 64), 4, 0, 0);
            __builtin_amdgcn_global_load_lds((const unsigned*)(SBD + ci) + (unsigned)lane, (PG8_LAS unsigned*)(epl + 768 + (wid - 4) * 64), 4, 0, 0); } }
    __device__ __forceinline__ void operator()(const i32x4 (&acc)[2][2][4][2], const Unit& u, int wr, int wc, int fr, int fq) const {
        if (probe_skip) return;
        f32x4 bv[2][2], sv[2][2];
#pragma unroll
        for (int bj = 0; bj < 2; ++bj) { const PG8_LAS float* ec = epl + 512 + bj * HALF + wc * 32 + 8 * fq; bv[bj][0] = *(const PG8_LAS f32x4*)ec; bv[bj][1] = *(const PG8_LAS f32x4*)(ec + 4);
            sv[bj][0] = *(const PG8_LAS f32x4*)(ec + 256); sv[bj][1] = *(const PG8_LAS f32x4*)(ec + 260); }
#pragma unroll
        for (int ai = 0; ai < 2; ++ai) if (!(u.half && ai != u.half - 1))
#pragma unroll
            for (int m = 0; m < 4; ++m) {
                const int r = ai * HALF + wr * 64 + m * 16 + fr; const float gt = epl[r], sa = epl[256 + r];
                bf16_t* yr = YS + (size_t)(u.pm * BM + r) * 2048 + u.pn * BM + wc * 32 + 8 * fq;
#pragma unroll
                for (int bj = 0; bj < 2; ++bj) {
                    const f32x4 o0 = (__builtin_convertvector(acc[ai][bj][m][0], f32x4) * (sv[bj][0] * sa) + bv[bj][0]) * gt, o1 = (__builtin_convertvector(acc[ai][bj][m][1], f32x4) * (sv[bj][1] * sa) + bv[bj][1]) * gt;
                    *(u32x4*)(yr + bj * HALF) = pack8(o0, o1);
                }
            }
    }
};
}
namespace attn_body {
using bf16=__hip_bfloat16;
using bf16x8=__attribute__((ext_vector_type(8)))short;
using s16x4=__attribute__((ext_vector_type(4)))short;
using f32x16=__attribute__((ext_vector_type(16)))float;
using u32x4=__attribute__((ext_vector_type(4)))unsigned;
constexpr int D=64;
constexpr int NW=8,QBLK=32,QB=QBLK*NW,KVBLK=64;
constexpr int ATTN_UNIT_ROWS=QB;
__device__ __forceinline__ int crow(int r,int hi){return (r&3)+8*(r>>2)+4*hi;}
#define SBAR() __builtin_amdgcn_sched_barrier(0)
__device__ __forceinline__ void wmask(f32x16&p0,f32x16&p1,int kpos0,int qpos,int hi){
  const float NEG=-INFINITY; const int kb=kpos0+4*hi-qpos;
  #pragma unroll
  for(int r=0;r<16;++r){const int d=kb+(r&3)+8*(r>>2); if(d>128||d<-128)p0[r]=NEG; if(d+32>128||d+32<-128)p1[r]=NEG;}
}
constexpr int NSLOT=3, SLOTB=8192;
constexpr int LDS_K=0, LDS_V=NSLOT*SLOTB, LDS_WS=2*NSLOT*SLOTB, LDS_OST=LDS_WS+NW*64*4, LDS_BYTES=LDS_OST+NW*4096;
constexpr float C2=0.125f*1.4426950408889634f;
__device__ __forceinline__ void glds16(const void*gsrc,unsigned lds_dst){unsigned keep;
  asm volatile("s_mov_b32 %0, m0\n\ts_mov_b32 m0, %2\n\ts_nop 0\n\tglobal_load_lds_dwordx4 %1, off\n\ts_mov_b32 m0, %0":"=&s"(keep):"v"(gsrc),"s"(lds_dst):"memory");}
__device__ __forceinline__ float max3f(float a,float b,float c){float r;asm("v_max3_f32 %0, %1, %2, %3":"=v"(r):"v"(a),"v"(b),"v"(c));return r;}
__device__ __forceinline__ float max2f(float a,float b){float r;asm("v_max_f32_e32 %0, %1, %2":"=v"(r):"v"(a),"v"(b));return r;}
__device__ __forceinline__ float fadd_s(float a,float b){float r;asm("v_add_f32_e32 %0, %1, %2":"=v"(r):"v"(a),"v"(b));return r;}
__device__ __forceinline__ float fsub_s(float a,float b){float r;asm("v_sub_f32_e32 %0, %1, %2":"=v"(r):"v"(a),"v"(b));return r;}
typedef float f32x2_t __attribute__((ext_vector_type(2))); typedef __bf16 bf16x2_t __attribute__((ext_vector_type(2)));
__device__ __forceinline__ unsigned cvtpk_s(float lo,float hi){f32x2_t v={lo,hi};bf16x2_t b=__builtin_convertvector(v,bf16x2_t);return __builtin_bit_cast(unsigned,b);}
#define WAIT_BAR(N) asm volatile("s_waitcnt vmcnt(" #N ") lgkmcnt(0)\n\ts_barrier":::"memory")

__device__ __forceinline__ void qkt(f32x16&p0,f32x16&p1,const char*Kslot,const bf16x8*qr,const f32x16&negm,int r32,int hi){
  const char*kb=Kslot+hi*1024+r32*16;
  #pragma unroll
  for(int d0=0;d0<4;++d0){
    const bf16x8 b0=*reinterpret_cast<const bf16x8*>(kb+d0*2048);
    const bf16x8 b1=*reinterpret_cast<const bf16x8*>(kb+d0*2048+512);
    if(d0==0){p0=__builtin_amdgcn_mfma_f32_32x32x16_bf16(b0,qr[0],negm,0,0,0);p1=__builtin_amdgcn_mfma_f32_32x32x16_bf16(b1,qr[0],negm,0,0,0);}
    else{p0=__builtin_amdgcn_mfma_f32_32x32x16_bf16(b0,qr[d0],p0,0,0,0);p1=__builtin_amdgcn_mfma_f32_32x32x16_bf16(b1,qr[d0],p1,0,0,0);}}
}
typedef __attribute__((address_space(3))) const char* lds_cptr;
typedef short v4i16_t __attribute__((ext_vector_type(4)));
__device__ __forceinline__ void kload8(bf16x8*kf,lds_cptr kp){
  kf[0]=*(const __attribute__((address_space(3))) bf16x8*)(kp);      kf[1]=*(const __attribute__((address_space(3))) bf16x8*)(kp+512);
  kf[2]=*(const __attribute__((address_space(3))) bf16x8*)(kp+2048); kf[3]=*(const __attribute__((address_space(3))) bf16x8*)(kp+2560);
  kf[4]=*(const __attribute__((address_space(3))) bf16x8*)(kp+4096); kf[5]=*(const __attribute__((address_space(3))) bf16x8*)(kp+4608);
  kf[6]=*(const __attribute__((address_space(3))) bf16x8*)(kp+6144); kf[7]=*(const __attribute__((address_space(3))) bf16x8*)(kp+6656);
}
__device__ __forceinline__ void kload2(bf16x8*kf,lds_cptr kp,int j){ kf[2*j]=*(const __attribute__((address_space(3))) bf16x8*)(kp+j*2048); kf[2*j+1]=*(const __attribute__((address_space(3))) bf16x8*)(kp+j*2048+512); }
__device__ __forceinline__ s16x4 vtr(lds_cptr p){ return __builtin_bit_cast(s16x4,__builtin_amdgcn_ds_read_tr16_b64_v4i16((__attribute__((address_space(3))) v4i16_t*)p)); }
__device__ __forceinline__ float rowmax(const f32x16&p0,const f32x16&p1){
  float a=max3f(p0[0],p0[1],p1[0]),b=max3f(p0[2],p0[3],p1[1]);a=max3f(a,p1[2],p1[3]);
  #pragma unroll
  for(int r=4;r<16;r+=4){a=max3f(a,p0[r],p0[r+1]);b=max3f(b,p0[r+2],p0[r+3]);a=max3f(a,p1[r],p1[r+1]);b=max3f(b,p1[r+2],p1[r+3]);}
  const float m=max2f(a,b);
  auto rr=__builtin_amdgcn_permlane32_swap(__float_as_uint(m),__float_as_uint(m),false,false);
  return max2f(__uint_as_float(rr[0]),__uint_as_float(rr[1]));
}
__device__ __forceinline__ void pv(f32x16*o,int vb,bf16x8 pa0,bf16x8 pa1,bf16x8 pa2,bf16x8 pa3){
  #pragma unroll
  for(int d0=0;d0<2;++d0){s16x4 lo[4],hi[4];
    #pragma unroll
    for(int ks=0;ks<4;++ks){
      asm volatile("ds_read_b64_tr_b16 %0,%1 offset:%c2":"=&v"(lo[ks]):"v"(vb),"i"(d0*4096+ks*1024):"memory");
      asm volatile("ds_read_b64_tr_b16 %0,%1 offset:%c2":"=&v"(hi[ks]):"v"(vb),"i"(d0*4096+ks*1024+512):"memory");}
    asm volatile("s_waitcnt lgkmcnt(0)":::"memory");SBAR();
    #define PK(k) (bf16x8){lo[k][0],lo[k][1],lo[k][2],lo[k][3],hi[k][0],hi[k][1],hi[k][2],hi[k][3]}
    o[d0]=__builtin_amdgcn_mfma_f32_32x32x16_bf16(pa0,PK(0),o[d0],0,0,0);
    o[d0]=__builtin_amdgcn_mfma_f32_32x32x16_bf16(pa1,PK(1),o[d0],0,0,0);
    o[d0]=__builtin_amdgcn_mfma_f32_32x32x16_bf16(pa2,PK(2),o[d0],0,0,0);
    o[d0]=__builtin_amdgcn_mfma_f32_32x32x16_bf16(pa3,PK(3),o[d0],0,0,0);
    #undef PK
  }
}

#ifndef ATTN_STORE16
#define ATTN_STORE16(p,v) (*(u32x4*)(p)=(v))
#endif
struct AttnArgs { const bf16* Qw0; const bf16* Kh; const bf16* Vh; bf16* Ow0; int NT; int win0; int qpos0; float sinkl2; };
template<class C,int THRL> __device__ __forceinline__ void attn_unit(const AttnArgs& aa,char*shm){
  int tid_=threadIdx.x; asm volatile("":"+v"(tid_)); const int tid=tid_,lane=tid&63,r32=lane&31,hi=lane>>5; const int wid=__builtin_amdgcn_readfirstlane(tid>>6);
  const bf16*Qw=aa.Qw0+(long)(wid*QBLK)*C::QP;
  const bf16*Kh=aa.Kh,*Vh=aa.Vh; const int win0=aa.win0;
  const unsigned lds0=(unsigned)(uintptr_t)shm;
  float*wsf=(float*)(shm+LDS_WS)+wid*64;
  const bf16*ksrc=Kh+(long)lane*C::KP+wid*8;
  const bf16*vsrc=Vh+(long)(16*(wid&3)+(lane>>2))*C::VP+(wid>>2)*32+(lane&3)*8;
  const unsigned kdst=lds0+LDS_K+wid*1024, vdst=lds0+LDS_V+wid*1024;
  #define KROW(t) (C::MASK ? ((t)<4 ? 4096+64*(t) : win0+64*((t)-4)) : 64*(t))
  #define DMA_K(t,slot) glds16(ksrc+(long)KROW(t)*C::KP,(unsigned)__builtin_amdgcn_readfirstlane(kdst+(slot)))
  #define DMA_V(t,slot) glds16(vsrc+(long)KROW(t)*C::VP,(unsigned)__builtin_amdgcn_readfirstlane(vdst+(slot)))
  const int vb0=(int)(lds0+LDS_V)+((lane>>4)&1)*32+(lane&3)*8+(4*hi+((lane&15)>>2))*64;
  const char*Kbase=shm+LDS_K; bf16x8 kf[8];
  const lds_cptr shm3=(lds_cptr)shm; const lds_cptr kp0=shm3+LDS_K+hi*1024+r32*16; const lds_cptr vp0=shm3+LDS_V+((lane>>4)&1)*32+(lane&3)*8+(4*hi+((lane&15)>>2))*64;
  const int NT=aa.NT;
  DMA_K(0,0);DMA_V(0,0);DMA_K(1,SLOTB);
  bf16x8 qr[4];
  #pragma unroll
  for(int d0=0;d0<4;++d0)qr[d0]=*reinterpret_cast<const bf16x8*>(&Qw[(long)r32*C::QP+d0*16+hi*8]);
  float mhat=0.f,l_reg=0.f;f32x16 o[2];o[0]=f32x16{};o[1]=f32x16{};f32x16 negm=f32x16{};asm volatile("":"+v"(negm));
  const int qpos=aa.qpos0+wid*QBLK+r32;
  #define CMASK(P0,P1,t) do{ if(C::MASK){ if((t)>=4) wmask(P0,P1,win0+64*((t)-4),qpos,hi); } }while(0)
  bool resc=false;
  #define START(P0,P1) do{ const float rm=rowmax(P0,P1); resc=false; \
    { const float dl=rm; mhat=fadd_s(mhat,dl); \
      _Pragma("unroll") for(int r=0;r<16;++r){P0[r]=fsub_s(P0[r],dl);P1[r]=fsub_s(P1[r],dl);} \
      _Pragma("unroll") for(int r=0;r<16;++r)negm[r]=-mhat; asm volatile("":"+v"(negm)); } \
    _Pragma("unroll") for(int r=0;r<16;++r)P0[r]=__builtin_amdgcn_exp2f(P0[r]); }while(0)
  #define RESC() do{ if(resc){ asm volatile("s_waitcnt lgkmcnt(0)":::"memory"); \
      _Pragma("unroll") for(int d_=0;d_<2;++d_) _Pragma("unroll") for(int r=0;r<16;++r)o[d_][r]*=wsf[crow(r,hi)]; } }while(0)
  f32x16 pA0,pA1,pB0,pB1;
  int sl_prev=0,sl_cur=0,sl_next=SLOTB;
  #define ROT() do{sl_prev=sl_cur;sl_cur=sl_next;sl_next=(sl_next==(NSLOT-1)*SLOTB)?0:sl_next+SLOTB;}while(0)
  DMA_K(2,2*SLOTB);
  WAIT_BAR(3);
  qkt(pA0,pA1,Kbase,qr,negm,r32,hi);asm volatile("s_nop 15\n\ts_nop 7":"+v"(pA0),"+v"(pA1));CMASK(pA0,pA1,0);
  START(pA0,pA1);
  _Pragma("unroll") for(int r=0;r<16;++r)pA1[r]=__builtin_amdgcn_exp2f(pA1[r]);
  WAIT_BAR(0);
  DMA_K(3,0);DMA_V(1,SLOTB);
  ROT();
  kload8(kf,kp0+sl_cur);
  WAIT_BAR(2);
  s16x4 vlo[8],vhi[8]; u32x4 pw0,pw1,pw2,pw3;
  #define PKW(P,B) cvtpk_s(P[B],P[B+1])
  #define PAF(k) __builtin_bit_cast(bf16x8,pw##k)
  #define VFR(i) (bf16x8){vlo[i][0],vlo[i][1],vlo[i][2],vlo[i][3],vhi[i][0],vhi[i][1],vhi[i][2],vhi[i][3]}
  #define PIN(x) asm volatile("":"+v"(x))
  #define MX3(a,b,c) __builtin_fmaxf(__builtin_fmaxf((a),(b)),(c))
  #define GAPA(MF,A0,A1,A2,A3,W0,W1,PW) do{ MF; sacc+=A0; sacc+=A1; sacc+=A2; sacc+=A3; PIN(sacc); W0; W1; PIN(PW); SBAR(); }while(0)
  #define EX(v) __builtin_amdgcn_exp2f(v)
  #define GAPB(MF,X,B) do{ MF; X[B]=EX(X[B]); X[B+1]=EX(X[B+1]); X[B+2]=EX(X[B+2]); X[B+3]=EX(X[B+3]); PIN(X); SBAR(); }while(0)
  #define VRD(i) do{ vlo[i]=vtr(vp_+(((i)>>2)*4096+((i)&3)*1024)); vhi[i]=vtr(vp_+(((i)>>2)*4096+((i)&3)*1024+512)); }while(0)
  #define KRD(G,j) do{ if(G){ kload2(kf,kp0+sl_next,j); SBAR(); } }while(0)
  #define STEP(C0,C1,P0,P1,t,GK,GV,GL) do{ SBAR(); \
    const lds_cptr vp_=vp0+sl_prev; \
    VRD(0); SBAR(); float sacc=(P0[0]+P0[1]); \
    GAPA(C0=__builtin_amdgcn_mfma_f32_32x32x16_bf16(kf[0],qr[0],negm,0,0,0), P0[2],P0[3],P0[4],P0[5],     pw0[0]=PKW(P0,0), pw0[1]=PKW(P0,2), pw0); \
    VRD(4); SBAR(); GAPA(C1=__builtin_amdgcn_mfma_f32_32x32x16_bf16(kf[1],qr[0],negm,0,0,0), P0[6],P0[7],P0[8],P0[9],     pw0[2]=PKW(P0,4), pw0[3]=PKW(P0,6), pw0); \
    VRD(1); SBAR(); GAPA(C0=__builtin_amdgcn_mfma_f32_32x32x16_bf16(kf[2],qr[1],C0,0,0,0),   P0[10],P0[11],P0[12],P0[13], pw1[0]=PKW(P0,8), pw1[1]=PKW(P0,10), pw1); \
    VRD(5); SBAR(); GAPA(C1=__builtin_amdgcn_mfma_f32_32x32x16_bf16(kf[3],qr[1],C1,0,0,0),   P0[14],P0[15],P1[0],P1[1],   pw1[2]=PKW(P0,12),pw1[3]=PKW(P0,14), pw1); \
    VRD(2); SBAR(); GAPA(C0=__builtin_amdgcn_mfma_f32_32x32x16_bf16(kf[4],qr[2],C0,0,0,0),   P1[2],P1[3],P1[4],P1[5],     pw2[0]=PKW(P1,0), pw2[1]=PKW(P1,2), pw2); \
    VRD(6); SBAR(); GAPA(C1=__builtin_amdgcn_mfma_f32_32x32x16_bf16(kf[5],qr[2],C1,0,0,0),   P1[6],P1[7],P1[8],P1[9],     pw2[2]=PKW(P1,4), pw2[3]=PKW(P1,6), pw2); \
    VRD(3); SBAR(); GAPA(C0=__builtin_amdgcn_mfma_f32_32x32x16_bf16(kf[6],qr[3],C0,0,0,0),   P1[10],P1[11],P1[12],P1[13], pw3[0]=PKW(P1,8), pw3[1]=PKW(P1,10), pw3); \
    VRD(7); SBAR(); GAPA(C1=__builtin_amdgcn_mfma_f32_32x32x16_bf16(kf[7],qr[3],C1,0,0,0),   P1[14],P1[15],0.f,0.f,       pw3[2]=PKW(P1,12),pw3[3]=PKW(P1,14), pw3); \
    l_reg+=sacc; \
    if(GK){DMA_K((t)+3,sl_cur);} if(GV){DMA_V((t)+1,sl_next);} \
    CMASK(C0,C1,t); \
    { float a=MX3(C0[0],C0[1],C1[0]),b=MX3(C0[2],C0[3],C1[1]); a=MX3(a,C1[2],C1[3]); \
      _Pragma("unroll") for(int r=4;r<16;r+=4){a=MX3(a,C0[r],C0[r+1]);b=MX3(b,C0[r+2],C0[r+3]);a=MX3(a,C1[r],C1[r+1]);b=MX3(b,C1[r+2],C1[r+3]);} \
      float rm=__builtin_fmaxf(a,b); { auto rr=__builtin_amdgcn_permlane32_swap(__float_as_uint(rm),__float_as_uint(rm),false,false); rm=__builtin_fmaxf(__uint_as_float(rr[0]),__uint_as_float(rr[1])); } \
      resc=false; \
      if(__builtin_expect(__any(rm>(float)THRL),0)){ const float dl=__builtin_fmaxf(rm,0.f); mhat+=dl; \
        _Pragma("unroll") for(int r=0;r<16;++r){C0[r]-=dl;C1[r]-=dl;} \
        _Pragma("unroll") for(int r=0;r<16;++r)negm[r]=-mhat; asm volatile("":"+v"(negm)); \
        const float f=__builtin_amdgcn_exp2f(-dl); l_reg*=f; if(hi==0)wsf[r32]=f; resc=true; } } \
    SBAR(); \
    GAPB(o[0]=__builtin_amdgcn_mfma_f32_32x32x16_bf16(PAF(0),VFR(0),o[0],0,0,0), C0,0); \
    GAPB(o[1]=__builtin_amdgcn_mfma_f32_32x32x16_bf16(PAF(0),VFR(4),o[1],0,0,0), C0,4); \
    KRD(GL,0); GAPB(o[0]=__builtin_amdgcn_mfma_f32_32x32x16_bf16(PAF(1),VFR(1),o[0],0,0,0), C0,8); \
    KRD(GL,1); GAPB(o[1]=__builtin_amdgcn_mfma_f32_32x32x16_bf16(PAF(1),VFR(5),o[1],0,0,0), C0,12); \
    KRD(GL,2); GAPB(o[0]=__builtin_amdgcn_mfma_f32_32x32x16_bf16(PAF(2),VFR(2),o[0],0,0,0), C1,0); \
    KRD(GL,3); GAPB(o[1]=__builtin_amdgcn_mfma_f32_32x32x16_bf16(PAF(2),VFR(6),o[1],0,0,0), C1,4); \
    GAPB(o[0]=__builtin_amdgcn_mfma_f32_32x32x16_bf16(PAF(3),VFR(3),o[0],0,0,0), C1,8); \
    GAPB(o[1]=__builtin_amdgcn_mfma_f32_32x32x16_bf16(PAF(3),VFR(7),o[1],0,0,0), C1,12); \
    }while(0)
  int t=1;
  #undef CMASK
  #define CMASK(P0,P1,t) do{ if(C::MASK){ if((t)>=4) wmask(P0,P1,win0+64*((t)-4),qpos,hi); } }while(0)
  for(;t+5<NT;t+=2){
    STEP(pB0,pB1,pA0,pA1,t,true,true,true);     WAIT_BAR(2); RESC(); ROT();
    STEP(pA0,pA1,pB0,pB1,t+1,true,true,true);   WAIT_BAR(2); RESC(); ROT();
  }
  #undef CMASK
  #define CMASK(P0,P1,t) do{ if(C::MASK){ if((t)>=4) wmask(P0,P1,win0+64*((t)-4),qpos,hi); } }while(0)
  #define ENDW(tt) do{ if((tt)+3<NT){WAIT_BAR(2);} else if((tt)+2<NT){WAIT_BAR(1);} else {WAIT_BAR(0);} }while(0)
  for(;t+1<NT;t+=2){
    STEP(pB0,pB1,pA0,pA1,t,(t+3<NT),(t+1<NT),(t+1<NT));       ENDW(t);   RESC(); ROT();
    STEP(pA0,pA1,pB0,pB1,t+1,(t+4<NT),(t+2<NT),(t+2<NT));     ENDW(t+1); RESC(); ROT();
  }
  STEP(pB0,pB1,pA0,pA1,NT-1,false,false,false); RESC();
  { float sacc=pB0[0]+pB0[1]; _Pragma("unroll") for(int r=2;r<16;++r)sacc+=pB0[r]; _Pragma("unroll") for(int r=0;r<16;++r)sacc+=pB1[r]; l_reg+=sacc;
    pw0=(u32x4){PKW(pB0,0),PKW(pB0,2),PKW(pB0,4),PKW(pB0,6)};pw1=(u32x4){PKW(pB0,8),PKW(pB0,10),PKW(pB0,12),PKW(pB0,14)};pw2=(u32x4){PKW(pB1,0),PKW(pB1,2),PKW(pB1,4),PKW(pB1,6)};pw3=(u32x4){PKW(pB1,8),PKW(pB1,10),PKW(pB1,12),PKW(pB1,14)};
    SBAR(); pv(o,vb0+sl_cur,PAF(0),PAF(1),PAF(2),PAF(3)); }
  #undef PKW
  #undef PAF
  #undef VFR
  #undef PIN
  #undef MX3
  #undef GAPA
  #undef GAPB
  #undef EX
  #undef VRD
  #undef KRD
  #undef STEP
  #undef ENDW
  {auto rr=__builtin_amdgcn_permlane32_swap(__float_as_uint(l_reg),__float_as_uint(l_reg),false,false);l_reg=__uint_as_float(rr[0])+__uint_as_float(rr[1]);}
  if(C::MASK) l_reg+=__builtin_amdgcn_exp2f(aa.sinkl2-mhat);
  if(hi==0)wsf[32+r32]=l_reg;asm volatile("s_waitcnt lgkmcnt(0)":::"memory");
  float rli[16];
  #pragma unroll
  for(int r=0;r<16;++r)rli[r]=__builtin_amdgcn_rcpf(wsf[32+crow(r,hi)]);
  bf16*Ow=aa.Ow0+(long)(wid*QBLK)*C::OP;
  { bf16*stg=(bf16*)(shm+LDS_OST)+wid*2048;
    #pragma unroll
    for(int r=0;r<16;++r){const int orow=crow(r,hi);
      #pragma unroll
      for(int d0=0;d0<2;++d0)stg[orow*64+d0*32+r32]=__float2bfloat16(o[d0][r]*rli[r]);}
    asm volatile("s_waitcnt lgkmcnt(0)":::"memory");
    #pragma unroll
    for(int i=0;i<4;++i){const int row=i*8+(lane>>3),ch=lane&7; const u32x4 v=*(const u32x4*)(stg+row*64+ch*8); ATTN_STORE16(Ow+(long)row*C::OP+ch*8,v);} }
  asm volatile("s_waitcnt lgkmcnt(0)\n\ts_barrier":::"memory");
  #undef DMA_K
  #undef KROW
  #undef DMA_V
  #undef CMASK
  #undef START
  #undef RESC
  #undef ROT
}
__device__ __forceinline__ void pv128(f32x16*o,int vb,bf16x8 pa0,bf16x8 pa1,bf16x8 pa2,bf16x8 pa3){
  #pragma unroll
  for(int d0=0;d0<4;++d0){s16x4 lo[4],hi[4];
    #pragma unroll
    for(int ks=0;ks<4;++ks){
      asm volatile("ds_read_b64_tr_b16 %0,%1 offset:%c2":"=&v"(lo[ks]):"v"(vb),"i"(d0*4096+ks*1024):"memory");
      asm volatile("ds_read_b64_tr_b16 %0,%1 offset:%c2":"=&v"(hi[ks]):"v"(vb),"i"(d0*4096+ks*1024+512):"memory");}
    asm volatile("s_waitcnt lgkmcnt(0)":::"memory");SBAR();
    #define PK(k) (bf16x8){lo[k][0],lo[k][1],lo[k][2],lo[k][3],hi[k][0],hi[k][1],hi[k][2],hi[k][3]}
    o[d0]=__builtin_amdgcn_mfma_f32_32x32x16_bf16(pa0,PK(0),o[d0],0,0,0);
    o[d0]=__builtin_amdgcn_mfma_f32_32x32x16_bf16(pa1,PK(1),o[d0],0,0,0);
    o[d0]=__builtin_amdgcn_mfma_f32_32x32x16_bf16(pa2,PK(2),o[d0],0,0,0);
    o[d0]=__builtin_amdgcn_mfma_f32_32x32x16_bf16(pa3,PK(3),o[d0],0,0,0);
    #undef PK
  }
}
template<class C,int THRL> __device__ __forceinline__ void attn_unit128(const AttnArgs& aa,char*shm){
  constexpr int LDS_K=0, LDS_V=NSLOT*SLOTB, LDS_WS=LDS_V+NSLOT*2*SLOTB, LDS_OST=LDS_WS+NW*64*4;

  int tid_=threadIdx.x; asm volatile("":"+v"(tid_)); const int tid=tid_,lane=tid&63,r32=lane&31,hi=lane>>5; const int wid=__builtin_amdgcn_readfirstlane(tid>>6);
  const bf16*Qw=aa.Qw0+(long)(wid*QBLK)*C::QP;
  const bf16*Kh=aa.Kh,*Vh=aa.Vh; const int win0=aa.win0;
  const unsigned lds0=(unsigned)(uintptr_t)shm;
  float*wsf=(float*)(shm+LDS_WS)+wid*64;
  const bf16*ksrc=Kh+(long)lane*C::KP+wid*8;
  const bf16*vsrc=Vh+(long)(16*(wid&3)+(lane>>2))*C::VP+(wid>>2)*32+(lane&3)*8;
  const unsigned kdst=lds0+LDS_K+wid*1024, vdst=lds0+LDS_V+wid*1024;
  #define KROW(t) (C::MASK ? ((t)<4 ? 4096+64*(t) : win0+64*((t)-4)) : 64*(t))
  #define DMA_K(t,slot) glds16(ksrc+(long)KROW(t)*C::KP,(unsigned)__builtin_amdgcn_readfirstlane(kdst+(slot)))
  #define DMA_V(t,slot) do{ glds16(vsrc+(long)KROW(t)*C::VP,(unsigned)__builtin_amdgcn_readfirstlane(vdst+2*(slot))); glds16(vsrc+(long)KROW(t)*C::VP+64,(unsigned)__builtin_amdgcn_readfirstlane(vdst+2*(slot)+8192)); }while(0)
  const int vb0=(int)(lds0+LDS_V)+((lane>>4)&1)*32+(lane&3)*8+(4*hi+((lane&15)>>2))*64;
  const char*Kbase=shm+LDS_K; bf16x8 kf[8];
  const lds_cptr shm3=(lds_cptr)shm; const lds_cptr kp0=shm3+LDS_K+hi*1024+r32*16; const lds_cptr vp0=shm3+LDS_V+((lane>>4)&1)*32+(lane&3)*8+(4*hi+((lane&15)>>2))*64;
  const int NT=aa.NT;
  DMA_K(0,0);DMA_V(0,0);DMA_K(1,SLOTB);
  bf16x8 qr[4];
  #pragma unroll
  for(int d0=0;d0<4;++d0)qr[d0]=*reinterpret_cast<const bf16x8*>(&Qw[(long)r32*C::QP+d0*16+hi*8]);
  float mhat=0.f,l_reg=0.f;f32x16 o[4];o[0]=f32x16{};o[1]=f32x16{};o[2]=f32x16{};o[3]=f32x16{};f32x16 negm=f32x16{};asm volatile("":"+v"(negm));
  const int qpos=aa.qpos0+wid*QBLK+r32;
  #define CMASK(P0,P1,t) do{ if(C::MASK){ if((t)>=4) wmask(P0,P1,win0+64*((t)-4),qpos,hi); } }while(0)
  bool resc=false;
  #define START(P0,P1) do{ const float rm=rowmax(P0,P1); resc=false; \
    { const float dl=rm; mhat=fadd_s(mhat,dl); \
      _Pragma("unroll") for(int r=0;r<16;++r){P0[r]=fsub_s(P0[r],dl);P1[r]=fsub_s(P1[r],dl);} \
      _Pragma("unroll") for(int r=0;r<16;++r)negm[r]=-mhat; asm volatile("":"+v"(negm)); } \
    _Pragma("unroll") for(int r=0;r<16;++r)P0[r]=__builtin_amdgcn_exp2f(P0[r]); }while(0)
  #define RESC() do{ if(resc){ asm volatile("s_waitcnt lgkmcnt(0)":::"memory"); \
      _Pragma("unroll") for(int d_=0;d_<4;++d_) _Pragma("unroll") for(int r=0;r<16;++r)o[d_][r]*=wsf[crow(r,hi)]; } }while(0)
  f32x16 pA0,pA1,pB0,pB1;
  int sl_prev=0,sl_cur=0,sl_next=SLOTB;
  #define ROT() do{sl_prev=sl_cur;sl_cur=sl_next;sl_next=(sl_next==(NSLOT-1)*SLOTB)?0:sl_next+SLOTB;}while(0)
  DMA_K(2,2*SLOTB);
  WAIT_BAR(3);
  qkt(pA0,pA1,Kbase,qr,negm,r32,hi);asm volatile("s_nop 15\n\ts_nop 7":"+v"(pA0),"+v"(pA1));CMASK(pA0,pA1,0);
  START(pA0,pA1);
  _Pragma("unroll") for(int r=0;r<16;++r)pA1[r]=__builtin_amdgcn_exp2f(pA1[r]);
  WAIT_BAR(0);
  DMA_K(3,0);DMA_V(1,SLOTB);
  ROT();
  kload8(kf,kp0+sl_cur);
  WAIT_BAR(3);
  s16x4 vlo[4],vhi[4]; u32x4 pw0,pw1,pw2,pw3;
  #define PKW(P,B) cvtpk_s(P[B],P[B+1])
  #define PAF(k) __builtin_bit_cast(bf16x8,pw##k)
  #define PIN(x) asm volatile("":"+v"(x))
  #define MX3(a,b,c) __builtin_fmaxf(__builtin_fmaxf((a),(b)),(c))
  #define GAPA(MF,A0,A1,A2,A3,W0,W1,PW) do{ MF; sacc+=A0; sacc+=A1; sacc+=A2; sacc+=A3; PIN(sacc); W0; W1; PIN(PW); SBAR(); }while(0)
  #define EX(v) __builtin_amdgcn_exp2f(v)
  #define GAPB(MF,X,B) do{ MF; X[B]=EX(X[B]); X[B+1]=EX(X[B+1]); PIN(X); SBAR(); }while(0)
  #define VRD(j) do{ vlo[(j)&3]=vtr(vp_+(((j)&3)*4096+((j)>>2)*1024)); vhi[(j)&3]=vtr(vp_+(((j)&3)*4096+((j)>>2)*1024+512)); SBAR(); }while(0)
  #define VFR(j) (bf16x8){vlo[(j)&3][0],vlo[(j)&3][1],vlo[(j)&3][2],vlo[(j)&3][3],vhi[(j)&3][0],vhi[(j)&3][1],vhi[(j)&3][2],vhi[(j)&3][3]}
  #define KRD(G,j) do{ if(G){ kload2(kf,kp0+sl_next,j); SBAR(); } }while(0)
  #define STEP(C0,C1,P0,P1,t,GK,GV,GL) do{ SBAR(); \
    const lds_cptr vp_=vp0+2*sl_prev; \
    float sacc=(P0[0]+P0[1]); \
    GAPA(C0=__builtin_amdgcn_mfma_f32_32x32x16_bf16(kf[0],qr[0],negm,0,0,0), P0[2],P0[3],P0[4],P0[5],     pw0[0]=PKW(P0,0), pw0[1]=PKW(P0,2), pw0); \
    GAPA(C1=__builtin_amdgcn_mfma_f32_32x32x16_bf16(kf[1],qr[0],negm,0,0,0), P0[6],P0[7],P0[8],P0[9],     pw0[2]=PKW(P0,4), pw0[3]=PKW(P0,6), pw0); \
    GAPA(C0=__builtin_amdgcn_mfma_f32_32x32x16_bf16(kf[2],qr[1],C0,0,0,0),   P0[10],P0[11],P0[12],P0[13], pw1[0]=PKW(P0,8), pw1[1]=PKW(P0,10), pw1); \
    GAPA(C1=__builtin_amdgcn_mfma_f32_32x32x16_bf16(kf[3],qr[1],C1,0,0,0),   P0[14],P0[15],P1[0],P1[1],   pw1[2]=PKW(P0,12),pw1[3]=PKW(P0,14), pw1); \
    GAPA(C0=__builtin_amdgcn_mfma_f32_32x32x16_bf16(kf[4],qr[2],C0,0,0,0),   P1[2],P1[3],P1[4],P1[5],     pw2[0]=PKW(P1,0), pw2[1]=PKW(P1,2), pw2); \
    GAPA(C1=__builtin_amdgcn_mfma_f32_32x32x16_bf16(kf[5],qr[2],C1,0,0,0),   P1[6],P1[7],P1[8],P1[9],     pw2[2]=PKW(P1,4), pw2[3]=PKW(P1,6), pw2); \
    VRD(0); GAPA(C0=__builtin_amdgcn_mfma_f32_32x32x16_bf16(kf[6],qr[3],C0,0,0,0),   P1[10],P1[11],P1[12],P1[13], pw3[0]=PKW(P1,8), pw3[1]=PKW(P1,10), pw3); \
    VRD(1); GAPA(C1=__builtin_amdgcn_mfma_f32_32x32x16_bf16(kf[7],qr[3],C1,0,0,0),   P1[14],P1[15],0.f,0.f,       pw3[2]=PKW(P1,12),pw3[3]=PKW(P1,14), pw3); \
    l_reg+=sacc; \
    if(GK){DMA_K((t)+3,sl_cur);} if(GV){DMA_V((t)+1,sl_next);} \
    CMASK(C0,C1,t); \
    { float a=MX3(C0[0],C0[1],C1[0]),b=MX3(C0[2],C0[3],C1[1]); a=MX3(a,C1[2],C1[3]); \
      _Pragma("unroll") for(int r=4;r<16;r+=4){a=MX3(a,C0[r],C0[r+1]);b=MX3(b,C0[r+2],C0[r+3]);a=MX3(a,C1[r],C1[r+1]);b=MX3(b,C1[r+2],C1[r+3]);} \
      float rm=__builtin_fmaxf(a,b); { auto rr=__builtin_amdgcn_permlane32_swap(__float_as_uint(rm),__float_as_uint(rm),false,false); rm=__builtin_fmaxf(__uint_as_float(rr[0]),__uint_as_float(rr[1])); } \
      resc=false; \
      if(__builtin_expect(__any(rm>(float)THRL),0)){ const float dl=__builtin_fmaxf(rm,0.f); mhat+=dl; \
        _Pragma("unroll") for(int r=0;r<16;++r){C0[r]-=dl;C1[r]-=dl;} \
        _Pragma("unroll") for(int r=0;r<16;++r)negm[r]=-mhat; asm volatile("":"+v"(negm)); \
        const float f=__builtin_amdgcn_exp2f(-dl); l_reg*=f; if(hi==0)wsf[r32]=f; resc=true; } } \
    SBAR(); \
    GAPB(o[0]=__builtin_amdgcn_mfma_f32_32x32x16_bf16(PAF(0),VFR(0),o[0],0,0,0),  C0,0);  VRD(2); \
    GAPB(o[1]=__builtin_amdgcn_mfma_f32_32x32x16_bf16(PAF(0),VFR(1),o[1],0,0,0),  C0,2);  VRD(3); \
    GAPB(o[2]=__builtin_amdgcn_mfma_f32_32x32x16_bf16(PAF(0),VFR(2),o[2],0,0,0),  C0,4);  VRD(4); \
    GAPB(o[3]=__builtin_amdgcn_mfma_f32_32x32x16_bf16(PAF(0),VFR(3),o[3],0,0,0),  C0,6);  VRD(5); \
    KRD(GL,0); GAPB(o[0]=__builtin_amdgcn_mfma_f32_32x32x16_bf16(PAF(1),VFR(4),o[0],0,0,0),  C0,8);  VRD(6); \
    GAPB(o[1]=__builtin_amdgcn_mfma_f32_32x32x16_bf16(PAF(1),VFR(5),o[1],0,0,0),  C0,10);  VRD(7); \
    KRD(GL,1); GAPB(o[2]=__builtin_amdgcn_mfma_f32_32x32x16_bf16(PAF(1),VFR(6),o[2],0,0,0),  C0,12);  VRD(8); \
    GAPB(o[3]=__builtin_amdgcn_mfma_f32_32x32x16_bf16(PAF(1),VFR(7),o[3],0,0,0),  C0,14);  VRD(9); \
    KRD(GL,2); GAPB(o[0]=__builtin_amdgcn_mfma_f32_32x32x16_bf16(PAF(2),VFR(8),o[0],0,0,0),  C1,0);  VRD(10); \
    GAPB(o[1]=__builtin_amdgcn_mfma_f32_32x32x16_bf16(PAF(2),VFR(9),o[1],0,0,0),  C1,2);  VRD(11); \
    KRD(GL,3); GAPB(o[2]=__builtin_amdgcn_mfma_f32_32x32x16_bf16(PAF(2),VFR(10),o[2],0,0,0), C1,4);  VRD(12); \
    GAPB(o[3]=__builtin_amdgcn_mfma_f32_32x32x16_bf16(PAF(2),VFR(11),o[3],0,0,0), C1,6);  VRD(13); \
    GAPB(o[0]=__builtin_amdgcn_mfma_f32_32x32x16_bf16(PAF(3),VFR(12),o[0],0,0,0), C1,8);  VRD(14); \
    GAPB(o[1]=__builtin_amdgcn_mfma_f32_32x32x16_bf16(PAF(3),VFR(13),o[1],0,0,0), C1,10);  VRD(15); \
    GAPB(o[2]=__builtin_amdgcn_mfma_f32_32x32x16_bf16(PAF(3),VFR(14),o[2],0,0,0), C1,12); \
    GAPB(o[3]=__builtin_amdgcn_mfma_f32_32x32x16_bf16(PAF(3),VFR(15),o[3],0,0,0), C1,14); \
    }while(0)
  int t=1;
  #undef CMASK
  #define CMASK(P0,P1,t) do{ if(C::MASK){ if((t)>=4) wmask(P0,P1,win0+64*((t)-4),qpos,hi); } }while(0)
  for(;t+5<NT;t+=2){
    STEP(pB0,pB1,pA0,pA1,t,true,true,true);     WAIT_BAR(3); RESC(); ROT();
    STEP(pA0,pA1,pB0,pB1,t+1,true,true,true);   WAIT_BAR(3); RESC(); ROT();
  }
  #undef CMASK
  #define CMASK(P0,P1,t) do{ if(C::MASK){ if((t)>=4) wmask(P0,P1,win0+64*((t)-4),qpos,hi); } }while(0)
  #define ENDW(tt) do{ if((tt)+3<NT){WAIT_BAR(3);} else if((tt)+2<NT){WAIT_BAR(2);} else {WAIT_BAR(0);} }while(0)
  for(;t+1<NT;t+=2){
    STEP(pB0,pB1,pA0,pA1,t,(t+3<NT),(t+1<NT),(t+1<NT));       ENDW(t);   RESC(); ROT();
    STEP(pA0,pA1,pB0,pB1,t+1,(t+4<NT),(t+2<NT),(t+2<NT));     ENDW(t+1); RESC(); ROT();
  }
  STEP(pB0,pB1,pA0,pA1,NT-1,false,false,false); RESC();
  { float sacc=pB0[0]+pB0[1]; _Pragma("unroll") for(int r=2;r<16;++r)sacc+=pB0[r]; _Pragma("unroll") for(int r=0;r<16;++r)sacc+=pB1[r]; l_reg+=sacc;
    pw0=(u32x4){PKW(pB0,0),PKW(pB0,2),PKW(pB0,4),PKW(pB0,6)};pw1=(u32x4){PKW(pB0,8),PKW(pB0,10),PKW(pB0,12),PKW(pB0,14)};pw2=(u32x4){PKW(pB1,0),PKW(pB1,2),PKW(pB1,4),PKW(pB1,6)};pw3=(u32x4){PKW(pB1,8),PKW(pB1,10),PKW(pB1,12),PKW(pB1,14)};
    SBAR(); pv128(o,vb0+2*sl_cur,PAF(0),PAF(1),PAF(2),PAF(3)); }
  #undef PKW
  #undef PAF
  #undef VFR
  #undef PIN
  #undef MX3
  #undef GAPA
  #undef GAPB
  #undef EX
  #undef VRD
  #undef KRD
  #undef STEP
  #undef ENDW
  {auto rr=__builtin_amdgcn_permlane32_swap(__float_as_uint(l_reg),__float_as_uint(l_reg),false,false);l_reg=__uint_as_float(rr[0])+__uint_as_float(rr[1]);}
  if(C::MASK) l_reg+=__builtin_amdgcn_exp2f(aa.sinkl2-mhat);
  if(hi==0)wsf[32+r32]=l_reg;asm volatile("s_waitcnt lgkmcnt(0)":::"memory");
  float rli[16];
  #pragma unroll
  for(int r=0;r<16;++r)rli[r]=__builtin_amdgcn_rcpf(wsf[32+crow(r,hi)]);
  bf16*Ow=aa.Ow0+(long)(wid*QBLK)*C::OP;
  { bf16*stg=(bf16*)(shm+LDS_OST)+wid*2048;
    #pragma unroll
    for(int hp=0;hp<2;++hp){
      #pragma unroll
      for(int r=0;r<16;++r){const int orow=crow(r,hi);
        #pragma unroll
        for(int d0=0;d0<2;++d0)stg[orow*64+d0*32+r32]=__float2bfloat16(o[2*hp+d0][r]*rli[r]);}
      asm volatile("s_waitcnt lgkmcnt(0)":::"memory");
      #pragma unroll
      for(int i=0;i<4;++i){const int row=i*8+(lane>>3),ch=lane&7; const u32x4 v=*(const u32x4*)(stg+row*64+ch*8); ATTN_STORE16(Ow+(long)row*C::OP+hp*64+ch*8,v);}
      asm volatile("s_waitcnt lgkmcnt(0)":::"memory");
    } }
  asm volatile("s_waitcnt lgkmcnt(0)\n\ts_barrier":::"memory");
  #undef DMA_K
  #undef KROW
  #undef DMA_V
  #undef CMASK
  #undef START
  #undef RESC
  #undef ROT
}
constexpr int ATTN_LDS_BYTES=LDS_BYTES;
#undef SBAR
#undef WAIT_BAR
}
constexpr int NWAVES = 8;
constexpr int DM = 2048, NBATCH = 4, SEQ = 4096, CTXL = 256;
constexpr int MT = NBATCH * SEQ, MC = NBATCH * CTXL, MH = MT + MC;
constexpr int KVR = SEQ + CTXL;
constexpr int PROJ = 8448, NE = 32, TOPK = 4;
constexpr int NASSIGN = MT * TOPK;
constexpr int MAXMT = NASSIGN / 256 + NE;
constexpr float LN_EPS = 1e-5f;
constexpr float DN_ALPHA = 1.189207115002721f;
constexpr float LAM_INIT = 0.2f;
constexpr int MODW = 6 * DM;

constexpr size_t MiB = 1u << 20;
constexpr size_t WS_CTL = 0, CTL_ZERO_BYTES = 64 * 1024;
constexpr size_t WS_MODP = 1 * MiB;
constexpr size_t WS_MOD = 2 * MiB;
constexpr size_t WS_PSLOT = 3 * MiB, WS_PGATE = 5 * MiB, WS_STATS = 7 * MiB, WS_SA = 7 * MiB + 256 * 1024, WS_SB = 7 * MiB + 512 * 1024, WS_SH = 7 * MiB + 128 * 1024, WS_SBIN = 7 * MiB + 320 * 1024;
constexpr size_t WS_WIN = 8 * MiB;
constexpr size_t WS_WOA = 42 * MiB, WS_WOB = 46 * MiB, WS_WOUT = 50 * MiB;
constexpr size_t WS_WUP = 64 * MiB;
constexpr size_t WS_WDN = 576 * MiB;
constexpr size_t WS_H = 832 * MiB;
constexpr size_t WS_QA = 900 * MiB, WS_KA = 932 * MiB, WS_VA = 966 * MiB, WS_QB = 1000 * MiB, WS_KB = 1032 * MiB, WS_VB = 1037 * MiB;
constexpr size_t WS_GA = 1042 * MiB, WS_GB = 1106 * MiB, WS_O4 = 1170 * MiB, WS_OA = 1234 * MiB, WS_OB = 1266 * MiB;
constexpr size_t WS_Y1 = 1298 * MiB, WS_Y = 1426 * MiB, WS_R = 1490 * MiB, WS_X1 = 1618 * MiB, WS_HM = 1746 * MiB;
constexpr size_t WS_XG = 1810 * MiB, WS_ACT = 2098 * MiB, WS_YS = 2386 * MiB, WS_ACTQ = 2642 * MiB, WS_RMAXP = 2794 * MiB, WS_SACT = 2814 * MiB, WS_SBD = 2815 * MiB, WS_END = 2816 * MiB;
constexpr size_t WS_YSG = WS_XG, WS_INV = WS_SBD + 512 * 1024;
constexpr size_t WS_OBQ = WS_X1, WS_SOA = WS_STATS + 384 * 1024, WS_SOB = WS_STATS + 448 * 1024, WS_SBOA = WS_SBD + 768 * 1024, WS_SBOB = WS_SBD + 776 * 1024;
constexpr size_t WS_RMAXY = WS_RMAXP, WS_SY = WS_SACT, WS_SBOUT = WS_SBD + 784 * 1024;
constexpr int CW_BAR = 4096;
constexpr int CW_CNT = 8192;
constexpr int CW_QDNQ = 8896;
constexpr int CW_QUPQ = 8512;
constexpr int CW_QCONV = 8448;
constexpr int NG_INPROJ = 144;
constexpr int NWORK = 208;

constexpr int RING_OFF = 0, RING_BYTES = 131072;
constexpr int LDSCTL_OFF = RING_BYTES, MISC_OFF = LDSCTL_OFF + 320;
constexpr int TOK_OFF = LDSCTL_OFF + 2816, EPL_OFF = TOK_OFF + 9216 + 18432;
constexpr int TBL_OFF = LDSCTL_OFF + 1024;
constexpr int LDS_BYTES = 163840;
#define GAS __attribute__((address_space(1)))
#define LAS __attribute__((address_space(3)))
typedef unsigned short bf16;
typedef unsigned v4u __attribute__((ext_vector_type(4)));
typedef float f32x4 __attribute__((ext_vector_type(4)));
typedef short bf16x8 __attribute__((ext_vector_type(8)));
typedef GAS unsigned gu32;
typedef GAS unsigned long long gu64;
#define RLX_AGENT __ATOMIC_RELAXED, __HIP_MEMORY_SCOPE_AGENT
#define LDS_WAIT() asm volatile("s_waitcnt lgkmcnt(0)" ::: "memory")
#define VM_WAIT() asm volatile("s_waitcnt vmcnt(0)" ::: "memory")
__device__ __forceinline__ unsigned long long rt() { return __builtin_amdgcn_s_memrealtime(); }
__device__ __forceinline__ unsigned f2bf(float f) { unsigned u = __builtin_bit_cast(unsigned, f); return (u + 0x7fffu + ((u >> 16) & 1u)) >> 16; }
__device__ __forceinline__ unsigned pk2(float lo, float hi) { return f2bf(lo) | (f2bf(hi) << 16); }

#define XB_TMO      128
#define XB_XCNT(j)  (256  + 64 * (j))
#define XB_XSUB(j)  (1280 + 64 * (j))
#define XB_XGEN(j)  (2304 + 64 * (j))
#define XB_TOP      3328
#define XB_TOPGEN   3392
#define XCD_BAR_WORDS 3456
#define XB_SPIN_CAP (1u << 18)

__device__ __forceinline__ unsigned xb_ld(unsigned* p)              { return __hip_atomic_load(p, __ATOMIC_RELAXED, __HIP_MEMORY_SCOPE_AGENT); }
__device__ __forceinline__ unsigned xb_add(unsigned* p, unsigned v) { return __hip_atomic_fetch_add(p, v, __ATOMIC_RELAXED, __HIP_MEMORY_SCOPE_AGENT); }
__device__ __forceinline__ unsigned xb_xcc_id() { return (unsigned)__builtin_amdgcn_s_getreg((3 << 11) | 20) & 0xFu; }
#define XB_SPIN(cond, bar) do { unsigned _sp = 0; while (cond) { __builtin_amdgcn_s_sleep(1); \
    if ((++_sp & 255u) == 0u) { if (xb_ld(&(bar)[XB_TMO])) break; if (_sp > XB_SPIN_CAP) { atomicAdd(&(bar)[XB_TMO], 1u); break; } } } } while (0)

struct XcdBarrier {
    unsigned* bar; unsigned x;
    volatile LAS unsigned* st;
};

__device__ __forceinline__ XcdBarrier xcd_barrier_post(unsigned* bar, volatile LAS unsigned* st) {
    XcdBarrier b; b.bar = bar; b.x = xb_xcc_id(); b.st = st;
    if (threadIdx.x == 0) (void)xb_add(&bar[XB_XCNT(b.x)], 1u);
    return b;
}
__device__ __forceinline__ void xcd_barrier_complete(unsigned* bar, unsigned x, unsigned& nloc, unsigned& nx) {
    const unsigned G = gridDim.x * gridDim.y * gridDim.z;
    unsigned sum, cnt, mine, sp = 0u;
    for (;;) {
        sum = 0u; cnt = 0u; mine = 0u;
#pragma unroll
        for (unsigned j = 0; j < 16; ++j) { const unsigned c = xb_ld(&bar[XB_XCNT(j)]); sum += c; cnt += (c > 0u) ? 1u : 0u; mine = (j == x) ? c : mine; }
        if (sum == G) break;
        __builtin_amdgcn_s_sleep(1);
        if ((++sp & 255u) == 0u) { if (xb_ld(&bar[XB_TMO])) break; if (sp > XB_SPIN_CAP) { atomicAdd(&bar[XB_TMO], 1u); break; } }
    }
    nloc = mine > 0u ? mine : 1u; nx = cnt > 0u ? cnt : 1u;
}

__device__ __forceinline__ void xcd_barrier(const XcdBarrier& b) {
    asm volatile("s_waitcnt vmcnt(0)" ::: "memory");
    __syncthreads();
    if (threadIdx.x == 0) {
        unsigned* bar = b.bar;
        __builtin_amdgcn_s_waitcnt(0);
        unsigned nloc = b.st[0], nx = b.st[1];
        if (nloc == 0u) { xcd_barrier_complete(bar, b.x, nloc, nx); b.st[0] = nloc; b.st[1] = nx; }
        const unsigned old = xb_add(&bar[XB_XSUB(b.x)], 1u);
        const unsigned gen = old / nloc;
        if (old + 1u == (gen + 1u) * nloc) {
            __builtin_amdgcn_fence(__ATOMIC_RELEASE, "agent");
            asm volatile("s_waitcnt vmcnt(0)" ::: "memory");
            const unsigned og = xb_add(&bar[XB_TOP], 1u);
            const unsigned tg = og / nx;
            if (og + 1u == (tg + 1u) * nx) xb_add(&bar[XB_TOPGEN], 1u);
            else XB_SPIN(xb_ld(&bar[XB_TOPGEN]) == tg, bar);
            __builtin_amdgcn_fence(__ATOMIC_ACQUIRE, "agent");
            xb_add(&bar[XB_XGEN(b.x)], 1u);
            asm volatile("s_waitcnt vmcnt(0)" ::: "memory");
        } else {
            XB_SPIN(xb_ld(&bar[XB_XGEN(b.x)]) == gen, bar);
            __builtin_amdgcn_fence(__ATOMIC_ACQUIRE, "agent");
            asm volatile("s_waitcnt vmcnt(0)" ::: "memory");
        }
    }
    __syncthreads();
}

__device__ __forceinline__ unsigned xcd_barrier_arrive(const XcdBarrier& b) {
    asm volatile("s_waitcnt vmcnt(0)" ::: "memory");
    __syncthreads();
    unsigned gen = 0u;
    if (threadIdx.x == 0) {
        unsigned* bar = b.bar;
        __builtin_amdgcn_s_waitcnt(0);
        unsigned nloc = b.st[0], nx = b.st[1];
        if (nloc == 0u) { xcd_barrier_complete(bar, b.x, nloc, nx); b.st[0] = nloc; b.st[1] = nx; }
        const unsigned old = xb_add(&bar[XB_XSUB(b.x)], 1u);
        gen = old / nloc;
        if (old + 1u == (gen + 1u) * nloc) {
            __builtin_amdgcn_fence(__ATOMIC_RELEASE, "agent");
            asm volatile("s_waitcnt vmcnt(0)" ::: "memory");
            const unsigned og = xb_add(&bar[XB_TOP], 1u);
            const unsigned tg = og / nx;
            if (og + 1u == (tg + 1u) * nx) xb_add(&bar[XB_TOPGEN], 1u);
            else XB_SPIN(xb_ld(&bar[XB_TOPGEN]) == tg, bar);
            __builtin_amdgcn_fence(__ATOMIC_ACQUIRE, "agent");
            xb_add(&bar[XB_XGEN(b.x)], 1u);
            asm volatile("s_waitcnt vmcnt(0)" ::: "memory");
        }
        b.st[2] = gen;
    }
    __syncthreads();
    return gen;
}
__device__ __forceinline__ bool xcd_barrier_test(const XcdBarrier& b) {
    if (threadIdx.x == 0) {
        const unsigned open_ = (xb_ld(&b.bar[XB_XGEN(b.x)]) != b.st[2]) ? 1u : 0u;
        if (open_) { __builtin_amdgcn_fence(__ATOMIC_ACQUIRE, "agent"); asm volatile("s_waitcnt vmcnt(0)" ::: "memory"); }
        b.st[3] = open_;
    }
    __syncthreads();
    const unsigned r = b.st[3];
    __syncthreads();
    return r != 0u;
}
__device__ __forceinline__ void xcd_barrier_wait(const XcdBarrier& b) {
    if (threadIdx.x == 0) {
        unsigned* bar = b.bar; const unsigned gen = b.st[2];
        XB_SPIN(xb_ld(&bar[XB_XGEN(b.x)]) == gen, bar);
        __builtin_amdgcn_fence(__ATOMIC_ACQUIRE, "agent");
        asm volatile("s_waitcnt vmcnt(0)" ::: "memory");
    }
    __syncthreads();
}
struct Frame {
    LAS unsigned char* lds;
    volatile LAS unsigned* MISC;
    gu32* ctl;
    int tid, lane, wave;
    int vcu, G;
    float* out;
    unsigned char* ws;
};
typedef float f32x2 __attribute__((ext_vector_type(2)));
typedef unsigned u32x2 __attribute__((ext_vector_type(2)));
__device__ __forceinline__ float wave_sum(float v) {
#pragma unroll
    for (int o = 1; o < 64; o <<= 1) v += __shfl_xor(v, o);
    return v;
}

template <int MODE> __device__ __forceinline__ int conv_rowmap(int n) {
    if (MODE == 1) {
        const bool rot = (n < 2048) || (n >= 3072 && n < 4224);
        if (!rot) return n;
        const int d = n & 63, g = 4 * (d >> 5) + ((d & 15) >> 2), j = 4 * ((d >> 4) & 1) + (d & 3);
        return (n & ~63) + 8 * g + j;
    }
    if (MODE == 2) { const int lin = n >= 2048 ? 1 : 0, m = n - 2048 * lin; return 256 * (m >> 7) + 128 * lin + (m & 127); }
    return n;
}
template <int MODE, int NI = 1> __device__ __forceinline__ void conv_item(const float* W, int K, int N, bf16* WT, LAS float* scr, int item, int lane) {
    (void)scr;
    const int nblk = N / 32, kb = item / nblk, nb = item % nblk, k0 = 64 * kb, n0 = 32 * nb, c = lane & 7, kg = lane >> 3;
    const float* src = W + (size_t)(k0 + 8 * kg) * N + n0 + 4 * c;
    f32x4 v[NI][8];
#pragma unroll
    for (int t = 0; t < NI; ++t)
#pragma unroll
        for (int i = 0; i < 8; ++i) v[t][i] = __builtin_nontemporal_load((const GAS f32x4*)(src + (size_t)i * N + 32 * t));
#pragma unroll
    for (int t = 0; t < NI; ++t)
#pragma unroll
        for (int q = 0; q < 4; ++q) { v4u o; o.x = pk2(v[t][0][q], v[t][1][q]); o.y = pk2(v[t][2][q], v[t][3][q]); o.z = pk2(v[t][4][q], v[t][5][q]); o.w = pk2(v[t][6][q], v[t][7][q]);
            *(GAS v4u*)(WT + (size_t)conv_rowmap<MODE>(n0 + 32 * t + 4 * c + q) * K + k0 + 8 * kg) = o; }
}
constexpr int CONV_I_UP = (DM / 64) * (4096 / 32), CONV_I_DN = (DM / 64) * (DM / 32), CONV_NCHUNK = NE * (CONV_I_UP + CONV_I_DN) / 16;
__device__ __forceinline__ void conv_pair_load(f32x4 (&v)[2][8], const float* src, int N) {
#pragma unroll
    for (int t = 0; t < 2; ++t)
#pragma unroll
        for (int i = 0; i < 8; ++i) v[t][i] = __builtin_nontemporal_load((const GAS f32x4*)(src + (size_t)i * N + 32 * t));
}
template <int MODE> __device__ __forceinline__ void conv_pair_store(const f32x4 (&v)[2][8], bf16* WT, int K, int ncol0, int kcol) {
#pragma unroll
    for (int t = 0; t < 2; ++t)
#pragma unroll
        for (int q = 0; q < 4; ++q) { v4u o; o.x = pk2(v[t][0][q], v[t][1][q]); o.y = pk2(v[t][2][q], v[t][3][q]); o.z = pk2(v[t][4][q], v[t][5][q]); o.w = pk2(v[t][6][q], v[t][7][q]);
            *(GAS v4u*)(WT + (size_t)conv_rowmap<MODE>(ncol0 + 32 * t + q) * K + kcol) = o; }
}
template <int MODE> __device__ __forceinline__ void conv_chunk(const float* W, int N, bf16* WT, int item0, int lane) {
    const int nblk = N / 32, kb = item0 / nblk, nb = item0 % nblk, k0 = 64 * kb, n0 = 32 * nb, c = lane & 7, kg = lane >> 3;
    const float* src = W + (size_t)(k0 + 8 * kg) * N + n0 + 4 * c; const int ncol = n0 + 4 * c, kcol = k0 + 8 * kg;
    f32x4 va[2][8], vb[2][8];
    conv_pair_load(va, src, N);
#pragma unroll
    for (int p = 0; p < 8; p += 2) {
        conv_pair_load(vb, src + 64 * (p + 1), N);
        conv_pair_store<MODE>(va, WT, DM, ncol + 64 * p, kcol);
        if (p + 2 < 8) conv_pair_load(va, src + 64 * (p + 2), N);
        conv_pair_store<MODE>(vb, WT, DM, ncol + 64 * (p + 1), kcol);
    }
}
__device__ __forceinline__ void conv_expert_queue(Frame& F, const float* wup, const float* wdn, int qword = CW_QCONV) {
    int tid = threadIdx.x; asm volatile("" : "+v"(tid)); const int lane = tid & 63;
    gu32* q = F.ctl + qword;
    unsigned nx = 0u; if (lane == 0) nx = __hip_atomic_fetch_add(q, 1u, RLX_AGENT);
    for (;;) {
        const unsigned ch = (unsigned)__builtin_amdgcn_readfirstlane((int)nx) + (unsigned)(NE * CONV_I_UP / 16);
        if (ch >= (unsigned)CONV_NCHUNK) break;
        if (lane == 0) nx = __hip_atomic_fetch_add(q, 1u, RLX_AGENT);
        const int it0 = (int)ch * 16;
        if (it0 < NE * CONV_I_UP) { const int e = it0 / CONV_I_UP, r = it0 % CONV_I_UP; conv_chunk<2>(wup + (size_t)e * DM * 4096, 4096, (bf16*)(F.ws + WS_WUP) + (size_t)e * 4096 * DM, r, lane); }
        else { const int qq = it0 - NE * CONV_I_UP, e = qq / CONV_I_DN, r = qq % CONV_I_DN; conv_chunk<0>(wdn + (size_t)e * DM * DM, DM, (bf16*)(F.ws + WS_WDN) + (size_t)e * DM * DM, r, lane); }
    }
}

__device__ __forceinline__ unsigned q4_pack(float a, float b, float c, float d, float inv);
template <int MODE, int KK = DM> __device__ __forceinline__ void conv_int8_task(const float* W, int N, int n0, unsigned char* WQ, float* SB, LAS float* red, int tid) {
    constexpr int RPL = KK / 64;
    const int lane = tid & 63, wave = __builtin_amdgcn_readfirstlane(tid >> 6), c = lane & 7, kg = lane >> 3;
    const float* src = W + (size_t)(8 * RPL * wave + RPL * kg) * N + n0 + 4 * c;
    f32x4 v[RPL];
#pragma unroll
    for (int i = 0; i < RPL; ++i) v[i] = __builtin_nontemporal_load((const GAS f32x4*)(src + (size_t)i * N));
    f32x4 mx = (f32x4){0.f, 0.f, 0.f, 0.f};
#pragma unroll
    for (int i = 0; i < RPL; ++i) { mx[0] = fmaxf(mx[0], fabsf(v[i][0])); mx[1] = fmaxf(mx[1], fabsf(v[i][1])); mx[2] = fmaxf(mx[2], fabsf(v[i][2])); mx[3] = fmaxf(mx[3], fabsf(v[i][3])); }
#pragma unroll
    for (int o = 8; o < 64; o <<= 1) { mx[0] = fmaxf(mx[0], __shfl_xor(mx[0], o)); mx[1] = fmaxf(mx[1], __shfl_xor(mx[1], o)); mx[2] = fmaxf(mx[2], __shfl_xor(mx[2], o)); mx[3] = fmaxf(mx[3], __shfl_xor(mx[3], o)); }
    if (kg == 0) *(LAS f32x4*)(red + wave * 32 + 4 * c) = mx;
    __syncthreads();
#pragma unroll
    for (int w = 0; w < 8; ++w) { const f32x4 t = *(const LAS f32x4*)(red + w * 32 + 4 * c); mx[0] = fmaxf(mx[0], t[0]); mx[1] = fmaxf(mx[1], t[1]); mx[2] = fmaxf(mx[2], t[2]); mx[3] = fmaxf(mx[3], t[3]); }
#pragma unroll
    for (int qq = 0; qq < 4; ++qq) {
        const float m = mx[qq], inv = m > 0.f ? 127.0f / m : 0.f; const int row = conv_rowmap<MODE>(n0 + 4 * c + qq);
        if (wave == 0 && kg == 0) SB[row] = m * (1.0f / 127.0f);
        unsigned wds[RPL / 4];
#pragma unroll
        for (int d = 0; d < RPL / 4; ++d) wds[d] = q4_pack(v[4 * d][qq], v[4 * d + 1][qq], v[4 * d + 2][qq], v[4 * d + 3][qq], inv);
        GAS v4u* dst = (GAS v4u*)(WQ + (size_t)row * KK + 8 * RPL * wave + RPL * kg);
#pragma unroll
        for (int d = 0; d < RPL / 16; ++d) dst[d] = (v4u){wds[4 * d], wds[4 * d + 1], wds[4 * d + 2], wds[4 * d + 3]};
    }
    __syncthreads();
}
__device__ __forceinline__ unsigned q4_pack(float a, float b, float c, float d, float inv) {
    const float M = 12582912.0f;
    const unsigned b0 = __float_as_uint(fmaf(a, inv, M)), b1 = __float_as_uint(fmaf(b, inv, M)), b2 = __float_as_uint(fmaf(c, inv, M)), b3 = __float_as_uint(fmaf(d, inv, M));
    return __builtin_amdgcn_perm(__builtin_amdgcn_perm(b3, b2, 0x0c0c0400u), __builtin_amdgcn_perm(b1, b0, 0x0c0c0400u), 0x05040100u);
}
typedef __fp16 h2_t __attribute__((ext_vector_type(2)));
template <int MODE, int N> __device__ __forceinline__ int conv_int8_queue(Frame& F, const float* W, unsigned char* WQ, float* SB, int qword, int maxit = 0x7fffffff) {
    int tid = threadIdx.x; asm volatile("" : "+v"(tid)); const int lane = tid & 63, wave = __builtin_amdgcn_readfirstlane(tid >> 6), c = lane & 15, kg = lane >> 4;
    constexpr int NCB = N / 64, NTASK = NE * NCB;
    gu32* q = F.ctl + qword; LAS float* red = (LAS float*)(F.lds + 1024); LAS unsigned* tkw = (LAS unsigned*)(F.lds);
    if (tid == 0) tkw[0] = __hip_atomic_fetch_add(q, 1u, RLX_AGENT);
    __syncthreads();
    unsigned cur = tkw[0];
    const size_t loff = (size_t)(256 * wave + 64 * kg) * N + 4 * c;
    int it = 0;
    for (; it < maxit && cur < (unsigned)NTASK; ++it) {
        if (tid == 0 && it + 1 < maxit) tkw[(it + 1) & 1] = __hip_atomic_fetch_add(q, 1u, RLX_AGENT);
        const int e = (int)(cur / NCB), n0 = 64 * (int)(cur % NCB);
        const float* src = W + (size_t)e * DM * N + loff + n0;
        f32x4 v[40]; h2_t hlo[40][2];
        f32x4 mx = (f32x4){0.f, 0.f, 0.f, 0.f};
#pragma unroll
        for (int i = 0; i < 40; ++i) v[i] = __builtin_nontemporal_load((const GAS f32x4*)(src + (size_t)i * N));
#pragma unroll
        for (int i = 0; i < 40; ++i) { mx[0] = fmaxf(mx[0], fabsf(v[i][0])); mx[1] = fmaxf(mx[1], fabsf(v[i][1])); mx[2] = fmaxf(mx[2], fabsf(v[i][2])); mx[3] = fmaxf(mx[3], fabsf(v[i][3]));
            hlo[i][0] = __builtin_amdgcn_cvt_pkrtz(v[i][0], v[i][1]); hlo[i][1] = __builtin_amdgcn_cvt_pkrtz(v[i][2], v[i][3]); }
#pragma unroll
        for (int i = 0; i < 40; ++i) { asm volatile("" : "+v"(hlo[i][0]), "+v"(hlo[i][1])); }
        __builtin_amdgcn_sched_barrier(0);
#pragma unroll
        for (int i = 0; i < 24; ++i) v[i] = __builtin_nontemporal_load((const GAS f32x4*)(src + (size_t)(40 + i) * N));
#pragma unroll
        for (int i = 0; i < 24; ++i) { mx[0] = fmaxf(mx[0], fabsf(v[i][0])); mx[1] = fmaxf(mx[1], fabsf(v[i][1])); mx[2] = fmaxf(mx[2], fabsf(v[i][2])); mx[3] = fmaxf(mx[3], fabsf(v[i][3])); }
#pragma unroll
        for (int o = 16; o < 64; o <<= 1) { mx[0] = fmaxf(mx[0], __shfl_xor(mx[0], o)); mx[1] = fmaxf(mx[1], __shfl_xor(mx[1], o)); mx[2] = fmaxf(mx[2], __shfl_xor(mx[2], o)); mx[3] = fmaxf(mx[3], __shfl_xor(mx[3], o)); }
        if (kg == 0) *(LAS f32x4*)(red + wave * 64 + 4 * c) = mx;
        __syncthreads();
        const unsigned nxt = tkw[(it + 1) & 1];
#pragma unroll
        for (int w = 0; w < 8; ++w) { const f32x4 t = *(const LAS f32x4*)(red + w * 64 + 4 * c); mx[0] = fmaxf(mx[0], t[0]); mx[1] = fmaxf(mx[1], t[1]); mx[2] = fmaxf(mx[2], t[2]); mx[3] = fmaxf(mx[3], t[3]); }
#pragma unroll
        for (int qq = 0; qq < 4; ++qq) {
            const float m = mx[qq], inv = m > 0.f ? 127.0f / m : 0.f; const int row = conv_rowmap<MODE>(n0 + 4 * c + qq);
            if (wave == 0 && kg == 0) SB[(size_t)e * N + row] = m * (1.0f / 127.0f);
            GAS v4u* dst = (GAS v4u*)(WQ + ((size_t)e * N + row) * DM + 256 * wave + 64 * kg);
            unsigned wd[16];
#pragma unroll
            for (int d = 0; d < 10; ++d) wd[d] = q4_pack((float)hlo[4 * d][qq >> 1][qq & 1], (float)hlo[4 * d + 1][qq >> 1][qq & 1], (float)hlo[4 * d + 2][qq >> 1][qq & 1], (float)hlo[4 * d + 3][qq >> 1][qq & 1], inv);
#pragma unroll
            for (int d = 0; d < 6; ++d) wd[10 + d] = q4_pack(v[4 * d][qq], v[4 * d + 1][qq], v[4 * d + 2][qq], v[4 * d + 3][qq], inv);
            dst[0] = (v4u){wd[0], wd[1], wd[2], wd[3]}; dst[1] = (v4u){wd[4], wd[5], wd[6], wd[7]}; dst[2] = (v4u){wd[8], wd[9], wd[10], wd[11]}; dst[3] = (v4u){wd[12], wd[13], wd[14], wd[15]};
        }
        __syncthreads();
        cur = nxt;
    }
    __syncthreads();
    return it;
}
__device__ __forceinline__ int conv_up_int8_queue(Frame& F, const float* wup, int qword = CW_QUPQ, int maxit = 0x7fffffff) { return conv_int8_queue<2, 4096>(F, wup, F.ws + WS_WUP, (float*)(F.ws + WS_SB), qword, maxit); }

__device__ __forceinline__ void p0_phase(Frame& F, const float* c, const float* cc, const float* wada, const float* win, const float* woa, const float* wob, const float* wout) {
    int tid = threadIdx.x; asm volatile("" : "+v"(tid)); const int lane = tid & 63, wave = __builtin_amdgcn_readfirstlane(tid >> 6); (void)lane; (void)wave;
    float* MODP = (float*)(F.ws + WS_MODP);
    if (blockIdx.x < 192) {
        const int chunk = blockIdx.x % 48, kg = blockIdx.x / 48;
        LAS float* s = (LAS float*)(F.lds);
        LAS float* red = (LAS float*)(F.lds + 40960);
        for (int i = tid; i < 5 * 2048; i += NWAVES * 64) { const int b = i >> 11, k = i & 2047; const float v = b < 4 ? c[b * 2048 + k] : cc[k]; s[i] = v / (1.0f + __expf(-v)); }
        __syncthreads();
        const float* W = wada + (size_t)(kg * 512 + wave * 64) * MODW + chunk * 256 + 4 * lane;
        const LAS float* sk = s + kg * 512 + wave * 64;
        f32x4 acc[5];
#pragma unroll
        for (int b = 0; b < 5; ++b) acc[b] = (f32x4){0.f, 0.f, 0.f, 0.f};
#pragma unroll 16
        for (int k = 0; k < 64; ++k) { const f32x4 w = *(const GAS f32x4*)(W + (size_t)k * MODW);
#pragma unroll
            for (int b = 0; b < 5; ++b) acc[b] += w * sk[b * 2048 + k]; }
#pragma unroll
        for (int b = 0; b < 5; ++b) *(LAS f32x4*)(red + (wave * 5 + b) * 256 + 4 * lane) = acc[b];
        __syncthreads();
        for (int i = tid; i < 1280; i += NWAVES * 64) { const int b = i >> 8, ci = i & 255; float t = 0.f;
#pragma unroll
            for (int w = 0; w < 8; ++w) t += red[(w * 5 + b) * 256 + ci];
            MODP[(size_t)(kg * 5 + b) * MODW + chunk * 256 + ci] = t; }
        __syncthreads();
    }
    if (F.G == 256) {
        const int bx = (int)blockIdx.x;
        if (bx >= 192) { conv_int8_task<1>(win, PROJ, 32 * (2 * (bx - 192)), F.ws + WS_WIN, (float*)(F.ws + WS_SBIN), (LAS float*)(F.lds + 1024), tid); conv_int8_task<1>(win, PROJ, 32 * (2 * (bx - 192) + 1), F.ws + WS_WIN, (float*)(F.ws + WS_SBIN), (LAS float*)(F.lds + 1024), tid); }
        else if (bx < PROJ / 32 - 128) conv_int8_task<1>(win, PROJ, 32 * (128 + bx), F.ws + WS_WIN, (float*)(F.ws + WS_SBIN), (LAS float*)(F.lds + 1024), tid);
    } else
    for (int tk = blockIdx.x; tk < PROJ / 32; tk += F.G)
        conv_int8_task<1>(win, PROJ, 32 * tk, F.ws + WS_WIN, (float*)(F.ws + WS_SBIN), (LAS float*)(F.lds + 1024), tid);
}
__device__ __forceinline__ void conv_mixer_out(Frame& F, const float* woa, const float* wob, const float* wout, int blk, int nblk) {
    int tid = threadIdx.x; asm volatile("" : "+v"(tid)); const int lane = tid & 63, wave = __builtin_amdgcn_readfirstlane(tid >> 6);
    for (int tk = blk; tk < 128; tk += nblk) {
        if (tk < 64) conv_int8_task<0, 1024>(woa, DM, 32 * tk, F.ws + WS_WOA, (float*)(F.ws + WS_SBOA), (LAS float*)(F.lds + 1024), tid);
        else conv_int8_task<0, 1024>(wob, DM, 32 * (tk - 64), F.ws + WS_WOB, (float*)(F.ws + WS_SBOB), (LAS float*)(F.lds + 1024), tid);
    }
    for (int tk = blk; tk < 64; tk += nblk) conv_int8_task<0>(wout, DM, 32 * tk, F.ws + WS_WOUT, (float*)(F.ws + WS_SBOUT), (LAS float*)(F.lds + 1024), tid);
    (void)lane; (void)wave;
}
__device__ __forceinline__ void p1_phase(Frame& F, const float* bada) {
    int tid = threadIdx.x; asm volatile("" : "+v"(tid)); const int lane = tid & 63, wave = __builtin_amdgcn_readfirstlane(tid >> 6); (void)lane; (void)wave;
    const float* MODP = (const float*)(F.ws + WS_MODP); float* MOD = (float*)(F.ws + WS_MOD);
    for (int i = blockIdx.x * (NWAVES * 64) + tid; i < 5 * MODW; i += F.G * NWAVES * 64) { const int n = i % MODW;
        MOD[i] = bada[n] + ((MODP[i] + MODP[i + 5 * MODW]) + (MODP[i + 10 * MODW] + MODP[i + 15 * MODW])); }
}
__device__ __forceinline__ void p2_phase(Frame& F, const float* x, const float* ctx, const float* bada) {
    int tid = threadIdx.x; asm volatile("" : "+v"(tid)); const int lane = tid & 63, wave = __builtin_amdgcn_readfirstlane(tid >> 6); (void)lane; (void)wave;
    const float* MOD = (const float*)(F.ws + WS_MOD); unsigned* HQ = (unsigned*)(F.ws + WS_H); float* SH = (float*)(F.ws + WS_SH);
    LAS f32x4* mv = (LAS f32x4*)F.lds;
    {
        const GAS f32x4* P4 = (const GAS f32x4*)(F.ws + WS_MODP); const GAS f32x4* b4 = (const GAS f32x4*)bada; constexpr int Q = 5 * MODW / 4, RW = MODW / 4;
        for (int i = tid; i < 5 * 1024; i += NWAVES * 64) { const int o = (i >> 10) * RW + (i & 1023); mv[i] = b4[i & 1023] + ((P4[o] + P4[o + Q]) + (P4[o + 2 * Q] + P4[o + 3 * Q])); }
        GAS f32x4* M4 = (GAS f32x4*)(F.ws + WS_MOD);
        for (int i = blockIdx.x * (NWAVES * 64) + tid; i < Q; i += F.G * NWAVES * 64) M4[i] = b4[i % RW] + ((P4[i] + P4[i + Q]) + (P4[i + 2 * Q] + P4[i + 3 * Q]));
    }
    __syncthreads();
    const int gw = F.vcu * NWAVES + wave, NGW = F.G * NWAVES;
    f32x4 xn[8];
    if (gw < MH) { const GAS f32x4* x4 = (const GAS f32x4*)(gw < MT ? x + (size_t)gw * DM : ctx + (size_t)(gw - MT) * DM) + lane;
#pragma unroll
        for (int j = 0; j < 8; ++j) xn[j] = x4[64 * j]; }
    for (int m = gw; m < MH; m += NGW) {
        const int b = m < MT ? (m >> 12) : 4; const LAS f32x4* sh4 = mv + b * 1024 + lane; const LAS f32x4* sc4 = sh4 + 512;
        f32x4 o[8]; float amax = 0.f;
#pragma unroll
        for (int j = 0; j < 8; ++j) { o[j] = xn[j] * (sc4[64 * j] + 1.0f) + sh4[64 * j];
            amax = fmaxf(amax, fmaxf(fmaxf(fabsf(o[j][0]), fabsf(o[j][1])), fmaxf(fabsf(o[j][2]), fabsf(o[j][3])))); }
        const int m2 = m + NGW;
        if (m2 < MH) { const GAS f32x4* x4 = (const GAS f32x4*)(m2 < MT ? x + (size_t)m2 * DM : ctx + (size_t)(m2 - MT) * DM) + lane;
#pragma unroll
            for (int j = 0; j < 8; ++j) xn[j] = x4[64 * j]; }
#pragma unroll
        for (int q = 1; q < 64; q <<= 1) amax = fmaxf(amax, __shfl_xor(amax, q));
        const float qinv = amax > 0.f ? 127.0f / amax : 0.f;
        if (lane == 0) SH[m] = amax * (1.0f / 127.0f);
        GAS unsigned* ho = (GAS unsigned*)(HQ + (size_t)m * (DM / 4)) + lane;
#pragma unroll
        for (int j = 0; j < 8; ++j) ho[64 * j] = q4_pack(o[j][0], o[j][1], o[j][2], o[j][3], qinv);
    }
    __syncthreads();
}
struct CfgA { static constexpr int QP = 1024, KP = 1024, VP = 1024, OP = 2048; static constexpr bool MASK = false; };
struct CfgB { static constexpr int QP = 1024, KP = 128, VP = 128, OP = 1024; static constexpr bool MASK = true; };
__device__ __forceinline__ void p4_phase(Frame& F, char* lds_generic, const float* sinks, int rank, int W) {
    using abf = attn_body::bf16;
    const abf* QA = (const abf*)(F.ws + WS_QA); const abf* KA = (const abf*)(F.ws + WS_KA); const abf* VA = (const abf*)(F.ws + WS_VA);
    const abf* QB = (const abf*)(F.ws + WS_QB); const abf* KB = (const abf*)(F.ws + WS_KB); const abf* VB = (const abf*)(F.ws + WS_VB);
    abf* O4 = (abf*)(F.ws + WS_O4); abf* OB = (abf*)(F.ws + WS_OB);
    for (int u = rank; u < 1024; u += W) {
        const int b = u >> 8, h = (u >> 5) & 7, j = (u >> 4) & 1, qb = u & 15; const size_t qrow = (size_t)b * SEQ + qb * 256, krow = (size_t)b * KVR;
        attn_body::AttnArgs aa; aa.Qw0 = QA + qrow * 1024 + (2 * h + j) * 64; aa.Kh = KA + krow * 1024 + (2 * h + j) * 64; aa.Vh = VA + krow * 1024 + h * 128;
        aa.Ow0 = O4 + qrow * 2048 + (h * 2 + j) * 128; aa.NT = KVR / 64; aa.win0 = 0; aa.qpos0 = 0; aa.sinkl2 = 0.f;
        attn_body::attn_unit128<CfgA, 8>(aa, lds_generic);
    }
    for (int u = rank; u < 1024; u += W) {
        const int b = u >> 8, qh = (u >> 4) & 15, qb = u & 15, kvh = qh >> 3; const size_t qrow = (size_t)b * SEQ + qb * 256, krow = (size_t)b * KVR;
        const int w0 = qb == 0 ? 0 : 256 * qb - 128, w1 = qb == 15 ? SEQ : 256 * qb + 384;
        attn_body::AttnArgs aa; aa.Qw0 = QB + qrow * 1024 + qh * 64; aa.Kh = KB + krow * 128 + kvh * 64; aa.Vh = VB + krow * 128 + kvh * 64; aa.Ow0 = OB + qrow * 1024 + qh * 64;
        aa.NT = 4 + (w1 - w0) / 64; aa.win0 = w0; aa.qpos0 = 256 * qb; aa.sinkl2 = sinks[qh] * 1.4426950408889634f;
        attn_body::attn_unit<CfgB, 8>(aa, lds_generic);
    }
}
__device__ __forceinline__ void p4c_phase(Frame& F, const float* lq1, const float* lk1, const float* lq2, const float* lk2, const float* subw) {
    int tid = threadIdx.x; asm volatile("" : "+v"(tid)); const int lane = tid & 63, wave = __builtin_amdgcn_readfirstlane(tid >> 6);
    const bf16* O4 = (const bf16*)(F.ws + WS_O4); unsigned char* OA = F.ws + WS_OA; float* SOA = (float*)(F.ws + WS_SOA);
    const bf16* OB = (const bf16*)(F.ws + WS_OB); unsigned char* OBQ = F.ws + WS_OBQ; float* SOB = (float*)(F.ws + WS_SOB);
    float lam; { const float a1 = lq1[lane] * lk1[lane], a2 = lq2[lane] * lk2[lane]; lam = __expf(wave_sum(a1)) - __expf(wave_sum(a2)) + LAM_INIT; }
    const int h = lane >> 3, part = lane & 7; float sw[16];
#pragma unroll
    for (int i = 0; i < 16; ++i) sw[i] = subw[part * 16 + i] * (1.0f - LAM_INIT);
    const int gw = F.vcu * NWAVES + wave, NGW = F.G * NWAVES;
    v4u na0, na1, nb0, nb1, nc0, nc1;
#define P4C_LOAD(mm) do { const GAS v4u* o0_ = (const GAS v4u*)(O4 + (size_t)(mm) * 2048 + h * 256 + part * 16); const GAS v4u* o1_ = (const GAS v4u*)(O4 + (size_t)(mm) * 2048 + h * 256 + 128 + part * 16); \
        const GAS v4u* bp_ = (const GAS v4u*)(OB + (size_t)(mm) * 1024 + lane * 16); na0 = o0_[0]; na1 = o0_[1]; nb0 = o1_[0]; nb1 = o1_[1]; nc0 = bp_[0]; nc1 = bp_[1]; } while (0)
    if (gw < MT) P4C_LOAD(gw);
    for (int m = gw; m < MT; m += NGW) {
        const v4u a0 = na0, a1 = na1, b0 = nb0, b1 = nb1, c0 = nc0, c1 = nc1;
        const unsigned aw[8] = {a0.x, a0.y, a0.z, a0.w, a1.x, a1.y, a1.z, a1.w}, bw[8] = {b0.x, b0.y, b0.z, b0.w, b1.x, b1.y, b1.z, b1.w};
        float d[16]; float ss = 0.f;
#pragma unroll
        for (int q = 0; q < 8; ++q) { d[2 * q] = pg8::bf_lo(aw[q]) - lam * pg8::bf_lo(bw[q]); d[2 * q + 1] = pg8::bf_hi(aw[q]) - lam * pg8::bf_hi(bw[q]); ss += d[2 * q] * d[2 * q] + d[2 * q + 1] * d[2 * q + 1]; }
        ss += __shfl_xor(ss, 1); ss += __shfl_xor(ss, 2); ss += __shfl_xor(ss, 4);
        const float rs = 1.0f / sqrtf(ss * (1.0f / 128.0f) + LN_EPS);
        float amax = 0.f;
#pragma unroll
        for (int q = 0; q < 16; ++q) { d[q] = d[q] * rs * sw[q]; amax = fmaxf(amax, fabsf(d[q])); }
        const unsigned cw[8] = {c0.x, c0.y, c0.z, c0.w, c1.x, c1.y, c1.z, c1.w}; float e[16]; float bmax = 0.f;
#pragma unroll
        for (int q = 0; q < 8; ++q) { e[2 * q] = pg8::bf_lo(cw[q]); e[2 * q + 1] = pg8::bf_hi(cw[q]); bmax = fmaxf(bmax, fmaxf(fabsf(e[2 * q]), fabsf(e[2 * q + 1]))); }
#pragma unroll
        for (int o = 1; o < 64; o <<= 1) { amax = fmaxf(amax, __shfl_xor(amax, o)); bmax = fmaxf(bmax, __shfl_xor(bmax, o)); }
        const float ai = amax > 0.f ? 127.0f / amax : 0.f, bi = bmax > 0.f ? 127.0f / bmax : 0.f;
        if (m + NGW < MT) P4C_LOAD(m + NGW);
        if (lane == 0) { SOA[m] = amax * (1.0f / 127.0f); SOB[m] = bmax * (1.0f / 127.0f); }
        *(GAS v4u*)(OA + (size_t)m * 1024 + h * 128 + part * 16) = (v4u){q4_pack(d[0], d[1], d[2], d[3], ai), q4_pack(d[4], d[5], d[6], d[7], ai), q4_pack(d[8], d[9], d[10], d[11], ai), q4_pack(d[12], d[13], d[14], d[15], ai)};
        *(GAS v4u*)(OBQ + (size_t)m * 1024 + lane * 16) = (v4u){q4_pack(e[0], e[1], e[2], e[3], bi), q4_pack(e[4], e[5], e[6], e[7], bi), q4_pack(e[8], e[9], e[10], e[11], bi), q4_pack(e[12], e[13], e[14], e[15], bi)};
    }
}
#undef P4C_LOAD
__device__ __forceinline__ void p7_phase(Frame& F, const float* g1n, const float* b1n, const float* wrt, const float* brt) {
    int tid = threadIdx.x; asm volatile("" : "+v"(tid)); const int lane = tid & 63, wave = __builtin_amdgcn_readfirstlane(tid >> 6); (void)lane; (void)wave;
    typedef float f32x16 __attribute__((ext_vector_type(16)));
    const float* R = (const float*)(F.ws + WS_R); float* STATS = (float*)(F.ws + WS_STATS); unsigned* HMQ = (unsigned*)(F.ws + WS_HM); float* SA = (float*)(F.ws + WS_SA);     const float* MOD = (const float*)(F.ws + WS_MOD);
    int* PSLOT = (int*)(F.ws + WS_PSLOT); float* PGATE = (float*)(F.ws + WS_PGATE);
    LAS float* part = (LAS float*)F.lds;
    LAS float* lg = (LAS float*)(F.lds + 34816);
    LAS int* cntL = (LAS int*)(F.lds + 40960);
    LAS int* baseL = cntL + 32;
    LAS float* stL = (LAS float*)(F.lds + 41472);
    LAS f32x4* vecL = (LAS f32x4*)(F.lds + 49152);
    for (int tile = blockIdx.x; tile < MT / 32; tile += F.G) {
        const int R0 = tile * 32; const float* modb = MOD + (size_t)(R0 >> 12) * MODW;
        if (tid < 32) cntL[tid] = 0;
        for (int i = tid; i < 2048; i += NWAVES * 64) { const int w = i >> 9, d = i & 511; const float* src = w == 0 ? g1n : w == 1 ? b1n : w == 2 ? modb + 4 * DM : modb + 3 * DM; vecL[i] = ((const GAS f32x4*)src)[d]; }
        f32x4 vv[4][8];
#pragma unroll
        for (int i = 0; i < 4; ++i) { const GAS f32x4* r4 = (const GAS f32x4*)(R + (size_t)(R0 + 4 * wave + i) * DM) + lane;
#pragma unroll
            for (int j = 0; j < 8; ++j) vv[i][j] = r4[64 * j]; }
        __syncthreads();
#pragma unroll
        for (int i = 0; i < 4; ++i) {
            const size_t row = R0 + 4 * wave + i;
            f32x4 v[8]; float s = 0.f;
#pragma unroll
            for (int j = 0; j < 8; ++j) { v[j] = vv[i][j]; s += (v[j][0] + v[j][1]) + (v[j][2] + v[j][3]); }
            const float mean = wave_sum(s) * (1.0f / DM); float s2 = 0.f;
#pragma unroll
            for (int j = 0; j < 8; ++j) { v[j] = v[j] - mean; s2 += (v[j][0] * v[j][0] + v[j][1] * v[j][1]) + (v[j][2] * v[j][2] + v[j][3] * v[j][3]); }
            const float rstd = 1.0f / sqrtf(wave_sum(s2) * (1.0f / DM) + LN_EPS);
            if (lane == 0) { STATS[row * 2] = mean; STATS[row * 2 + 1] = rstd; stL[(4 * wave + i) * 2] = mean; stL[(4 * wave + i) * 2 + 1] = rstd; }
            float amax = 0.f;
#pragma unroll
            for (int j = 0; j < 8; ++j) { const int d4 = lane + 64 * j;
                const f32x4 g = vecL[d4], bb = vecL[512 + d4], sc = vecL[1024 + d4], sh = vecL[1536 + d4];
                const f32x4 x1 = v[j] * rstd * g + bb; v[j] = x1 * (sc + 1.0f) + sh;
                amax = fmaxf(amax, fmaxf(fmaxf(fabsf(v[j][0]), fabsf(v[j][1])), fmaxf(fabsf(v[j][2]), fabsf(v[j][3])))); }
#pragma unroll
            for (int o = 1; o < 64; o <<= 1) amax = fmaxf(amax, __shfl_xor(amax, o));
            const float qinv = amax > 0.f ? 127.0f / amax : 0.f;
            if (lane == 0) SA[row] = amax * (1.0f / 127.0f);
            GAS unsigned* ho = (GAS unsigned*)(HMQ + row * (DM / 4)) + lane;
#pragma unroll
            for (int j = 0; j < 8; ++j) ho[64 * j] = q4_pack(v[j][0], v[j][1], v[j][2], v[j][3], qinv);
        }
        VM_WAIT(); __syncthreads();
        {
            const int rw = lane & 31, hf = lane >> 5;
            const float* xr = R + (size_t)(R0 + rw) * DM + 256 * wave + 4 * hf; const float mu = stL[rw * 2], rs = stL[rw * 2 + 1];
            const float* wp = wrt + (size_t)(256 * wave + 4 * hf) * NE + rw;
            const LAS f32x4* vl = vecL + 64 * wave + hf;
            f32x16 acc;
#pragma unroll
            for (int q = 0; q < 16; ++q) acc[q] = 0.f;
#pragma unroll 8
            for (int c = 0; c < 32; ++c) {
                const f32x4 r4 = *(const GAS f32x4*)(xr + 8 * c), g4 = vl[2 * c], b4 = vl[512 + 2 * c], s4 = vl[1024 + 2 * c], h4 = vl[1536 + 2 * c];
                const f32x4 x4 = (r4 - mu) * rs * g4 + b4; const f32x4 hm = x4 * (s4 + 1.0f) + h4;
#pragma unroll
                for (int i = 0; i < 4; ++i) acc = __builtin_amdgcn_mfma_f32_32x32x2f32(hm[i], wp[(size_t)(8 * c + i) * NE], acc, 0, 0, 0);
            }
#pragma unroll
            for (int q = 0; q < 16; ++q) part[(wave * 32 + (q & 3) + 8 * (q >> 2) + 4 * hf) * 33 + rw] = acc[q];
        }
        __syncthreads();
        for (int p = tid; p < 1024; p += NWAVES * 64) { const int rr = p >> 5, e = p & 31; float t = brt[e];
#pragma unroll
            for (int w = 0; w < 8; ++w) t += part[(w * 32 + rr) * 33 + e];
            lg[rr * 33 + e] = t; }
        __syncthreads();
        int sel0 = 0, sel1 = 0, sel2 = 0, sel3 = 0, lr0 = 0, lr1 = 0, lr2 = 0, lr3 = 0; float gt0 = 0.f, gt1 = 0.f, gt2 = 0.f, gt3 = 0.f;
        if (tid < 32) {
            float val[4]; int sel[4];
#pragma unroll
            for (int k = 0; k < 4; ++k) { float best = -INFINITY; int bi = 0;
                for (int e = 0; e < NE; ++e) { const float vv = lg[tid * 33 + e]; if (vv > best) { best = vv; bi = e; } }
                sel[k] = bi; val[k] = best; lg[tid * 33 + bi] = -INFINITY; }
            const float p1 = __expf(val[1] - val[0]), p2 = __expf(val[2] - val[0]), p3 = __expf(val[3] - val[0]); const float inv = 1.0f / (1.0f + p1 + p2 + p3);
            gt0 = inv; gt1 = p1 * inv; gt2 = p2 * inv; gt3 = p3 * inv;
            sel0 = sel[0]; sel1 = sel[1]; sel2 = sel[2]; sel3 = sel[3];
            lr0 = atomicAdd((int*)(cntL + sel0), 1); lr1 = atomicAdd((int*)(cntL + sel1), 1); lr2 = atomicAdd((int*)(cntL + sel2), 1); lr3 = atomicAdd((int*)(cntL + sel3), 1);
        }
        __syncthreads();
        if (tid < 32) { const int cl = cntL[tid]; baseL[tid] = cl ? (int)__hip_atomic_fetch_add((unsigned*)(F.ctl + CW_CNT + tid), (unsigned)cl, __ATOMIC_RELAXED, __HIP_MEMORY_SCOPE_AGENT) : 0; }
        __syncthreads();
        if (tid < 32) { const int a0 = (R0 + tid) * 4;
            const int v0 = sel0 * 16384 + ((baseL[sel0] + lr0) & 16383), v1 = sel1 * 16384 + ((baseL[sel1] + lr1) & 16383), v2 = sel2 * 16384 + ((baseL[sel2] + lr2) & 16383), v3 = sel3 * 16384 + ((baseL[sel3] + lr3) & 16383);
            PSLOT[v0] = a0; PSLOT[v1] = a0 + 1; PSLOT[v2] = a0 + 2; PSLOT[v3] = a0 + 3; *(GAS v4u*)((int*)(F.ws + WS_INV) + a0) = (v4u){(unsigned)v0, (unsigned)v1, (unsigned)v2, (unsigned)v3}; PGATE[v0] = gt0; PGATE[v1] = gt1; PGATE[v2] = gt2; PGATE[v3] = gt3; }
        __syncthreads();
    }
}
__device__ __forceinline__ void p8_phase(Frame& F) {
    int tid = threadIdx.x; asm volatile("" : "+v"(tid)); const int lane = tid & 63, wave = __builtin_amdgcn_readfirstlane(tid >> 6); (void)lane; (void)wave;
    LAS int* cnt = (LAS int*)(F.lds + TBL_OFF); LAS int* pstart = cnt + 32; LAS int* nmt = cnt + 96; LAS int* mt_e = cnt + 128;
    if (tid < 32) cnt[tid] = (int)__hip_atomic_load((unsigned*)(F.ctl + CW_CNT + tid), RLX_AGENT);
    __syncthreads();
    if (tid == 0) { int acc = 0, nt = 0;
        for (int e = 0; e < NE; ++e) { pstart[e] = acc; const int t = (cnt[e] + 255) >> 8; for (int j = 0; j < t && nt < MAXMT; ++j) mt_e[nt++] = e; acc += t * 256; }
        pstart[32] = acc; nmt[0] = nt; }
    __syncthreads();
}
__device__ __forceinline__ unsigned requant4(unsigned w, float ratio) {
    return pg8::q4p((float)(int)(signed char)(w & 255u), (float)(int)(signed char)((w >> 8) & 255u), (float)(int)(signed char)((w >> 16) & 255u), (float)((int)w >> 24), ratio);
}
__device__ __forceinline__ void p9b_phase(Frame& F, int nrows, const float* RMAXP, unsigned char* ACTQ, float* SACT) {
    int tid = threadIdx.x; asm volatile("" : "+v"(tid)); const int lane = tid & 63, wave = __builtin_amdgcn_readfirstlane(tid >> 6);
    const int gw = F.vcu * NWAVES + wave, NGW = F.G * NWAVES;
    float nml = 0.f; v4u nw0 = (v4u){0u, 0u, 0u, 0u}, nw1 = nw0;
#define P9B_LOAD(rr) do { nml = RMAXP[(size_t)(rr) * 64 + lane]; const GAS v4u* p_ = (const GAS v4u*)(ACTQ + (size_t)(rr) * DM) + 2 * lane; nw0 = p_[0]; nw1 = p_[1]; } while (0)
    if (gw < nrows) P9B_LOAD(gw);
    for (int r = gw; r < nrows; r += NGW) {
        float ml = nml; const v4u w0 = nw0, w1 = nw1;
        GAS v4u* p = (GAS v4u*)(ACTQ + (size_t)r * DM) + 2 * lane;
        if (!(ml < 1e30f)) ml = 0.f;
        float mx = ml;
#pragma unroll
        for (int o = 1; o < 64; o <<= 1) mx = fmaxf(mx, __shfl_xor(mx, o));
        const float ratio = mx > 0.f ? ml / mx : 0.f;
        const v4u o0 = (v4u){requant4(w0.x, ratio), requant4(w0.y, ratio), requant4(w0.z, ratio), requant4(w0.w, ratio)}, o1 = (v4u){requant4(w1.x, ratio), requant4(w1.y, ratio), requant4(w1.z, ratio), requant4(w1.w, ratio)};
        if (r + NGW < nrows) P9B_LOAD(r + NGW);
        if (lane == 0) SACT[r] = mx * (1.0f / 127.0f);
        p[0] = o0; p[1] = o1;
    }
#undef P9B_LOAD
}
__device__ __forceinline__ void p11_phase(Frame& F, const float* g1n, const float* b1n, const float* g2n, const float* b2n) {
    int tid = threadIdx.x; asm volatile("" : "+v"(tid)); const int lane0 = tid & 63, wave = __builtin_amdgcn_readfirstlane(tid >> 6); (void)wave;
    const float* R = (const float*)(F.ws + WS_R); const float* STATS = (const float*)(F.ws + WS_STATS); const bf16* YS = (const bf16*)(F.ws + WS_YSG); const float* MOD = (const float*)(F.ws + WS_MOD);
    const int* INV = (const int*)(F.ws + WS_INV); const LAS int* t_ps = (const LAS int*)(F.lds + TBL_OFF) + 32;
    LAS f32x4* vec = (LAS f32x4*)F.lds;
    for (int i = tid; i < 4096; i += NWAVES * 64) { const int w = i >> 9, d = i & 511; const float* src = w == 0 ? g1n : w == 1 ? b1n : w == 2 ? g2n : w == 3 ? b2n : MOD + (size_t)(w - 4) * MODW + 5 * DM; vec[i] = ((const GAS f32x4*)src)[d]; }
    __syncthreads();
    const int gw = F.vcu * NWAVES + wave, NGW = F.G * NWAVES;
    f32x4 nv[8]; u32x2 nyw[4][8]; float nmu = 0.f, nrs = 0.f; int iv[4] = {0, 0, 0, 0};
#define P11_INV(mm) do { _Pragma("unroll") for (int k_ = 0; k_ < 4; ++k_) iv[k_] = INV[4 * (mm) + k_]; } while (0)
#define P11_LOAD(mm) do { int ln_ = lane0; asm volatile("" : "+v"(ln_)); const GAS f32x4* x4_ = (const GAS f32x4*)(R + (size_t)(mm) * DM) + ln_; nmu = STATS[(size_t)(mm) * 2]; nrs = STATS[(size_t)(mm) * 2 + 1]; \
        const GAS u32x2* y8_[4]; _Pragma("unroll") for (int k_ = 0; k_ < 4; ++k_) { const int v_ = __builtin_amdgcn_readfirstlane(iv[k_]); y8_[k_] = (const GAS u32x2*)(YS + (size_t)(t_ps[v_ >> 14] + (v_ & 16383)) * DM) + ln_; } \
        _Pragma("unroll") for (int j_ = 0; j_ < 8; ++j_) { nv[j_] = x4_[64 * j_]; _Pragma("unroll") for (int k_ = 0; k_ < 4; ++k_) nyw[k_][j_] = y8_[k_][64 * j_]; } } while (0)
    if (gw < MT) { P11_INV(gw); P11_LOAD(gw); if (gw + NGW < MT) P11_INV(gw + NGW); }
    for (int m = gw; m < MT; m += NGW) {
        int lane = lane0; asm volatile("" : "+v"(lane));
        const float mu = nmu, rs = nrs; const LAS f32x4* g2v = vec + 2048 + (m >> 12) * 512;
        f32x4 v[8]; float s = 0.f;
#pragma unroll
        for (int j = 0; j < 8; ++j) { f32x4 mo = (f32x4){0.f, 0.f, 0.f, 0.f};
#pragma unroll
            for (int k = 0; k < 4; ++k) { const u32x2 w = nyw[k][j]; mo += (f32x4){pg8::bf_lo(w.x), pg8::bf_hi(w.x), pg8::bf_lo(w.y), pg8::bf_hi(w.y)}; }
            const f32x4 x1 = (nv[j] - mu) * rs * vec[lane + 64 * j] + vec[512 + lane + 64 * j];
            v[j] = x1 * DN_ALPHA + g2v[lane + 64 * j] * mo; s += (v[j][0] + v[j][1]) + (v[j][2] + v[j][3]);
            if (j & 1) __builtin_amdgcn_sched_barrier(0); }
        const float mean = wave_sum(s) * (1.0f / DM); float s2 = 0.f;
#pragma unroll
        for (int j = 0; j < 8; ++j) { v[j] = v[j] - mean; s2 += (v[j][0] * v[j][0] + v[j][1] * v[j][1]) + (v[j][2] * v[j][2] + v[j][3] * v[j][3]); }
        const float rstd = 1.0f / sqrtf(wave_sum(s2) * (1.0f / DM) + LN_EPS);
        if (m + NGW < MT) { P11_LOAD(m + NGW); if (m + 2 * NGW < MT) P11_INV(m + 2 * NGW); }
        __builtin_amdgcn_sched_barrier(0);
        GAS f32x4* o4 = (GAS f32x4*)(F.out + (size_t)m * DM) + lane;
#pragma unroll
        for (int j = 0; j < 8; ++j) o4[64 * j] = v[j] * rstd * vec[1024 + lane + 64 * j] + vec[1536 + lane + 64 * j];
    }
#undef P11_INV
#undef P11_LOAD
}

#ifndef PROBE
#define PROBE 0
#endif
struct Args { const float* in[26]; float* out; unsigned char* ws; };
__global__ void __launch_bounds__(NWAVES * 64, 2) mega_fwd(Args args) {
    extern __shared__ __attribute__((aligned(16))) unsigned char lds[];
    Frame F;
    F.lds = (LAS unsigned char*)lds;
    F.MISC = (volatile LAS unsigned*)(F.lds + MISC_OFF);
    F.tid = threadIdx.x; F.lane = F.tid & 63; F.wave = __builtin_amdgcn_readfirstlane(F.tid >> 6);
    F.G = gridDim.x; { const int bx = blockIdx.x; F.vcu = (F.G % 8 == 0) ? (bx % 8) * (F.G / 8) + bx / 8 : bx; }
    F.ws = args.ws; F.ctl = (gu32*)(args.ws + WS_CTL); F.out = args.out;
    for (int u = F.tid; u < (LDS_BYTES - LDSCTL_OFF) / 4; u += NWAVES * 64) ((LAS unsigned*)(F.lds + LDSCTL_OFF))[u] = 0u;
    __syncthreads();
    XcdBarrier bar = xcd_barrier_post((unsigned*)(F.ctl + CW_BAR), F.MISC + 8);
#define GRID_BAR() xcd_barrier(bar)
    unsigned char* ws = args.ws;
    pg8::bf16_t* WIN = (pg8::bf16_t*)(ws + WS_WIN);

    p0_phase(F, args.in[1], args.in[3], args.in[4], args.in[6], args.in[13], args.in[14], args.in[15]); GRID_BAR();
    p2_phase(F, args.in[0], args.in[2], args.in[5]); GRID_BAR();
    const bool split = (F.G == 256); const int NWRK = split ? NWORK : F.G; const bool conv_role = split && (int)blockIdx.x >= NWORK;
    if (conv_role) (void)xcd_barrier_arrive(bar);
    else {
        pg8::Gemm g{(const pg8::bf16_t*)(ws + WS_H), WIN, MH, PROJ, DM / 2}; pg8::InProjOrder S{NWRK, (int)blockIdx.x};
        pg8::EpiInProj E{(const float*)(ws + WS_SH), (const float*)(ws + WS_SBIN), (pg8::bf16_t*)(ws + WS_QA), (pg8::bf16_t*)(ws + WS_KA), (pg8::bf16_t*)(ws + WS_VA), (pg8::bf16_t*)(ws + WS_QB), (pg8::bf16_t*)(ws + WS_KB), (pg8::bf16_t*)(ws + WS_VB),
                          (pg8::bf16_t*)(ws + WS_GA), (pg8::bf16_t*)(ws + WS_GB), attn_body::C2, (LAS float*)(F.lds + TOK_OFF)};
        pg8::gemm_phase<pg8::EpiInProj, pg8::InProjOrder, PG8_ALIGN, PG8_SP2>(F.lds + RING_OFF, g, S, E);
    }
    if (conv_role) { conv_mixer_out(F, args.in[13], args.in[14], args.in[15], (int)blockIdx.x - NWORK, F.G - NWORK);
        conv_up_int8_queue(F, args.in[20]); conv_int8_queue<0, 2048>(F, args.in[22], F.ws + WS_WDN, (float*)(F.ws + WS_SBD), CW_QDNQ); xcd_barrier_wait(bar); }
    else if (split) {
        (void)xcd_barrier_arrive(bar);
        for (;;) {
            if (xcd_barrier_test(bar)) break;
            int done = conv_up_int8_queue(F, args.in[20], CW_QUPQ, 1);
            if (!done) done = conv_int8_queue<0, 2048>(F, args.in[22], F.ws + WS_WDN, (float*)(F.ws + WS_SBD), CW_QDNQ, 1);
            if (!done) { xcd_barrier_wait(bar); break; }
        }
    } else GRID_BAR();
    if (!conv_role) p4_phase(F, (char*)lds + RING_OFF, args.in[12], split ? (int)((blockIdx.x & 7) * (NWORK / 8) + (blockIdx.x >> 3)) : F.vcu, NWRK);
    if (!split) conv_mixer_out(F, args.in[13], args.in[14], args.in[15], (int)blockIdx.x, F.G);
    conv_up_int8_queue(F, args.in[20]);
    conv_int8_queue<0, 2048>(F, args.in[22], F.ws + WS_WDN, (float*)(F.ws + WS_SBD), CW_QDNQ);
    GRID_BAR();
    p4c_phase(F, args.in[7], args.in[8], args.in[9], args.in[10], args.in[11]);
    GRID_BAR();
    {
        pg8::Gemm g{(const pg8::bf16_t*)(ws + WS_OA), (const pg8::bf16_t*)(ws + WS_WOA), MT, DM, 512}; pg8::StaticOrder S; S.init(MT, DM, F.G, (int)blockIdx.x);
        pg8::EpiGate1Q E{(const pg8::bf16_t*)(ws + WS_GA), (float*)(ws + WS_Y1), (const float*)(ws + WS_SOA), (const float*)(ws + WS_SBOA), (LAS float*)(F.lds + TOK_OFF)};
        pg8::gemm_phase<pg8::EpiGate1Q, pg8::StaticOrder, PG8_ALIGN, PG8_SP2>(F.lds + RING_OFF, g, S, E);
    }
    VM_WAIT(); __syncthreads();
    {
        pg8::Gemm g{(const pg8::bf16_t*)(ws + WS_OBQ), (const pg8::bf16_t*)(ws + WS_WOB), MT, DM, 512}; pg8::StaticOrder S; S.init(MT, DM, F.G, (int)blockIdx.x);
        pg8::EpiGate2Q E{(const pg8::bf16_t*)(ws + WS_GB), (const float*)(ws + WS_Y1), ws + WS_Y, (float*)(ws + WS_RMAXY), (const float*)(ws + WS_SOB), (const float*)(ws + WS_SBOB), (LAS float*)(F.lds + TOK_OFF)};
        pg8::gemm_phase<pg8::EpiGate2Q, pg8::StaticOrder, PG8_ALIGN, PG8_SP2>(F.lds + RING_OFF, g, S, E);
    }
    GRID_BAR();
    {
        p9b_phase(F, MT, (const float*)(ws + WS_RMAXY), ws + WS_Y, (float*)(ws + WS_SY)); GRID_BAR();
        pg8::Gemm g{(const pg8::bf16_t*)(ws + WS_Y), (const pg8::bf16_t*)(ws + WS_WOUT), MT, DM, DM / 2}; pg8::StaticOrder S; S.init(MT, DM, F.G, (int)blockIdx.x);
        pg8::EpiOutQ E{args.in[0], (const float*)(ws + WS_MOD), (float*)(ws + WS_R), DN_ALPHA, (const float*)(ws + WS_SY), (const float*)(ws + WS_SBOUT), (LAS float*)(F.lds + TOK_OFF)};
        pg8::gemm_phase<pg8::EpiOutQ, pg8::StaticOrder, PG8_ALIGN, PG8_SP2>(F.lds + RING_OFF, g, S, E);
    }
    GRID_BAR();
    p7_phase(F, args.in[16], args.in[17], args.in[18], args.in[19]); GRID_BAR();
    p8_phase(F);
    const LAS int* t_cnt = (const LAS int*)(F.lds + TBL_OFF); const LAS int* t_pstart = t_cnt + 32; const LAS int* t_mte = t_cnt + 128; const int nMt = t_cnt[96];
    {
        pg8::Gemm g{(const pg8::bf16_t*)(ws + WS_HM), (const pg8::bf16_t*)(ws + WS_WUP), MT, NE * 4096, DM / 2}; pg8::MoeOrder S;     S.init(nMt, 16, F.G, (int)blockIdx.x, t_mte, t_cnt, t_pstart); S.mode = 1; pg8::MoeOrder S2 = S; S2.mode = 2;
        LAS unsigned short* tokl = (LAS unsigned short*)(F.lds + TOK_OFF); LAS float* sclL = (LAS float*)(F.lds + TOK_OFF + 9216);
        if (F.wave < 4) {
            const int* PSL = (const int*)(ws + WS_PSLOT); const float* SAp = (const float*)(ws + WS_SA); int tl_ = threadIdx.x; asm volatile("" : "+v"(tl_));
            int tkv[18]; bool okv[18];
#pragma unroll
            for (int i = 0; i < 18; ++i) { pg8::Unit u; u.pm = 0; bool has = S.next(i, u); if (!has && i == S.nwg / S.G) has = S2.next(0, u); const int pm = has ? u.pm : 0, e = t_mte[pm], q = pm * 256 + tl_ - t_pstart[e];
                okv[i] = has && q < t_cnt[e]; tkv[i] = PSL[okv[i] ? e * 16384 + q : 0]; }
            float sav[18];
#pragma unroll
            for (int i = 0; i < 18; ++i) { tkv[i] = okv[i] ? ((tkv[i] >> 2) & 16383) : 0; sav[i] = SAp[tkv[i]]; }
#pragma unroll
            for (int i = 0; i < 18; ++i) { tokl[i * 256 + tl_] = (unsigned short)tkv[i]; sclL[i * 256 + tl_] = okv[i] ? sav[i] : 0.f; }
        }
        __syncthreads();
        pg8::EpiUpQ E{args.in[21], ws + WS_ACTQ, (const float*)(ws + WS_SA), (const float*)(ws + WS_SB), (const int*)(ws + WS_PSLOT), t_cnt, t_pstart, (float*)(ws + WS_RMAXP), sclL, (LAS float*)(F.lds + EPL_OFF)};
        pg8::gemm_phase<pg8::EpiUpQ, pg8::MoeOrder, PG8_ALIGN, PG8_SP2, true, false>(F.lds + RING_OFF, g, S, E, tokl);
        pg8::gemm_phase<pg8::EpiUpQ, pg8::MoeOrder, PG8_ALIGN, PG8_SP2, true, true>(F.lds + RING_OFF, g, S2, E, tokl);
    }
    GRID_BAR();
    {
        p9b_phase(F, nMt * 256, (const float*)(ws + WS_RMAXP), ws + WS_ACTQ, (float*)(ws + WS_SACT)); GRID_BAR();
        pg8::Gemm g{(const pg8::bf16_t*)(ws + WS_ACTQ), (const pg8::bf16_t*)(ws + WS_WDN), MAXMT * 256, NE * DM, DM / 2}; pg8::MoeOrder S; S.init(nMt, 8, F.G, (int)blockIdx.x, t_mte, t_cnt, t_pstart); S.mode = 1; pg8::MoeOrder S2 = S; S2.mode = 2;
        pg8::EpiDownQ E{args.in[23], (pg8::bf16_t*)(ws + WS_YSG), (const int*)(ws + WS_PSLOT), (const float*)(ws + WS_PGATE), t_cnt, t_pstart, (const float*)(ws + WS_SACT), (const float*)(ws + WS_SBD), (LAS float*)(F.lds + TOK_OFF)};
        pg8::gemm_phase<pg8::EpiDownQ, pg8::MoeOrder, PG8_ALIGN, PG8_SP2, false, false>(F.lds + RING_OFF, g, S, E);
        pg8::gemm_phase<pg8::EpiDownQ, pg8::MoeOrder, PG8_ALIGN, PG8_SP2, false, true>(F.lds + RING_OFF, g, S2, E);
    }
    GRID_BAR();
#if PROBE == 3 || PROBE == 4
    {
        pg8::Gemm g{(const pg8::bf16_t*)(ws + WS_HM), (const pg8::bf16_t*)(ws + WS_WUP), MT, NE * 4096, DM / 2}; pg8::MoeOrder S;     S.init(nMt, 16, F.G, (int)blockIdx.x, t_mte, t_cnt, t_pstart);
        LAS unsigned short* tokl = (LAS unsigned short*)(F.lds + TOK_OFF); LAS float* sclL = (LAS float*)(F.lds + TOK_OFF + 9216);
        { const int* PSL = (const int*)(ws + WS_PSLOT); pg8::Unit u;
          for (int i = 0; i < 18 && S.next(i, u); ++i) if (F.tid < 256) { const int e = t_mte[u.pm], q = u.pm * 256 + F.tid - t_pstart[e];
              const int tk = q < t_cnt[e] ? ((PSL[e * 16384 + q] >> 2) & 16383) : 0; tokl[i * 256 + F.tid] = (unsigned short)tk; sclL[i * 256 + F.tid] = q < t_cnt[e] ? ((const float*)(ws + WS_SA))[tk] : 0.f; } }
        __syncthreads();
        pg8::EpiUpQ E{args.in[21], ws + WS_ACTQ, (const float*)(ws + WS_SA), (const float*)(ws + WS_SB), (const int*)(ws + WS_PSLOT), t_cnt, t_pstart, (float*)(ws + WS_RMAXP), sclL, (LAS float*)(F.lds + EPL_OFF)};
        pg8::gemm_phase<pg8::EpiUpQ, pg8::MoeOrder, PG8_ALIGN, PG8_SP2, true, false>(F.lds + RING_OFF, g, S, E, tokl);
    }
    GRID_BAR();
#endif
#if PROBE == 3 || PROBE == 5 || PROBE == 6
    {
#if PROBE != 5
        p9b_phase(F, nMt * 256, (const float*)(ws + WS_RMAXP), ws + WS_ACTQ, (float*)(ws + WS_SACT)); GRID_BAR();
#endif
#if PROBE != 6
        pg8::Gemm g{(const pg8::bf16_t*)(ws + WS_ACTQ), (const pg8::bf16_t*)(ws + WS_WDN), MAXMT * 256, NE * DM, DM / 2}; pg8::MoeOrder S; S.init(nMt, 8, F.G, (int)blockIdx.x, t_mte, t_cnt, t_pstart);
        pg8::EpiDownQ E{args.in[23], (pg8::bf16_t*)(ws + WS_YSG), (const int*)(ws + WS_PSLOT), (const float*)(ws + WS_PGATE), t_cnt, t_pstart, (const float*)(ws + WS_SACT), (const float*)(ws + WS_SBD), (LAS float*)(F.lds + TOK_OFF)};
        pg8::gemm_phase<pg8::EpiDownQ, pg8::MoeOrder, PG8_ALIGN, PG8_SP2, false, false>(F.lds + RING_OFF, g, S, E);
#endif
    }
    GRID_BAR();
#endif
    p11_phase(F, args.in[16], args.in[17], args.in[24], args.in[25]);
#if PROBE == 8
    GRID_BAR(); p11_phase(F, args.in[16], args.in[17], args.in[24], args.in[25]);
#endif
#undef GRID_BAR
}

extern "C" void kernel_launch(void* const* d_in, const int* in_sizes, int n_in, void* d_out, int out_size, void* d_ws, size_t ws_size, hipStream_t stream) {
    static int grid = 0;
    if (grid == 0) {
        if (n_in != 26 || out_size != MT * DM || ws_size < WS_END) { fprintf(stderr, "kernel_launch: unexpected shapes (n_in %d, out %d, ws %zu); nothing launched\n", n_in, out_size, ws_size); grid = -1; return; }
        int dev = 0, cus = 0, per_cu = 0;
        if (hipGetDevice(&dev) != hipSuccess || hipDeviceGetAttribute(&cus, hipDeviceAttributeMultiprocessorCount, dev) != hipSuccess) { grid = -1; return; }
        if (hipFuncSetAttribute((const void*)mega_fwd, hipFuncAttributeMaxDynamicSharedMemorySize, LDS_BYTES) != hipSuccess) { fprintf(stderr, "kernel_launch: hipFuncSetAttribute failed\n"); grid = -1; return; }
        if (hipOccupancyMaxActiveBlocksPerMultiprocessor(&per_cu, (const void*)mega_fwd, NWAVES * 64, LDS_BYTES) != hipSuccess || per_cu < 1) fprintf(stderr, "kernel_launch: occupancy query reports %d\n", per_cu);
        (void)hipGetLastError();
        grid = cus;
    }
    if (grid < 0) return;
    if (hipMemsetAsync((char*)d_ws + WS_CTL, 0, CTL_ZERO_BYTES, stream) != hipSuccess) return;
    Args a{};
    for (int i = 0; i < 26; ++i) a.in[i] = (const float*)d_in[i];
    a.out = (float*)d_out; a.ws = (unsigned char*)d_ws;
    hipLaunchKernelGGL(mega_fwd, dim3(grid), dim3(NWAVES * 64), LDS_BYTES, stream, a);
}
```
